# Optimizing an MI355X kernel written in HIP

```python
import math
import jax, jax.numpy as jnp
from jax import lax
import numpy as np

D_MODEL = 4096
BATCH = 4
SEQ = 4096
DEPTH = 1

PLE_DIM = 256
CHUNK = 128
QBLOCK = 128
HEAD_DIM = 128
A_WIDTH = D_MODEL // 2
B_WIDTH = D_MODEL - A_WIDTH
SGU_HEADS = A_WIDTH // HEAD_DIM
SB_HEADS = B_WIDTH // HEAD_DIM
D_IN = 2 * A_WIDTH + 3 * B_WIDTH
D_FF = 4 * D_MODEL
EPS = 1e-6

kernel_name = "hybrid_sgu_stickbreaking_block"


def _rms_norm(x, g):
    x32 = x.astype(jnp.float32)
    y = x32 * lax.rsqrt(jnp.mean(x32 * x32, axis=-1, keepdims=True) + EPS)
    return (y * g.astype(jnp.float32)).astype(x.dtype)


def _head_rms_norm(y, g, n_heads):
    b, s, w = y.shape
    dh = w // n_heads
    y32 = y.reshape(b, s, n_heads, dh).astype(jnp.float32)
    y32 = y32 * lax.rsqrt(jnp.mean(y32 * y32, axis=-1, keepdims=True) + EPS)
    y32 = y32 * g.reshape(n_heads, dh).astype(jnp.float32)
    return y32.reshape(b, s, w).astype(y.dtype)


def _chunked_sgu(u, v, w_s, b_s):
    b, s, w = u.shape
    nc = s // CHUNK
    u = jax.nn.gelu(u)
    v = jax.nn.gelu(v)
    v32 = v.reshape(b, nc, CHUNK, SGU_HEADS, HEAD_DIM).astype(jnp.float32)
    mu = jnp.mean(v32, axis=-1, keepdims=True)
    var = jnp.mean(jnp.square(v32 - mu), axis=-1, keepdims=True)
    vn = (v32 - mu) * lax.rsqrt(var + EPS)
    causal = jnp.tril(jnp.ones((CHUNK, CHUNK), dtype=bool))
    w_masked = jnp.where(causal[None], w_s.astype(jnp.float32), 0.0)
    mixed = jnp.einsum('hts,bnshd->bnthd', w_masked, vn)
    mixed = mixed + b_s.astype(jnp.float32).T[None, None, :, :, None]
    return u * mixed.reshape(b, s, w).astype(u.dtype)


def _stick_breaking(q, k, v):
    b, s, w = q.shape
    nb = s // QBLOCK
    scale = 1.0 / math.sqrt(HEAD_DIM)

    def heads(t):
        return t.reshape(b, s, SB_HEADS, HEAD_DIM).transpose(0, 2, 1, 3).astype(jnp.float32)

    qh = heads(q) * scale
    kh = heads(k)
    vh = heads(v)
    q_blocks = qh.reshape(b, SB_HEADS, nb, QBLOCK, HEAD_DIM).transpose(2, 0, 1, 3, 4)
    key_pos = jnp.arange(s)

    def block(args):
        qb, bi = args
        z = jnp.einsum('bhqd,bhkd->bhqk', qb, kh)
        q_pos = bi * QBLOCK + jnp.arange(QBLOCK)
        causal = key_pos[None, :] < q_pos[:, None]
        log_keep = jnp.where(causal, jax.nn.log_sigmoid(-z), 0.0)
        log_after = lax.cumsum(log_keep, axis=3, reverse=True) - log_keep
        a = jnp.where(causal, jnp.exp(jax.nn.log_sigmoid(z) + log_after), 0.0)
        return jnp.einsum('bhqk,bhkd->bhqd', a, vh)

    o = lax.map(block, (q_blocks, jnp.arange(nb)))
    o = o.transpose(1, 0, 3, 2, 4).reshape(b, s, w)
    return o.astype(q.dtype)


def setup_inputs(seed: int = 0) -> dict:
    key = jax.random.key(seed)
    ks = jax.random.split(key, 18)
    f32 = jnp.float32

    def nrm(k, shape, scale):
        return jax.random.normal(k, shape, f32) * scale

    def gain(k, shape):
        return 1.0 + 0.02 * jax.random.normal(k, shape, f32)

    return {
        "x": nrm(ks[0], (BATCH, SEQ, D_MODEL), 1.0),
        "p": nrm(ks[1], (DEPTH, BATCH, SEQ, PLE_DIM), 1.0),
        "norm_mix": gain(ks[2], (DEPTH, D_MODEL)),
        "w_in": nrm(ks[3], (DEPTH, D_MODEL, D_IN), D_MODEL ** -0.5),
        "w_s": nrm(ks[4], (DEPTH, SGU_HEADS, CHUNK, CHUNK), CHUNK ** -0.5),
        "b_s": gain(ks[5], (DEPTH, SGU_HEADS, CHUNK)),
        "norm_a_out": gain(ks[6], (DEPTH, A_WIDTH)),
        "norm_b_out": gain(ks[7], (DEPTH, B_WIDTH)),
        "w_out": nrm(ks[8], (DEPTH, D_MODEL, D_MODEL), D_MODEL ** -0.5),
        "norm_ffn": gain(ks[9], (DEPTH, D_MODEL)),
        "w_up": nrm(ks[10], (DEPTH, D_MODEL, D_FF), D_MODEL ** -0.5),
        "w_down": nrm(ks[11], (DEPTH, D_FF, D_MODEL), D_FF ** -0.5),
        "norm_ple": gain(ks[12], (DEPTH, D_MODEL)),
        "w_ple_gate": nrm(ks[13], (DEPTH, D_MODEL, D_MODEL), D_MODEL ** -0.5),
        "w_ple_proj": nrm(ks[14], (DEPTH, PLE_DIM, D_MODEL), PLE_DIM ** -0.5),
        "norm_final": gain(ks[15], (D_MODEL,)),
    }


def reference(x, p, norm_mix, w_in, w_s, b_s, norm_a_out, norm_b_out, w_out,
              norm_ffn, w_up, w_down, norm_ple, w_ple_gate, w_ple_proj, norm_final):
    h = x
    for i in range(DEPTH):
        a = _rms_norm(h, norm_mix[i])
        z = jnp.einsum('bsd,de->bse', a, w_in[i])
        o1 = A_WIDTH
        o2 = 2 * A_WIDTH
        o3 = o2 + B_WIDTH
        o4 = o3 + B_WIDTH
        u_a, v_a = z[..., :o1], z[..., o1:o2]
        q_b, k_b, v_b = z[..., o2:o3], z[..., o3:o4], z[..., o4:]
        y_a = _chunked_sgu(u_a, v_a, w_s[i], b_s[i])
        y_b = _stick_breaking(q_b, k_b, v_b)
        y = jnp.concatenate([_head_rms_norm(y_a, norm_a_out[i], SGU_HEADS),
                             _head_rms_norm(y_b, norm_b_out[i], SB_HEADS)], axis=-1)
        h = h + jnp.einsum('bsd,de->bse', y, w_out[i])
        m = _rms_norm(h, norm_ffn[i])
        hid = jnp.square(jax.nn.relu(jnp.einsum('bsd,df->bsf', m, w_up[i])))
        h = h + jnp.einsum('bsf,fd->bsd', hid, w_down[i])
        gate = jax.nn.sigmoid(jnp.einsum('bsd,de->bse', _rms_norm(h, norm_ple[i]), w_ple_gate[i]))
        e = jnp.einsum('bsk,kd->bsd', p[i], w_ple_proj[i])
        h = h + gate * e
    return _rms_norm(h, norm_final)
```

```cpp
#include <hip/hip_runtime.h>
#include <cstdio>
#include <cstdint>

typedef unsigned short bf16;
typedef short bf16x8 __attribute__((ext_vector_type(8)));
typedef float f32x4 __attribute__((ext_vector_type(4)));
typedef unsigned u32x4 __attribute__((ext_vector_type(4)));

constexpr int NB = 4, SEQ = 4096, DM = 4096, M = NB * SEQ, DIN = 10240, DFF = 16384, PLE = 256, AW = 2048, NH = 16, HD = 128, CH = 128;
constexpr float EPS = 1e-6f;

constexpr size_t MiB = 1u << 20;
constexpr size_t OFF_CTL = 0, OFF_PBF = 1 * MiB, OFF_WSB = 9 * MiB;
constexpr size_t OFF_WIN = 10 * MiB, OFF_WOUT = OFF_WIN + 80 * MiB, OFF_WUP = OFF_WOUT + 32 * MiB, OFF_WDN = OFF_WUP + 128 * MiB, OFF_WGT = OFF_WDN + 128 * MiB, OFF_WPJ = OFF_WGT + 32 * MiB;
constexpr size_t OFF_ACT = OFF_WPJ + 2 * MiB;
constexpr size_t OFF_BIG = OFF_ACT + 128 * MiB;
constexpr size_t WS_END = OFF_BIG + 512 * MiB;

__device__ __forceinline__ unsigned f2bf(float f) { unsigned u = __builtin_bit_cast(unsigned, f); return (u + 0x7fffu + ((u >> 16) & 1u)) >> 16; }
__device__ __forceinline__ float bf2f(unsigned short h) { return __builtin_bit_cast(float, (unsigned)h << 16); }
__device__ __forceinline__ float gelu_tanh(float x) { const float y = 0.7978845608028654f * (x + 0.044715f * x * x * x); return x / (1.0f + __expf(-2.0f * y)); }

__global__ void __launch_bounds__(256) k_transpose_w(const float* __restrict__ W, bf16* __restrict__ WT, int K, int N) {
    __shared__ float tile[64][65];
    const int n0 = blockIdx.x * 64, k0 = blockIdx.y * 64, tx = threadIdx.x & 63, ty = threadIdx.x >> 6;
    for (int r = ty; r < 64; r += 4) tile[r][tx] = W[(size_t)(k0 + r) * N + n0 + tx];
    __syncthreads();
    for (int r = ty; r < 64; r += 4) WT[(size_t)(n0 + r) * K + k0 + tx] = (bf16)f2bf(tile[tx][r]);
}
__global__ void __launch_bounds__(256) k_cvt(const float* __restrict__ in, bf16* __restrict__ out, size_t n) {
    size_t i = (size_t)blockIdx.x * 256 + threadIdx.x; if (i < n) out[i] = (bf16)f2bf(in[i]);
}
__global__ void __launch_bounds__(256) k_rmsnorm_bf16(const float* __restrict__ x, const float* __restrict__ g, bf16* __restrict__ y) {
    __shared__ float red[4];
    const int row = blockIdx.x, t = threadIdx.x;
    const float* xr = x + (size_t)row * DM;
    float v[16]; float ss = 0.f;
    for (int i = 0; i < 16; ++i) { v[i] = xr[t + 256 * i]; ss += v[i] * v[i]; }
    for (int o = 32; o > 0; o >>= 1) ss += __shfl_xor(ss, o);
    if ((t & 63) == 0) red[t >> 6] = ss;
    __syncthreads();
    const float tot = red[0] + red[1] + red[2] + red[3];
    const float r = 1.0f / sqrtf(tot * (1.0f / DM) + EPS);
    for (int i = 0; i < 16; ++i) y[(size_t)row * DM + t + 256 * i] = (bf16)f2bf(v[i] * r * g[t + 256 * i]);
}
__global__ void __launch_bounds__(256) k_rmsnorm_f32(float* __restrict__ x, const float* __restrict__ g) {
    __shared__ float red[4];
    const int row = blockIdx.x, t = threadIdx.x;
    float* xr = x + (size_t)row * DM;
    float v[16]; float ss = 0.f;
    for (int i = 0; i < 16; ++i) { v[i] = xr[t + 256 * i]; ss += v[i] * v[i]; }
    for (int o = 32; o > 0; o >>= 1) ss += __shfl_xor(ss, o);
    if ((t & 63) == 0) red[t >> 6] = ss;
    __syncthreads();
    const float tot = red[0] + red[1] + red[2] + red[3];
    const float r = 1.0f / sqrtf(tot * (1.0f / DM) + EPS);
    for (int i = 0; i < 16; ++i) xr[t + 256 * i] = v[i] * r * g[t + 256 * i];
}

enum { EPI_Z = 0, EPI_RES1 = 1, EPI_UP = 2, EPI_RES2 = 3, EPI_E = 4, EPI_GATE = 5 };
struct EpiArgs { bf16* ob; float* of; const float* base; const bf16* e; int ldc; int pad; };
template <int EPI>
__global__ void __launch_bounds__(256) k_gemm(const bf16* __restrict__ A, const bf16* __restrict__ Bt, int K, EpiArgs ea) {
    __shared__ __attribute__((aligned(16))) bf16 As[128][40];
    __shared__ __attribute__((aligned(16))) bf16 Bs[128][40];
    const int tid = threadIdx.x, lane = tid & 63, w = tid >> 6, wm = w >> 1, wn = w & 1;
    const int bm = blockIdx.y * 128, bn = blockIdx.x * 128;
    const int lr = tid >> 1, lc = (tid & 1) * 16;
    const bf16* ap = A + (size_t)(bm + lr) * K + lc;
    const bf16* bp = Bt + (size_t)(bn + lr) * K + lc;
    f32x4 acc[4][4];
    for (int i = 0; i < 4; ++i) for (int j = 0; j < 4; ++j) acc[i][j] = (f32x4){0.f, 0.f, 0.f, 0.f};
    const int fr = lane & 15, fq = lane >> 4;
    for (int k0 = 0; k0 < K; k0 += 32) {
        const u32x4 a0 = *(const u32x4*)(ap + k0), a1 = *(const u32x4*)(ap + k0 + 8);
        const u32x4 b0 = *(const u32x4*)(bp + k0), b1 = *(const u32x4*)(bp + k0 + 8);
        __syncthreads();
        *(u32x4*)&As[lr][lc] = a0; *(u32x4*)&As[lr][lc + 8] = a1;
        *(u32x4*)&Bs[lr][lc] = b0; *(u32x4*)&Bs[lr][lc + 8] = b1;
        __syncthreads();
        bf16x8 af[4], bfr[4];
        for (int i = 0; i < 4; ++i) af[i] = *(const bf16x8*)&As[wm * 64 + i * 16 + fr][fq * 8];
        for (int j = 0; j < 4; ++j) bfr[j] = *(const bf16x8*)&Bs[wn * 64 + j * 16 + fr][fq * 8];
        for (int i = 0; i < 4; ++i) for (int j = 0; j < 4; ++j) acc[i][j] = __builtin_amdgcn_mfma_f32_16x16x32_bf16(af[i], bfr[j], acc[i][j], 0, 0, 0);
    }
    for (int i = 0; i < 4; ++i) for (int j = 0; j < 4; ++j) for (int r = 0; r < 4; ++r) {
        const int row = bm + wm * 64 + i * 16 + fq * 4 + r, col = bn + wn * 64 + j * 16 + fr;
        const size_t o = (size_t)row * ea.ldc + col; const float v = acc[i][j][r];
        if (EPI == EPI_Z || EPI == EPI_E) ea.ob[o] = (bf16)f2bf(v);
        else if (EPI == EPI_RES1 || EPI == EPI_RES2) ea.of[o] = ea.base[o] + v;
        else if (EPI == EPI_UP) { const float t = v > 0.f ? v : 0.f; ea.ob[o] = (bf16)f2bf(t * t); }
        else if (EPI == EPI_GATE) { const float gt = 1.0f / (1.0f + __expf(-v)); ea.of[o] = ea.base[o] + gt * bf2f(ea.e[o]); }
    }
}

__global__ void __launch_bounds__(256) k_sgu(const bf16* __restrict__ z, const float* __restrict__ ws, const float* __restrict__ bs, const float* __restrict__ ga, bf16* __restrict__ y) {
    __shared__ float vn[128][128];
    const int h = blockIdx.x, nc = blockIdx.y, b = blockIdx.z, tid = threadIdx.x;
    const int t = tid >> 1, half = tid & 1;
    const size_t row = (size_t)b * SEQ + nc * CH + t;
    const bf16* vr = z + row * DIN + AW + h * HD + half * 64;
    float s1 = 0.f;
    for (int j = 0; j < 64; ++j) { const float gv = gelu_tanh(bf2f(vr[j])); vn[t][half * 64 + j] = gv; s1 += gv; }
    s1 += __shfl_xor(s1, 1);
    const float mu = s1 * (1.0f / 128.0f);
    float s2 = 0.f;
    for (int j = 0; j < 64; ++j) { const float d = vn[t][half * 64 + j] - mu; s2 += d * d; }
    s2 += __shfl_xor(s2, 1);
    const float rs = 1.0f / sqrtf(s2 * (1.0f / 128.0f) + EPS);
    for (int j = 0; j < 64; ++j) vn[t][half * 64 + j] = (vn[t][half * 64 + j] - mu) * rs;
    __syncthreads();
    float acc[64];
    for (int j = 0; j < 64; ++j) acc[j] = 0.f;
    const float* wr = ws + ((size_t)h * CH + t) * CH;
    for (int s = 0; s <= t; ++s) { const float wv = wr[s];
        for (int j = 0; j < 64; ++j) acc[j] += wv * vn[s][half * 64 + j]; }
    const float bias = bs[h * CH + t];
    const bf16* ur = z + row * DIN + h * HD + half * 64;
    float ss = 0.f;
    for (int j = 0; j < 64; ++j) { const float u = gelu_tanh(bf2f(ur[j])); acc[j] = u * (acc[j] + bias); ss += acc[j] * acc[j]; }
    ss += __shfl_xor(ss, 1);
    const float r = 1.0f / sqrtf(ss * (1.0f / 128.0f) + EPS);
    for (int j = 0; j < 64; ++j) y[row * DM + h * HD + half * 64 + j] = (bf16)f2bf(acc[j] * r * ga[h * HD + half * 64 + j]);
}

__global__ void __launch_bounds__(256) k_attn(const bf16* __restrict__ z, const float* __restrict__ gb, bf16* __restrict__ y) {
    __shared__ float qs[4][128];
    const int lane = threadIdx.x & 63, w = threadIdx.x >> 6;
    const int gi = blockIdx.x * 4 + w;
    const int t = gi % SEQ, h = (gi / SEQ) % NH, b = gi / (SEQ * NH);
    const size_t rowq = (size_t)b * SEQ + t;
    const float scale = 0.08838834764831845f;
    { const bf16* qr = z + rowq * DIN + 2 * AW + h * HD; qs[w][lane] = bf2f(qr[lane]) * scale; qs[w][lane + 64] = bf2f(qr[lane + 64]) * scale; }
    __syncthreads();
    float o0 = 0.f, o1 = 0.f, L = 0.f;
    for (int c = 0; 64 * c < t; ++c) {
        const int s = t - 1 - (64 * c + lane); const bool valid = s >= 0;
        float zz = 0.f;
        if (valid) { const bf16* kr = z + ((size_t)b * SEQ + s) * DIN + 2 * AW + AW + h * HD;
            for (int d8 = 0; d8 < 16; ++d8) { const bf16x8 kv = *(const bf16x8*)(kr + d8 * 8);
                for (int j = 0; j < 8; ++j) zz += qs[w][d8 * 8 + j] * bf2f((unsigned short)kv[j]); } }
        const float sp = fmaxf(zz, 0.f) + log1pf(__expf(-fabsf(zz)));
        const float lk = valid ? -sp : 0.f, ls = zz - sp;
        float inc = lk;
        for (int off = 1; off < 64; off <<= 1) { const float v = __shfl_up(inc, off); if (lane >= off) inc += v; }
        const float a = valid ? __expf(ls + L + (inc - lk)) : 0.f;
        L += __shfl(inc, 63);
        const int nk = (t - 64 * c) < 64 ? (t - 64 * c) : 64;
        for (int i = 0; i < nk; ++i) { const float ai = __shfl(a, i); const int si = t - 1 - (64 * c + i);
            const unsigned vv = *(const unsigned*)(z + ((size_t)b * SEQ + si) * DIN + 2 * AW + 2 * AW + h * HD + 2 * lane);
            o0 += ai * bf2f((unsigned short)(vv & 0xffffu)); o1 += ai * bf2f((unsigned short)(vv >> 16)); }
        if (L < -104.0f) break;
    }
    float ss = o0 * o0 + o1 * o1;
    for (int o = 32; o > 0; o >>= 1) ss += __shfl_xor(ss, o);
    const float r = 1.0f / sqrtf(ss * (1.0f / 128.0f) + EPS);
    const unsigned pk = f2bf(o0 * r * gb[h * HD + 2 * lane]) | (f2bf(o1 * r * gb[h * HD + 2 * lane + 1]) << 16);
    *(unsigned*)(y + rowq * DM + AW + h * HD + 2 * lane) = pk;
}

extern "C" void kernel_launch(void* const* d_in, const int* in_sizes, int n_in, void* d_out, int out_size, void* d_ws, size_t ws_size, hipStream_t stream) {
    if (n_in != 16 || ws_size < WS_END || out_size != M * DM) { fprintf(stderr, "kernel_launch: unexpected shapes (n_in %d, ws %zu, out %d)\n", n_in, ws_size, out_size); return; }
    const float* x = (const float*)d_in[0]; const float* p = (const float*)d_in[1]; const float* norm_mix = (const float*)d_in[2]; const float* w_in = (const float*)d_in[3];
    const float* w_s = (const float*)d_in[4]; const float* b_s = (const float*)d_in[5]; const float* norm_a = (const float*)d_in[6]; const float* norm_b = (const float*)d_in[7];
    const float* w_out = (const float*)d_in[8]; const float* norm_ffn = (const float*)d_in[9]; const float* w_up = (const float*)d_in[10]; const float* w_down = (const float*)d_in[11];
    const float* norm_ple = (const float*)d_in[12]; const float* w_gate = (const float*)d_in[13]; const float* w_proj = (const float*)d_in[14]; const float* norm_final = (const float*)d_in[15];
    unsigned char* ws = (unsigned char*)d_ws; float* out = (float*)d_out;
    bf16* pbf = (bf16*)(ws + OFF_PBF);
    bf16 *Wi = (bf16*)(ws + OFF_WIN), *Wo = (bf16*)(ws + OFF_WOUT), *Wu = (bf16*)(ws + OFF_WUP), *Wd = (bf16*)(ws + OFF_WDN), *Wg = (bf16*)(ws + OFF_WGT), *Wp = (bf16*)(ws + OFF_WPJ);
    bf16* act = (bf16*)(ws + OFF_ACT); bf16* big = (bf16*)(ws + OFF_BIG);
    k_transpose_w<<<dim3(DIN / 64, DM / 64), 256, 0, stream>>>(w_in, Wi, DM, DIN);
    k_transpose_w<<<dim3(DM / 64, DM / 64), 256, 0, stream>>>(w_out, Wo, DM, DM);
    k_transpose_w<<<dim3(DFF / 64, DM / 64), 256, 0, stream>>>(w_up, Wu, DM, DFF);
    k_transpose_w<<<dim3(DM / 64, DFF / 64), 256, 0, stream>>>(w_down, Wd, DFF, DM);
    k_transpose_w<<<dim3(DM / 64, DM / 64), 256, 0, stream>>>(w_gate, Wg, DM, DM);
    k_transpose_w<<<dim3(DM / 64, PLE / 64), 256, 0, stream>>>(w_proj, Wp, PLE, DM);
    k_cvt<<<(M * PLE) / 256, 256, 0, stream>>>(p, pbf, (size_t)M * PLE);
    k_rmsnorm_bf16<<<M, 256, 0, stream>>>(x, norm_mix, act);
    { EpiArgs ea{big, nullptr, nullptr, nullptr, DIN, 0}; k_gemm<EPI_Z><<<dim3(DIN / 128, M / 128), 256, 0, stream>>>(act, Wi, DM, ea); }
    k_sgu<<<dim3(NH, SEQ / CH, NB), 256, 0, stream>>>(big, w_s, b_s, norm_a, act);
    k_attn<<<(M * NH) / 4, 256, 0, stream>>>(big, norm_b, act);
    { EpiArgs ea{nullptr, out, x, nullptr, DM, 0}; k_gemm<EPI_RES1><<<dim3(DM / 128, M / 128), 256, 0, stream>>>(act, Wo, DM, ea); }
    k_rmsnorm_bf16<<<M, 256, 0, stream>>>(out, norm_ffn, act);
    { EpiArgs ea{big, nullptr, nullptr, nullptr, DFF, 0}; k_gemm<EPI_UP><<<dim3(DFF / 128, M / 128), 256, 0, stream>>>(act, Wu, DM, ea); }
    { EpiArgs ea{nullptr, out, out, nullptr, DM, 0}; k_gemm<EPI_RES2><<<dim3(DM / 128, M / 128), 256, 0, stream>>>(big, Wd, DFF, ea); }
    k_rmsnorm_bf16<<<M, 256, 0, stream>>>(out, norm_ple, act);
    { EpiArgs ea{big, nullptr, nullptr, nullptr, DM, 0}; k_gemm<EPI_E><<<dim3(DM / 128, M / 128), 256, 0, stream>>>(pbf, Wp, PLE, ea); }
    { EpiArgs ea{nullptr, out, out, big, DM, 0}; k_gemm<EPI_GATE><<<dim3(DM / 128, M / 128), 256, 0, stream>>>(act, Wg, DM, ea); }
    k_rmsnorm_f32<<<M, 256, 0, stream>>>(out, norm_final);
}
```

```cpp
#include <hip/hip_runtime.h>
#include <cstdio>
#include <cstdint>
namespace pg8 {
#define PG8_LAS __attribute__((address_space(3)))
typedef unsigned short bf16_t;
typedef short bf16x8 __attribute__((ext_vector_type(8)));
typedef float f32x4 __attribute__((ext_vector_type(4)));
typedef unsigned u32x4 __attribute__((ext_vector_type(4)));
constexpr int BM = 256, BK = 64, HALF = 128, HTB = HALF * BK * 2  , STAGE_BYTES = 8 * HTB, NXCD = 8, WGM = 8;

__host__ __device__ __forceinline__ int lds_byte(int r, int c) { const int st = (r >> 4) * 2 + (c >> 5), rr = r & 15, cc = c & 31, ob = rr * 64 + cc * 2; return st * 1024 + (ob ^ (((ob >> 9) & 1) << 5)); }
__host__ __device__ __forceinline__ void stage_rc(int b, int& R, int& C) { const int st = b / 1024, sb = b % 1024, swz = sb ^ (((sb >> 9) & 1) << 5); R = (st >> 1) * 16 + swz / 64; C = (st & 1) * 32 + (swz % 64) / 2; }
__host__ __device__ __forceinline__ int perm32(int rho) { const int n = rho >> 4, i = rho & 15; return 8 * (i >> 2) + 4 * n + (i & 3); }

struct Unit { int pm, pn; };
struct Gemm { const bf16_t* A; const bf16_t* Bt; int M, N, K; };

struct StaticOrder {
    int nM, nN, nwg, G, c;
    __host__ __device__ void init(int M, int N, int G_, int c_) { nM = M / BM; nN = N / BM; nwg = nM * nN; G = G_; c = c_; }
    __host__ __device__ bool next(int i, Unit& u) const {
        const long L = (long)i * G + c; if (L >= nwg) return false;
        int wgid = (int)L; { const int q = nwg / NXCD, r = nwg % NXCD, xcd = wgid % NXCD, off = wgid / NXCD; wgid = (xcd < r ? xcd * (q + 1) : r * (q + 1) + (xcd - r) * q) + off; }
        const int nig = WGM * nN, gid = wgid / nig, fm = gid * WGM, gsz = (nM - fm) < WGM ? (nM - fm) : WGM;
        u.pm = fm + ((wgid % nig) % gsz); u.pn = (wgid % nig) / gsz; return true;
    }
    __device__ __forceinline__ void a_ready(const Unit&) const {}
    __device__ __forceinline__ void done(const Unit&) const {}
};

__device__ __forceinline__ unsigned cvt_pk_bf16(float lo, float hi) { unsigned r; asm volatile("v_cvt_pk_bf16_f32 %0, %1, %2" : "=v"(r) : "v"(lo), "v"(hi)); return r; }
typedef float f32x2 __attribute__((ext_vector_type(2)));
typedef unsigned u32x2 __attribute__((ext_vector_type(2)));
__device__ __forceinline__ float bf_lo(unsigned w) { return __builtin_bit_cast(float, w << 16); }
__device__ __forceinline__ float bf_hi(unsigned w) { return __builtin_bit_cast(float, w & 0xffff0000u); }
__device__ __forceinline__ float gelu_tanh_f(float x) {
    const float x2 = x * x, t = x * (-2.302208198f + (-0.1029432397f) * x2);
    return x * __builtin_amdgcn_rcpf(1.0f + __builtin_amdgcn_exp2f(t));
}
__device__ __forceinline__ u32x4 pack8(const f32x4 v0, const f32x4 v1) { u32x4 w; w.x = cvt_pk_bf16(v0[0], v0[1]); w.y = cvt_pk_bf16(v0[2], v0[3]); w.z = cvt_pk_bf16(v1[0], v1[1]); w.w = cvt_pk_bf16(v1[2], v1[3]); return w; }
struct EpiInProj {
    static constexpr bool PERM = true, AFTER_DRAIN = false;
    bf16_t* O; int ldc; int gelu_tiles, q_tiles; float qscale;
    __device__ __forceinline__ void operator()(const f32x4 (&acc)[2][2][4][2], const Unit& u, int wr, int wc, int fr, int fq) const {
        const int row0 = u.pm * BM + wr * 64 + fr, col0 = u.pn * BM + wc * 32 + 8 * fq;
        const int mode = u.pn < gelu_tiles ? 1 : (u.pn < q_tiles ? 2 : 0);
#pragma unroll
        for (int ai = 0; ai < 2; ++ai)
#pragma unroll
            for (int m = 0; m < 4; ++m) { bf16_t* rowp = O + (size_t)(row0 + ai * HALF + m * 16) * ldc + col0;
#pragma unroll
                for (int bj = 0; bj < 2; ++bj) { f32x4 v0 = acc[ai][bj][m][0], v1 = acc[ai][bj][m][1];
                    if (mode == 1) {
#pragma unroll
                        for (int e = 0; e < 4; ++e) { v0[e] = gelu_tanh_f(v0[e]); v1[e] = gelu_tanh_f(v1[e]); } }
                    else if (mode == 2) { v0 = v0 * qscale; v1 = v1 * qscale; }
                    *(u32x4*)(rowp + bj * HALF) = pack8(v0, v1); } }
    }
};
struct EpiPlainBf16 {
    static constexpr bool PERM = true, AFTER_DRAIN = false;
    bf16_t* O; int ldc;
    __device__ __forceinline__ void operator()(const f32x4 (&acc)[2][2][4][2], const Unit& u, int wr, int wc, int fr, int fq) const {
        const int row0 = u.pm * BM + wr * 64 + fr, col0 = u.pn * BM + wc * 32 + 8 * fq;
#pragma unroll
        for (int ai = 0; ai < 2; ++ai)
#pragma unroll
            for (int m = 0; m < 4; ++m) { bf16_t* rowp = O + (size_t)(row0 + ai * HALF + m * 16) * ldc + col0;
#pragma unroll
                for (int bj = 0; bj < 2; ++bj) *(u32x4*)(rowp + bj * HALF) = pack8(acc[ai][bj][m][0], acc[ai][bj][m][1]); }
    }
};
struct EpiResNorm {
    static constexpr bool PERM = true, AFTER_DRAIN = false;
    const float* base; float* out; bf16_t* hg; const float* gain; float* ssq; int ldc;
    __device__ __forceinline__ void operator()(const f32x4 (&acc)[2][2][4][2], const Unit& u, int wr, int wc, int fr, int fq) const {
        const int row0 = u.pm * BM + wr * 64 + fr, col0 = u.pn * BM + wc * 32 + 8 * fq;
        f32x4 gv[2][2];
#pragma unroll
        for (int bj = 0; bj < 2; ++bj)
#pragma unroll
            for (int n = 0; n < 2; ++n) gv[bj][n] = *(const f32x4*)(gain + col0 + bj * HALF + 4 * n);
#pragma unroll
        for (int ai = 0; ai < 2; ++ai)
#pragma unroll
            for (int m = 0; m < 4; ++m) { const int row = row0 + ai * HALF + m * 16; const size_t off = (size_t)row * ldc + col0; float s = 0.f;
#pragma unroll
                for (int bj = 0; bj < 2; ++bj) {
                    const f32x4 h0 = *(const f32x4*)(base + off + bj * HALF) + acc[ai][bj][m][0], h1 = *(const f32x4*)(base + off + bj * HALF + 4) + acc[ai][bj][m][1];
                    *(f32x4*)(out + off + bj * HALF) = h0; *(f32x4*)(out + off + bj * HALF + 4) = h1;
                    s += (h0[0] * h0[0] + h0[1] * h0[1]) + (h0[2] * h0[2] + h0[3] * h0[3]) + (h1[0] * h1[0] + h1[1] * h1[1]) + (h1[2] * h1[2] + h1[3] * h1[3]);
                    *(u32x4*)(hg + off + bj * HALF) = pack8(h0 * gv[bj][0], h1 * gv[bj][1]); }
                s += __shfl_xor(s, 16); s += __shfl_xor(s, 32);
                if (fq == 0) atomicAdd(ssq + row, s);
                if (m & 1) asm volatile("" ::: "memory"); }
    }
};
struct EpiUp {
    static constexpr bool PERM = true, AFTER_DRAIN = false;
    bf16_t* O; int ldc; const float* ssq; float inv_n, eps;
    __device__ __forceinline__ void operator()(const f32x4 (&acc)[2][2][4][2], const Unit& u, int wr, int wc, int fr, int fq) const {
        const int row0 = u.pm * BM + wr * 64 + fr, col0 = u.pn * BM + wc * 32 + 8 * fq;
#pragma unroll
        for (int ai = 0; ai < 2; ++ai)
#pragma unroll
            for (int m = 0; m < 4; ++m) { const int row = row0 + ai * HALF + m * 16; bf16_t* rowp = O + (size_t)row * ldc + col0;
                const float r2 = 1.0f / (ssq[row] * inv_n + eps);
#pragma unroll
                for (int bj = 0; bj < 2; ++bj) { f32x4 v0 = acc[ai][bj][m][0], v1 = acc[ai][bj][m][1];
#pragma unroll
                    for (int e = 0; e < 4; ++e) { const float a = fmaxf(v0[e], 0.f), b = fmaxf(v1[e], 0.f); v0[e] = a * a * r2; v1[e] = b * b * r2; }
                    *(u32x4*)(rowp + bj * HALF) = pack8(v0, v1); } }
    }
};
struct EpiGate {
    static constexpr bool PERM = true, AFTER_DRAIN = false;
    float* out; const bf16_t* E; const float* ssq_in; float* ssq_out; int ldc; float inv_n, eps;
    __device__ __forceinline__ void operator()(const f32x4 (&acc)[2][2][4][2], const Unit& u, int wr, int wc, int fr, int fq) const {
        const int row0 = u.pm * BM + wr * 64 + fr, col0 = u.pn * BM + wc * 32 + 8 * fq;
#pragma unroll
        for (int ai = 0; ai < 2; ++ai)
#pragma unroll
            for (int m = 0; m < 4; ++m) { const int row = row0 + ai * HALF + m * 16; const size_t off = (size_t)row * ldc + col0; float s = 0.f;
                const float nr = -1.4426950408889634f / sqrtf(ssq_in[row] * inv_n + eps);
#pragma unroll
                for (int bj = 0; bj < 2; ++bj) {
                    const u32x4 ew = *(const u32x4*)(E + off + bj * HALF);
                    f32x4 h0 = *(const f32x4*)(out + off + bj * HALF), h1 = *(const f32x4*)(out + off + bj * HALF + 4);
                    const f32x4 a0 = acc[ai][bj][m][0], a1 = acc[ai][bj][m][1];
                    const float e0[4] = {bf_lo(ew.x), bf_hi(ew.x), bf_lo(ew.y), bf_hi(ew.y)}, e1[4] = {bf_lo(ew.z), bf_hi(ew.z), bf_lo(ew.w), bf_hi(ew.w)};
#pragma unroll
                    for (int e = 0; e < 4; ++e) {
                        h0[e] += __builtin_amdgcn_rcpf(1.0f + __builtin_amdgcn_exp2f(nr * a0[e])) * e0[e];
                        h1[e] += __builtin_amdgcn_rcpf(1.0f + __builtin_amdgcn_exp2f(nr * a1[e])) * e1[e]; }
                    *(f32x4*)(out + off + bj * HALF) = h0; *(f32x4*)(out + off + bj * HALF + 4) = h1;
                    s += (h0[0] * h0[0] + h0[1] * h0[1]) + (h0[2] * h0[2] + h0[3] * h0[3]) + (h1[0] * h1[0] + h1[1] * h1[1]) + (h1[2] * h1[2] + h1[3] * h1[3]); }
                s += __shfl_xor(s, 16); s += __shfl_xor(s, 32);
                if (fq == 0) atomicAdd(ssq_out + row, s);
                if (m & 1) asm volatile("" ::: "memory"); }
    }
};
template <class Epi, class Sched, bool ALIGN_EPI = false, bool SP2 = false>
__device__ __forceinline__ void gemm_phase(PG8_LAS unsigned char* lds, const Gemm g, const Sched& S, const Epi& E) {
    const int tid = threadIdx.x, wid = __builtin_amdgcn_readfirstlane(tid >> 6), lane = tid & 63, wr = wid >> 2, wc = wid & 3, fr = lane & 15, fq = lane >> 4;
    const int K = g.K, nt = K / BK;
    unsigned voffA[2], voffB[2];
#pragma unroll
    for (int i = 0; i < 2; ++i) { int R, C; stage_rc(tid * 16 + i * 8192, R, C); const int Rb = Epi::PERM ? ((R & ~31) + perm32(R & 31)) : R;
        voffA[i] = (unsigned)(R * K + C) * 2u; voffB[i] = (unsigned)(Rb * K + C) * 2u; }
    const size_t kstep = (size_t)(BK * 2);
    const size_t hstep = (size_t)HALF * K * 2;
    const size_t tstep = 2 * hstep;
    const unsigned ldsw = (unsigned)wid * 1024u;
    const int aoff = lds_byte(wr * 64 + fr, fq * 8), boff = lds_byte(wc * 32 + fr, fq * 8);
#define PG8_SA(b, h) (((b) * 2 + (h)) * HTB)
#define PG8_SB(b, h) ((4 + (b) * 2 + (h)) * HTB)
#define PG8_STAGE(bufoff, gbase, voff) do { _Pragma("unroll") for (int _i = 0; _i < 2; ++_i) \
        __builtin_amdgcn_global_load_lds((const unsigned*)((const char*)(gbase) + (voff)[_i]), (PG8_LAS unsigned*)(lds + (bufoff) + ldsw + _i * 8192), 16, 0, 0); } while (0)
#define PG8_LDA(dst, b, h) do { _Pragma("unroll") for (int m = 0; m < 4; ++m) _Pragma("unroll") for (int k = 0; k < 2; ++k) dst[m][k] = *(const PG8_LAS bf16x8*)(lds + PG8_SA(b, h) + aoff + m * 2048 + k * 1024); } while (0)
#define PG8_LDB(dst, b, h) do { _Pragma("unroll") for (int n = 0; n < 2; ++n) _Pragma("unroll") for (int k = 0; k < 2; ++k) dst[n][k] = *(const PG8_LAS bf16x8*)(lds + PG8_SB(b, h) + boff + n * 2048 + k * 1024); } while (0)
#define PG8_MMA(ai, bj, At, Bt) do { __builtin_amdgcn_s_setprio(1); _Pragma("unroll") for (int m = 0; m < 4; ++m) _Pragma("unroll") for (int n = 0; n < 2; ++n) _Pragma("unroll") for (int k = 0; k < 2; ++k) \
        acc[ai][bj][m][n] = __builtin_amdgcn_mfma_f32_16x16x32_bf16(Bt[n][k], At[m][k], acc[ai][bj][m][n], 0, 0, 0); __builtin_amdgcn_s_setprio(0); } while (0)
#define PG8_WAIT_V(n) asm volatile("s_waitcnt vmcnt(" #n ")" ::: "memory")
#define PG8_WAIT_L(n) asm volatile("s_waitcnt lgkmcnt(" #n ")" ::: "memory")
#define PG8_BAR __builtin_amdgcn_s_barrier()
#define PG8_SCHED __builtin_amdgcn_sched_barrier(0)
    Unit cur, nxt; int ui = 0;
    if (!S.next(0, cur)) return;
    f32x4 acc[2][2][4][2];
#pragma unroll
    for (int a = 0; a < 2; ++a)
#pragma unroll
        for (int b = 0; b < 2; ++b)
#pragma unroll
            for (int m = 0; m < 4; ++m)
#pragma unroll
                for (int n = 0; n < 2; ++n) acc[a][b][m][n] = (f32x4){0.f, 0.f, 0.f, 0.f};
    bf16x8 At[4][2], B0[2][2], B1[2][2];
    const char* cA = (const char*)g.A + (size_t)cur.pm * tstep; const char* cB = (const char*)g.Bt + (size_t)cur.pn * tstep;
    S.a_ready(cur);
    if constexpr (SP2) {
        PG8_STAGE(PG8_SB(0, 0), cB, voffB); PG8_STAGE(PG8_SB(0, 1), cB + hstep, voffB); PG8_STAGE(PG8_SA(0, 0), cA, voffA); PG8_STAGE(PG8_SA(0, 1), cA + hstep, voffA);
        if (wr == 1) PG8_BAR;
        PG8_WAIT_V(2); PG8_BAR;
        PG8_STAGE(PG8_SB(1, 0), cB + kstep, voffB); PG8_STAGE(PG8_SA(1, 0), cA + kstep, voffA); PG8_STAGE(PG8_SB(1, 1), cB + hstep + kstep, voffB);
        PG8_WAIT_V(6); PG8_BAR;
    } else {
        PG8_STAGE(PG8_SB(0, 0), cB, voffB); PG8_STAGE(PG8_SA(0, 0), cA, voffA); PG8_STAGE(PG8_SB(0, 1), cB + hstep, voffB); PG8_STAGE(PG8_SA(0, 1), cA + hstep, voffA);
        if (wr == 1) PG8_BAR;
        PG8_WAIT_V(4); PG8_BAR;
        PG8_STAGE(PG8_SB(1, 0), cB + kstep, voffB); PG8_STAGE(PG8_SA(1, 0), cA + kstep, voffA); PG8_STAGE(PG8_SB(1, 1), cB + hstep + kstep, voffB);
        PG8_WAIT_V(6); PG8_BAR;
    }
    for (;;) {
        const bool has_next = S.next(ui + 1, nxt);
        const char* nA = has_next ? (const char*)g.A + (size_t)nxt.pm * tstep : cA; const char* nB = has_next ? (const char*)g.Bt + (size_t)nxt.pn * tstep : cB;
        for (int t = 0; t < nt; t += 2) {
            const bool last = (t == nt - 2);
            const char* a1 = cA + (size_t)(t + 1) * kstep;
            const char* a2 = last ? nA : cA + (size_t)(t + 2) * kstep; const char* b2 = last ? nB : cB + (size_t)(t + 2) * kstep;
            const char* a3 = a2 + kstep; const char* b3 = b2 + kstep;
            if (last && has_next) S.a_ready(nxt);
            if constexpr (SP2) {
            PG8_LDB(B0, 0, 0); PG8_LDB(B1, 0, 1); PG8_SCHED; PG8_LDA(At, 0, 0); PG8_STAGE(PG8_SA(1, 1), a1 + hstep, voffA);
            PG8_WAIT_V(8); PG8_WAIT_L(0); PG8_BAR; PG8_MMA(0, 0, At, B0); PG8_MMA(0, 1, At, B1); PG8_BAR; PG8_SCHED;
            PG8_LDA(At, 0, 1); PG8_STAGE(PG8_SB(0, 0), b2, voffB); PG8_STAGE(PG8_SB(0, 1), b2 + hstep, voffB); PG8_STAGE(PG8_SA(0, 0), a2, voffA);
            PG8_WAIT_V(8); PG8_WAIT_L(0); PG8_BAR; PG8_MMA(1, 0, At, B0); PG8_MMA(1, 1, At, B1); PG8_BAR; PG8_SCHED;
            PG8_LDB(B0, 1, 0); PG8_LDB(B1, 1, 1); PG8_SCHED; PG8_LDA(At, 1, 0); PG8_STAGE(PG8_SA(0, 1), a2 + hstep, voffA);
            PG8_WAIT_V(8); PG8_WAIT_L(0); PG8_BAR; PG8_MMA(0, 0, At, B0); PG8_MMA(0, 1, At, B1); PG8_BAR; PG8_SCHED;
            PG8_LDA(At, 1, 1); PG8_STAGE(PG8_SB(1, 0), b3, voffB); PG8_STAGE(PG8_SB(1, 1), b3 + hstep, voffB); PG8_STAGE(PG8_SA(1, 0), a3, voffA);
            PG8_WAIT_V(8); PG8_WAIT_L(0); PG8_BAR; PG8_MMA(1, 0, At, B0); PG8_MMA(1, 1, At, B1); PG8_BAR; PG8_SCHED;
            } else {
            PG8_LDB(B0, 0, 0); PG8_SCHED; PG8_LDA(At, 0, 0); PG8_STAGE(PG8_SA(1, 1), a1 + hstep, voffA);
            PG8_WAIT_L(8); PG8_BAR; PG8_WAIT_L(0); PG8_MMA(0, 0, At, B0); PG8_BAR; PG8_SCHED;
            PG8_LDB(B1, 0, 1); PG8_STAGE(PG8_SB(0, 0), b2, voffB);
            PG8_BAR; PG8_WAIT_L(0); PG8_MMA(0, 1, At, B1); PG8_BAR;
            PG8_LDA(At, 0, 1); PG8_STAGE(PG8_SA(0, 0), a2, voffA);
            PG8_BAR; PG8_WAIT_L(0); PG8_MMA(1, 0, At, B0); PG8_BAR; PG8_SCHED;
            PG8_STAGE(PG8_SB(0, 1), b2 + hstep, voffB);
            PG8_WAIT_V(6); PG8_BAR; PG8_MMA(1, 1, At, B1); PG8_BAR;
            PG8_LDB(B0, 1, 0); PG8_SCHED; PG8_LDA(At, 1, 0); PG8_STAGE(PG8_SA(0, 1), a2 + hstep, voffA);
            PG8_WAIT_L(8); PG8_BAR; PG8_WAIT_L(0); PG8_MMA(0, 0, At, B0); PG8_BAR; PG8_SCHED;
            PG8_LDB(B1, 1, 1); PG8_STAGE(PG8_SB(1, 0), b3, voffB);
            PG8_BAR; PG8_WAIT_L(0); PG8_MMA(0, 1, At, B1); PG8_BAR;
            PG8_LDA(At, 1, 1); PG8_STAGE(PG8_SA(1, 0), a3, voffA);
            PG8_BAR; PG8_WAIT_L(0); PG8_MMA(1, 0, At, B0); PG8_BAR; PG8_SCHED;
            PG8_STAGE(PG8_SB(1, 1), b3 + hstep, voffB);
            PG8_WAIT_V(6); PG8_BAR; PG8_MMA(1, 1, At, B1); PG8_BAR;
            }
        }
        if constexpr (ALIGN_EPI) { if (wr == 0) PG8_BAR; }
        if constexpr (!Epi::AFTER_DRAIN) { E(acc, cur, wr, wc, fr, fq); S.done(cur); }
        if (!has_next) break;
#pragma unroll
        for (int a = 0; a < 2; ++a)
#pragma unroll
            for (int b = 0; b < 2; ++b)
#pragma unroll
                for (int m = 0; m < 4; ++m)
#pragma unroll
                    for (int n = 0; n < 2; ++n) acc[a][b][m][n] = (f32x4){0.f, 0.f, 0.f, 0.f};
        cur = nxt; cA = nA; cB = nB; ++ui;
        if constexpr (ALIGN_EPI) { if (wr == 1) PG8_BAR; }
    }
    PG8_WAIT_V(0);
    if constexpr (!ALIGN_EPI) { if (wr == 0) PG8_BAR; }
    PG8_BAR;
    if constexpr (Epi::AFTER_DRAIN) { E.fused(acc, cur, wr, wc, fr, fq, lds, wid, lane); S.done(cur); }
#undef PG8_SA
#undef PG8_SB
#undef PG8_STAGE
#undef PG8_LDA
#undef PG8_LDB
#undef PG8_MMA
#undef PG8_WAIT_V
#undef PG8_WAIT_L
#undef PG8_BAR
#undef PG8_SCHED
}
}
constexpr int NWAVES = 8;
constexpr int NB = 4, SEQ = 4096, DM = 4096, M = NB * SEQ, DIN = 10240, DFF = 16384, PLE = 256, AW = 2048, NH = 16, HD = 128, CH = 128;
constexpr float EPS = 1e-6f;
constexpr float QSCALE = 0.08838834764831845f;
constexpr size_t MiB = 1u << 20;
constexpr size_t WS_CTL = 0, CTL_ZERO_BYTES = 256 * 1024;
constexpr size_t WS_PBF = 1 * MiB;
constexpr size_t WS_WSB = 9 * MiB;
constexpr size_t WS_WIN = 10 * MiB, WS_WOUT = WS_WIN + 80 * MiB, WS_WUP = WS_WOUT + 32 * MiB, WS_WDN = WS_WUP + 128 * MiB, WS_WGT = WS_WDN + 128 * MiB, WS_WPJ = WS_WGT + 32 * MiB;
constexpr size_t WS_ACT = WS_WPJ + 2 * MiB;
constexpr size_t WS_Z = WS_ACT + 128 * MiB;
constexpr size_t WS_HID = WS_ACT;
constexpr size_t WS_HG = WS_ACT + 512 * MiB;
constexpr size_t WS_END = WS_HG + 128 * MiB;
static_assert(WS_Z + (size_t)M * DIN * 2 <= WS_HG && WS_HID + (size_t)M * DFF * 2 <= WS_HG && WS_WPJ + (size_t)DM * PLE * 2 <= WS_ACT && WS_PBF + (size_t)M * PLE * 2 <= WS_WSB, "d_ws map");
constexpr int CW_TMO = 0, CW_CODE = 1;
constexpr int CW_BAR = 4096;
constexpr int CW_SSQ1 = 16384, CW_SSQ2 = 32768, CW_SSQ3 = 49152;
static_assert((CW_SSQ3 + M) * 4 <= (int)CTL_ZERO_BYTES, "CTL words inside the memset region");
constexpr int RING_OFF = 0, RING_BYTES = 131072;
constexpr int LDSCTL_OFF = RING_BYTES, MISC_OFF = LDSCTL_OFF + 320;
constexpr int LDS_BYTES = 147456;
static_assert(MISC_OFF + 128 <= LDS_BYTES, "LDS map");

#define GAS __attribute__((address_space(1)))
#define LAS __attribute__((address_space(3)))
typedef unsigned short bf16;
typedef unsigned v4u __attribute__((ext_vector_type(4)));
typedef float f32x4 __attribute__((ext_vector_type(4)));
typedef short bf16x8 __attribute__((ext_vector_type(8)));
typedef GAS unsigned gu32;
typedef GAS unsigned long long gu64;
#define RLX_AGENT __ATOMIC_RELAXED, __HIP_MEMORY_SCOPE_AGENT
#define LDS_WAIT() asm volatile("s_waitcnt lgkmcnt(0)" ::: "memory")
#define VM_WAIT() asm volatile("s_waitcnt vmcnt(0)" ::: "memory")
__device__ __forceinline__ unsigned long long rt() { return __builtin_amdgcn_s_memrealtime(); }
__device__ __forceinline__ unsigned f2bf(float f) { unsigned u = __builtin_bit_cast(unsigned, f); return (u + 0x7fffu + ((u >> 16) & 1u)) >> 16; }
__device__ __forceinline__ unsigned pk2(float lo, float hi) { return f2bf(lo) | (f2bf(hi) << 16); }
#define XB_TMO      128
#define XB_XCNT(j)  (256  + 64 * (j))
#define XB_XSUB(j)  (1280 + 64 * (j))
#define XB_XGEN(j)  (2304 + 64 * (j))
#define XB_TOP      3328
#define XB_TOPGEN   3392
#define XCD_BAR_WORDS 3456
#define XB_SPIN_CAP (1u << 18)

__device__ __forceinline__ unsigned xb_ld(unsigned* p)              { return __hip_atomic_load(p, __ATOMIC_RELAXED, __HIP_MEMORY_SCOPE_AGENT); }
__device__ __forceinline__ unsigned xb_add(unsigned* p, unsigned v) { return __hip_atomic_fetch_add(p, v, __ATOMIC_RELAXED, __HIP_MEMORY_SCOPE_AGENT); }
__device__ __forceinline__ unsigned xb_xcc_id() { return (unsigned)__builtin_amdgcn_s_getreg((3 << 11) | 20) & 0xFu; }
#define XB_SPIN(cond, bar) do { unsigned _sp = 0; while (cond) { __builtin_amdgcn_s_sleep(1); \
    if ((++_sp & 255u) == 0u) { if (xb_ld(&(bar)[XB_TMO])) break; if (_sp > XB_SPIN_CAP) { atomicAdd(&(bar)[XB_TMO], 1u); break; } } } } while (0)

struct XcdBarrier {
    unsigned* bar; unsigned x;
    volatile LAS unsigned* st;
};

__device__ __forceinline__ XcdBarrier xcd_barrier_post(unsigned* bar, volatile LAS unsigned* st) {
    XcdBarrier b; b.bar = bar; b.x = xb_xcc_id(); b.st = st;
    if (threadIdx.x == 0) (void)xb_add(&bar[XB_XCNT(b.x)], 1u);
    return b;
}
__device__ __forceinline__ void xcd_barrier_complete(unsigned* bar, unsigned x, unsigned& nloc, unsigned& nx) {
    const unsigned G = gridDim.x * gridDim.y * gridDim.z;
    unsigned sum, cnt, mine, sp = 0u;
    for (;;) {
        sum = 0u; cnt = 0u; mine = 0u;
#pragma unroll
        for (unsigned j = 0; j < 16; ++j) { const unsigned c = xb_ld(&bar[XB_XCNT(j)]); sum += c; cnt += (c > 0u) ? 1u : 0u; mine = (j == x) ? c : mine; }
        if (sum == G) break;
        __builtin_amdgcn_s_sleep(1);
        if ((++sp & 255u) == 0u) { if (xb_ld(&bar[XB_TMO])) break; if (sp > XB_SPIN_CAP) { atomicAdd(&bar[XB_TMO], 1u); break; } }
    }
    nloc = mine > 0u ? mine : 1u; nx = cnt > 0u ? cnt : 1u;
}

__device__ __forceinline__ void xcd_barrier(const XcdBarrier& b) {
    asm volatile("s_waitcnt vmcnt(0)" ::: "memory");
    __syncthreads();
    if (threadIdx.x == 0) {
        unsigned* bar = b.bar;
        __builtin_amdgcn_s_waitcnt(0);
        unsigned nloc = b.st[0], nx = b.st[1];
        if (nloc == 0u) { xcd_barrier_complete(bar, b.x, nloc, nx); b.st[0] = nloc; b.st[1] = nx; }
        const unsigned old = xb_add(&bar[XB_XSUB(b.x)], 1u);
        const unsigned gen = old / nloc;
        if (old + 1u == (gen + 1u) * nloc) {
            __builtin_amdgcn_fence(__ATOMIC_RELEASE, "agent");
            asm volatile("s_waitcnt vmcnt(0)" ::: "memory");
            const unsigned og = xb_add(&bar[XB_TOP], 1u);
            const unsigned tg = og / nx;
            if (og + 1u == (tg + 1u) * nx) xb_add(&bar[XB_TOPGEN], 1u);
            else XB_SPIN(xb_ld(&bar[XB_TOPGEN]) == tg, bar);
            __builtin_amdgcn_fence(__ATOMIC_ACQUIRE, "agent");
            xb_add(&bar[XB_XGEN(b.x)], 1u);
            asm volatile("s_waitcnt vmcnt(0)" ::: "memory");
        } else {
            XB_SPIN(xb_ld(&bar[XB_XGEN(b.x)]) == gen, bar);
            __builtin_amdgcn_fence(__ATOMIC_ACQUIRE, "agent");
            asm volatile("s_waitcnt vmcnt(0)" ::: "memory");
        }
    }
    __syncthreads();
}

struct Frame {
    LAS unsigned char* lds;
    volatile LAS unsigned* MISC;
    gu32* ctl;
    int tid, lane, wave;
    int vcu, G;
};
__device__ __forceinline__ float wave_sum(float v) {
#pragma unroll
    for (int o = 1; o < 64; o <<= 1) v += __shfl_xor(v, o);
    return v;
}
__device__ __forceinline__ float bf2f(unsigned short h) { return __builtin_bit_cast(float, (unsigned)h << 16); }
__device__ __forceinline__ void p0_transpose_item(const float* W, int K, int N, bf16* WT, LAS float* scr, int item, int lane) {
    const int nblk = N / 32, kb = item / nblk, nb = item % nblk, k0 = 64 * kb, n0 = 32 * nb;
#pragma unroll 8
    for (int i = 0; i < 32; ++i) { const int kk = 2 * i + (lane >> 5); scr[kk * 33 + (lane & 31)] = W[(size_t)(k0 + kk) * N + n0 + (lane & 31)]; }
    LDS_WAIT(); asm volatile("" ::: "memory");
    const int c = lane & 7;
#pragma unroll
    for (int j = 0; j < 4; ++j) { const int n = (lane >> 3) + 8 * j; const LAS float* s = scr + (8 * c) * 33 + n;
        v4u o; o.x = pk2(s[0 * 33], s[1 * 33]); o.y = pk2(s[2 * 33], s[3 * 33]); o.z = pk2(s[4 * 33], s[5 * 33]); o.w = pk2(s[6 * 33], s[7 * 33]);
        *(GAS v4u*)(WT + (size_t)(n0 + n) * K + k0 + 8 * c) = o; }
    LDS_WAIT(); asm volatile("" ::: "memory");
}
__device__ __forceinline__ void rms_row_to_bf16(int lane, const float* xrow, const float* g, bf16* orow) {
    const GAS f32x4* xr = (const GAS f32x4*)xrow + lane; const GAS f32x4* gr = (const GAS f32x4*)g + lane;
    f32x4 v[16]; float s = 0.f;
#pragma unroll
    for (int j = 0; j < 16; ++j) { v[j] = xr[64 * j]; s += (v[j].x * v[j].x + v[j].y * v[j].y) + (v[j].z * v[j].z + v[j].w * v[j].w); }
    const float rstd = 1.f / sqrtf(wave_sum(s) * (1.f / DM) + EPS);
    GAS unsigned long long* o8 = (GAS unsigned long long*)orow + lane;
#pragma unroll
    for (int j = 0; j < 16; ++j) { const f32x4 gg = gr[64 * j];
        o8[64 * j] = (unsigned long long)pk2(v[j].x * rstd * gg.x, v[j].y * rstd * gg.y) | ((unsigned long long)pk2(v[j].z * rstd * gg.z, v[j].w * rstd * gg.w) << 32); }
}
__device__ __forceinline__ void final_row(int lane, float* xrow, const float* g, float ssq) {
    GAS f32x4* xr = (GAS f32x4*)xrow + lane; const GAS f32x4* gr = (const GAS f32x4*)g + lane;
    const float rstd = 1.f / sqrtf(ssq * (1.f / DM) + EPS);
#pragma unroll
    for (int j = 0; j < 16; ++j) { f32x4 v = xr[64 * j]; const f32x4 gg = gr[64 * j]; v = v * rstd * gg; xr[64 * j] = v; }
}

__device__ __forceinline__ float gelu_tanh(float x) { const float y = 0.7978845608028654f * (x + 0.044715f * x * x * x); return x / (1.0f + __expf(-2.0f * y)); }
__device__ __forceinline__ void sgu_unit_naive(bool active, int unit, int t256, LAS float* vn, const bf16* z, const float* ws, const float* bs, const float* ga, bf16* y) {
    const int h = unit % NH, nc = (unit / NH) % (SEQ / CH), b = unit / (NH * (SEQ / CH));
    const int t = t256 >> 1, half = t256 & 1;
    const size_t row = (size_t)b * SEQ + nc * CH + t;
    float mu = 0.f, rs = 0.f;
    if (active) {
        const bf16* vr = z + row * DIN + AW + h * HD + half * 64;
        float s1 = 0.f;
        for (int j = 0; j < 64; ++j) { const float gv = gelu_tanh(bf2f(vr[j])); vn[t * 128 + half * 64 + j] = gv; s1 += gv; }
        s1 += __shfl_xor(s1, 1);
        mu = s1 * (1.0f / 128.0f);
        float s2 = 0.f;
        for (int j = 0; j < 64; ++j) { const float d = vn[t * 128 + half * 64 + j] - mu; s2 += d * d; }
        s2 += __shfl_xor(s2, 1);
        rs = 1.0f / sqrtf(s2 * (1.0f / 128.0f) + EPS);
        for (int j = 0; j < 64; ++j) vn[t * 128 + half * 64 + j] = (vn[t * 128 + half * 64 + j] - mu) * rs;
    }
    __syncthreads();
    if (active) {
        float acc[64];
#pragma unroll
        for (int j = 0; j < 64; ++j) acc[j] = 0.f;
        const float* wr = ws + ((size_t)h * CH + t) * CH;
        for (int s = 0; s <= t; ++s) { const float wv = wr[s];
#pragma unroll
            for (int j = 0; j < 64; ++j) acc[j] += wv * vn[s * 128 + half * 64 + j]; }
        const float bias = bs[h * CH + t];
        const bf16* ur = z + row * DIN + h * HD + half * 64;
        float ss = 0.f;
#pragma unroll
        for (int j = 0; j < 64; ++j) { const float u = gelu_tanh(bf2f(ur[j])); acc[j] = u * (acc[j] + bias); ss += acc[j] * acc[j]; }
        ss += __shfl_xor(ss, 1);
        const float r = 1.0f / sqrtf(ss * (1.0f / 128.0f) + EPS);
#pragma unroll
        for (int j = 0; j < 64; ++j) y[row * DM + h * HD + half * 64 + j] = (bf16)f2bf(acc[j] * r * ga[h * HD + half * 64 + j]);
    }
    __syncthreads();
}
__device__ __forceinline__ void attn_row_naive(int gi, int lane, LAS float* qs, const bf16* z, const float* gb, bf16* y) {
    const int t = gi % SEQ, h = (gi / SEQ) % NH, b = gi / (SEQ * NH);
    const size_t rowq = (size_t)b * SEQ + t;
    { const bf16* qr = z + rowq * DIN + 2 * AW + h * HD; qs[lane] = bf2f(qr[lane]) * QSCALE; qs[lane + 64] = bf2f(qr[lane + 64]) * QSCALE; }
    LDS_WAIT(); asm volatile("" ::: "memory");
    float o0 = 0.f, o1 = 0.f, L = 0.f;
    for (int c = 0; 64 * c < t; ++c) {
        const int s = t - 1 - (64 * c + lane); const bool valid = s >= 0;
        float zz = 0.f;
        if (valid) { const bf16* kr = z + ((size_t)b * SEQ + s) * DIN + 2 * AW + AW + h * HD;
            for (int d8 = 0; d8 < 16; ++d8) { const bf16x8 kv = *(const bf16x8*)(kr + d8 * 8);
#pragma unroll
                for (int j = 0; j < 8; ++j) zz += qs[d8 * 8 + j] * bf2f((unsigned short)kv[j]); } }
        const float sp = fmaxf(zz, 0.f) + log1pf(__expf(-fabsf(zz)));
        const float lk = valid ? -sp : 0.f, ls = zz - sp;
        float inc = lk;
#pragma unroll
        for (int off = 1; off < 64; off <<= 1) { const float v = __shfl_up(inc, off); if (lane >= off) inc += v; }
        const float a = valid ? __expf(ls + L + (inc - lk)) : 0.f;
        L += __shfl(inc, 63);
        const int nk = (t - 64 * c) < 64 ? (t - 64 * c) : 64;
        for (int i = 0; i < nk; ++i) { const float ai = __shfl(a, i); const int si = t - 1 - (64 * c + i);
            const unsigned vv = *(const unsigned*)(z + ((size_t)b * SEQ + si) * DIN + 2 * AW + 2 * AW + h * HD + 2 * lane);
            o0 += ai * bf2f((unsigned short)(vv & 0xffffu)); o1 += ai * bf2f((unsigned short)(vv >> 16)); }
        if (L < -104.0f) break;
    }
    float ss = wave_sum(o0 * o0 + o1 * o1);
    const float r = 1.0f / sqrtf(ss * (1.0f / 128.0f) + EPS);
    const unsigned pk = f2bf(o0 * r * gb[h * HD + 2 * lane]) | (f2bf(o1 * r * gb[h * HD + 2 * lane + 1]) << 16);
    *(unsigned*)(y + rowq * DM + AW + h * HD + 2 * lane) = pk;
    LDS_WAIT(); asm volatile("" ::: "memory");
}

constexpr int N_PHASES = 9;
struct Args { const float* in[16]; float* out; unsigned char* ws; int ph_lo, ph_hi; };
__global__ void __launch_bounds__(NWAVES * 64, 2) mk_fwd(Args args) {
    extern __shared__ __attribute__((aligned(16))) unsigned char lds[];
    Frame F;
    F.lds = (LAS unsigned char*)lds;
    F.MISC = (volatile LAS unsigned*)(F.lds + MISC_OFF);
    F.tid = threadIdx.x; F.lane = F.tid & 63; F.wave = __builtin_amdgcn_readfirstlane(F.tid >> 6);
    F.G = gridDim.x; { const int bx = blockIdx.x; F.vcu = (F.G % 8 == 0) ? (bx % 8) * (F.G / 8) + bx / 8 : bx; }
    unsigned char* ws = args.ws;
    F.ctl = (gu32*)(ws + WS_CTL);
    const float* x = args.in[0]; const float* p = args.in[1]; const float* norm_mix = args.in[2]; const float* w_in = args.in[3];
    const float* w_s = args.in[4]; const float* b_s = args.in[5]; const float* norm_a = args.in[6]; const float* norm_b = args.in[7];
    const float* w_out = args.in[8]; const float* norm_ffn = args.in[9]; const float* w_up = args.in[10]; const float* w_down = args.in[11];
    const float* norm_ple = args.in[12]; const float* w_gate = args.in[13]; const float* w_proj = args.in[14]; const float* norm_final = args.in[15];
    float* out = args.out;
    bf16* PBF = (bf16*)(ws + WS_PBF);
    bf16 *Wi = (bf16*)(ws + WS_WIN), *Wo = (bf16*)(ws + WS_WOUT), *Wu = (bf16*)(ws + WS_WUP), *Wd = (bf16*)(ws + WS_WDN), *Wg = (bf16*)(ws + WS_WGT), *Wp = (bf16*)(ws + WS_WPJ);
    bf16 *ACT = (bf16*)(ws + WS_ACT), *Z = (bf16*)(ws + WS_Z), *HID = (bf16*)(ws + WS_HID), *HG = (bf16*)(ws + WS_HG);
    float* ssq1 = (float*)(ws + WS_CTL) + CW_SSQ1; float* ssq2 = (float*)(ws + WS_CTL) + CW_SSQ2; float* ssq3 = (float*)(ws + WS_CTL) + CW_SSQ3;
    for (int u = F.tid; u < (LDS_BYTES - LDSCTL_OFF) / 4; u += NWAVES * 64) ((LAS unsigned*)(F.lds + LDSCTL_OFF))[u] = 0u;
    __syncthreads();
    const int lo = args.ph_lo, hi = args.ph_hi;
    const bool one_launch = (lo == 0 && hi == N_PHASES);
    XcdBarrier bar; bar.bar = (unsigned*)(F.ctl + CW_BAR); bar.x = 0; bar.st = nullptr;
    if (one_launch) bar = xcd_barrier_post((unsigned*)(F.ctl + CW_BAR), F.MISC + 8);
#define IN(k) (lo <= (k) && (k) < hi)
#define GRID_BAR(k) do { if (IN(k) && IN((k) + 1)) xcd_barrier(bar); } while (0)
    const int gw = F.vcu * NWAVES + F.wave, NGW = F.G * NWAVES;

    if (IN(0)) {
        LAS float* scr = (LAS float*)(F.lds + RING_OFF + F.wave * 16384);
        constexpr int I_IN = (DM / 64) * (DIN / 32), I_OUT = (DM / 64) * (DM / 32), I_UP = (DM / 64) * (DFF / 32), I_DN = (DFF / 64) * (DM / 32), I_GT = I_OUT, I_PJ = (PLE / 64) * (DM / 32);
        constexpr int NITEMS = I_IN + I_OUT + I_UP + I_DN + I_GT + I_PJ;
        for (int it = gw; it < NITEMS; it += NGW) {
            int r = it;
            if (r < I_IN) { p0_transpose_item(w_in, DM, DIN, Wi, scr, r, F.lane); continue; } r -= I_IN;
            if (r < I_OUT) { p0_transpose_item(w_out, DM, DM, Wo, scr, r, F.lane); continue; } r -= I_OUT;
            if (r < I_UP) { p0_transpose_item(w_up, DM, DFF, Wu, scr, r, F.lane); continue; } r -= I_UP;
            if (r < I_DN) { p0_transpose_item(w_down, DFF, DM, Wd, scr, r, F.lane); continue; } r -= I_DN;
            if (r < I_GT) { p0_transpose_item(w_gate, DM, DM, Wg, scr, r, F.lane); continue; } r -= I_GT;
            p0_transpose_item(w_proj, PLE, DM, Wp, scr, r, F.lane);
        }
        for (int i = gw; i < M * PLE / 256; i += NGW) {
            const f32x4 v = ((const GAS f32x4*)p)[(size_t)i * 64 + F.lane];
            ((GAS unsigned long long*)PBF)[(size_t)i * 64 + F.lane] = (unsigned long long)pk2(v.x, v.y) | ((unsigned long long)pk2(v.z, v.w) << 32); }
        for (int m = gw; m < M; m += NGW) rms_row_to_bf16(F.lane, x + (size_t)m * DM, norm_mix, ACT + (size_t)m * DM);
    }
    GRID_BAR(0);
    if (IN(1)) {
        pg8::Gemm g{ACT, Wi, M, DIN, DM}; pg8::StaticOrder S; S.init(M, DIN, F.G, (int)blockIdx.x);
        pg8::EpiInProj E{Z, DIN, 0, 0, 1.0f};
        pg8::gemm_phase<pg8::EpiInProj, pg8::StaticOrder, true, true>(F.lds + RING_OFF, g, S, E);
    }
    GRID_BAR(1);
    if (IN(2)) {
        const int hw = F.tid >> 8, t256 = F.tid & 255; LAS float* vn = (LAS float*)(F.lds + RING_OFF + hw * 65536);
        constexpr int NSGU = NB * (SEQ / CH) * NH;
        for (int it = 0; it * (2 * F.G) < NSGU; ++it) { const int unit = it * (2 * F.G) + 2 * (int)blockIdx.x + hw;
            sgu_unit_naive(unit < NSGU, unit < NSGU ? unit : 0, t256, vn, Z, w_s, b_s, norm_a, ACT); }
        LAS float* qs = (LAS float*)(F.lds + RING_OFF + F.wave * 512);
        for (int gi = (int)blockIdx.x * NWAVES + F.wave; gi < M * NH; gi += NGW) attn_row_naive(gi, F.lane, qs, Z, norm_b, ACT);
    }
    GRID_BAR(2);
    if (IN(3)) {
        pg8::Gemm g{ACT, Wo, M, DM, DM}; pg8::StaticOrder S; S.init(M, DM, F.G, (int)blockIdx.x);
        pg8::EpiResNorm E{x, out, HG, norm_ffn, ssq1, DM};
        pg8::gemm_phase<pg8::EpiResNorm, pg8::StaticOrder, true, true>(F.lds + RING_OFF, g, S, E);
    }
    GRID_BAR(3);
    if (IN(4)) {
        pg8::Gemm g{HG, Wu, M, DFF, DM}; pg8::StaticOrder S; S.init(M, DFF, F.G, (int)blockIdx.x);
        pg8::EpiUp E{HID, DFF, ssq1, 1.0f / DM, EPS};
        pg8::gemm_phase<pg8::EpiUp, pg8::StaticOrder, true, true>(F.lds + RING_OFF, g, S, E);
    }
    GRID_BAR(4);
    if (IN(5)) {
        pg8::Gemm g{HID, Wd, M, DM, DFF}; pg8::StaticOrder S; S.init(M, DM, F.G, (int)blockIdx.x);
        pg8::EpiResNorm E{out, out, HG, norm_ple, ssq2, DM};
        pg8::gemm_phase<pg8::EpiResNorm, pg8::StaticOrder, true, true>(F.lds + RING_OFF, g, S, E);
    }
    GRID_BAR(5);
    if (IN(6)) {
        pg8::Gemm g{PBF, Wp, M, DM, PLE}; pg8::StaticOrder S; S.init(M, DM, F.G, (int)blockIdx.x);
        pg8::EpiPlainBf16 E{ACT, DM};
        pg8::gemm_phase<pg8::EpiPlainBf16, pg8::StaticOrder, true, true>(F.lds + RING_OFF, g, S, E);
        VM_WAIT(); __syncthreads();
    }
    if (IN(7)) {
        pg8::Gemm g{HG, Wg, M, DM, DM}; pg8::StaticOrder S; S.init(M, DM, F.G, (int)blockIdx.x);
        pg8::EpiGate E{out, ACT, ssq2, ssq3, DM, 1.0f / DM, EPS};
        pg8::gemm_phase<pg8::EpiGate, pg8::StaticOrder, true, true>(F.lds + RING_OFF, g, S, E);
    }
    GRID_BAR(7);
    if (IN(8)) {
        for (int m = gw; m < M; m += NGW) final_row(F.lane, out + (size_t)m * DM, norm_final, ssq3[m]);
    }
#undef IN
#undef GRID_BAR
}

#ifndef MK_PER_PHASE
#define MK_PER_PHASE 0
#endif
extern "C" void kernel_launch(void* const* d_in, const int* in_sizes, int n_in, void* d_out, int out_size, void* d_ws, size_t ws_size, hipStream_t stream) {
    static int grid = 0;
    if (grid == 0) {
        if (n_in != 16 || in_sizes[0] != M * DM || out_size != M * DM || ws_size < WS_END) { fprintf(stderr, "kernel_launch: unexpected shapes: n_in %d, in0 %d, out %d, ws %zu (need %zu); nothing launched\n", n_in, n_in > 0 ? in_sizes[0] : -1, out_size, ws_size, (size_t)WS_END); grid = -1; return; }
        int dev = 0, cus = 0, per_cu = 0;
        if (hipGetDevice(&dev) != hipSuccess || hipDeviceGetAttribute(&cus, hipDeviceAttributeMultiprocessorCount, dev) != hipSuccess) { fprintf(stderr, "kernel_launch: device query failed\n"); grid = -1; return; }
        if (hipFuncSetAttribute((const void*)mk_fwd, hipFuncAttributeMaxDynamicSharedMemorySize, LDS_BYTES) != hipSuccess) { fprintf(stderr, "kernel_launch: hipFuncSetAttribute failed\n"); grid = -1; return; }
        if (hipOccupancyMaxActiveBlocksPerMultiprocessor(&per_cu, (const void*)mk_fwd, NWAVES * 64, LDS_BYTES) != hipSuccess || per_cu < 1) { fprintf(stderr, "kernel_launch: occupancy query reports %d workgroups per CU\n", per_cu); }
        (void)hipGetLastError();
        grid = cus;
    }
    if (grid < 0) return;
    if (hipMemsetAsync((char*)d_ws + WS_CTL, 0, CTL_ZERO_BYTES, stream) != hipSuccess) { fprintf(stderr, "kernel_launch: hipMemsetAsync failed\n"); return; }
    Args a{};
    for (int i = 0; i < 16; ++i) a.in[i] = (const float*)d_in[i];
    a.out = (float*)d_out; a.ws = (unsigned char*)d_ws;
#if MK_PER_PHASE
    for (int ph = 0; ph < N_PHASES; ++ph) { a.ph_lo = ph; a.ph_hi = ph + 1; hipLaunchKernelGGL(mk_fwd, dim3(grid), dim3(NWAVES * 64), LDS_BYTES, stream, a); }
#else
    a.ph_lo = 0; a.ph_hi = N_PHASES;
    hipLaunchKernelGGL(mk_fwd, dim3(grid), dim3(NWAVES * 64), LDS_BYTES, stream, a);
#endif
    const hipError_t le = hipPeekAtLastError();
    if (le != hipSuccess) fprintf(stderr, "kernel_launch: launch failed: %s\n", hipGetErrorName(le));
}
```

```cpp
#include <hip/hip_runtime.h>
#include <cstdio>
#include <cstdint>
namespace pg8 {
#define PG8_LAS __attribute__((address_space(3)))
typedef unsigned short bf16_t;
typedef short bf16x8 __attribute__((ext_vector_type(8)));
typedef float f32x4 __attribute__((ext_vector_type(4)));
typedef unsigned u32x4 __attribute__((ext_vector_type(4)));
constexpr int BM = 256, BK = 64, HALF = 128, HTB = HALF * BK * 2  , STAGE_BYTES = 8 * HTB, NXCD = 8, WGM = 8;

__host__ __device__ __forceinline__ int lds_byte(int r, int c) { const int st = (r >> 4) * 2 + (c >> 5), rr = r & 15, cc = c & 31, ob = rr * 64 + cc * 2; return st * 1024 + (ob ^ (((ob >> 9) & 1) << 5)); }
__host__ __device__ __forceinline__ void stage_rc(int b, int& R, int& C) { const int st = b / 1024, sb = b % 1024, swz = sb ^ (((sb >> 9) & 1) << 5); R = (st >> 1) * 16 + swz / 64; C = (st & 1) * 32 + (swz % 64) / 2; }
__host__ __device__ __forceinline__ int perm32(int rho) { const int n = rho >> 4, i = rho & 15; return 8 * (i >> 2) + 4 * n + (i & 3); }

struct Unit { int pm, pn; };
struct Gemm { const bf16_t* A; const bf16_t* Bt; int M, N, K; };

struct StaticOrder {
    int nM, nN, nwg, G, c;
    __host__ __device__ void init(int M, int N, int G_, int c_) { nM = M / BM; nN = N / BM; nwg = nM * nN; G = G_; c = c_; }
    __host__ __device__ bool next(int i, Unit& u) const {
        const long L = (long)i * G + c; if (L >= nwg) return false;
        int wgid = (int)L; { const int q = nwg / NXCD, r = nwg % NXCD, xcd = wgid % NXCD, off = wgid / NXCD; wgid = (xcd < r ? xcd * (q + 1) : r * (q + 1) + (xcd - r) * q) + off; }
        const int nig = WGM * nN, gid = wgid / nig, fm = gid * WGM, gsz = (nM - fm) < WGM ? (nM - fm) : WGM;
        u.pm = fm + ((wgid % nig) % gsz); u.pn = (wgid % nig) / gsz; return true;
    }
    __device__ __forceinline__ void a_ready(const Unit&) const {}
    __device__ __forceinline__ void done(const Unit&) const {}
};

__device__ __forceinline__ unsigned cvt_pk_bf16(float lo, float hi) { unsigned r; asm volatile("v_cvt_pk_bf16_f32 %0, %1, %2" : "=v"(r) : "v"(lo), "v"(hi)); return r; }
typedef float f32x2 __attribute__((ext_vector_type(2)));
typedef unsigned u32x2 __attribute__((ext_vector_type(2)));
__device__ __forceinline__ float bf_lo(unsigned w) { return __builtin_bit_cast(float, w << 16); }
__device__ __forceinline__ float bf_hi(unsigned w) { return __builtin_bit_cast(float, w & 0xffff0000u); }
__device__ __forceinline__ float gelu_tanh_f(float x) {
    const float x2 = x * x, t = x * (-2.302208198f + (-0.1029432397f) * x2);
    return x * __builtin_amdgcn_rcpf(1.0f + __builtin_amdgcn_exp2f(t));
}
__device__ __forceinline__ u32x4 pack8(const f32x4 v0, const f32x4 v1) { u32x4 w; w.x = cvt_pk_bf16(v0[0], v0[1]); w.y = cvt_pk_bf16(v0[2], v0[3]); w.z = cvt_pk_bf16(v1[0], v1[1]); w.w = cvt_pk_bf16(v1[2], v1[3]); return w; }
struct EpiInProj {
    static constexpr bool PERM = true, AFTER_DRAIN = false;
    bf16_t* O; int ldc; int gelu_tiles, q_tiles; float qscale;
    __device__ __forceinline__ void operator()(const f32x4 (&acc)[2][2][4][2], const Unit& u, int wr, int wc, int fr, int fq) const {
        const int row0 = u.pm * BM + wr * 64 + fr, col0 = u.pn * BM + wc * 32 + 8 * fq;
        const int mode = u.pn < gelu_tiles ? 1 : (u.pn < q_tiles ? 2 : 0);
#pragma unroll
        for (int ai = 0; ai < 2; ++ai)
#pragma unroll
            for (int m = 0; m < 4; ++m) { bf16_t* rowp = O + (size_t)(row0 + ai * HALF + m * 16) * ldc + col0;
#pragma unroll
                for (int bj = 0; bj < 2; ++bj) { f32x4 v0 = acc[ai][bj][m][0], v1 = acc[ai][bj][m][1];
                    if (mode == 1) {
#pragma unroll
                        for (int e = 0; e < 4; ++e) { v0[e] = gelu_tanh_f(v0[e]); v1[e] = gelu_tanh_f(v1[e]); } }
                    else if (mode == 2) { v0 = v0 * qscale; v1 = v1 * qscale; }
                    *(u32x4*)(rowp + bj * HALF) = pack8(v0, v1); } }
    }
};
struct EpiPlainBf16 {
    static constexpr bool PERM = true, AFTER_DRAIN = false;
    bf16_t* O; int ldc;
    __device__ __forceinline__ void operator()(const f32x4 (&acc)[2][2][4][2], const Unit& u, int wr, int wc, int fr, int fq) const {
        const int row0 = u.pm * BM + wr * 64 + fr, col0 = u.pn * BM + wc * 32 + 8 * fq;
#pragma unroll
        for (int ai = 0; ai < 2; ++ai)
#pragma unroll
            for (int m = 0; m < 4; ++m) { bf16_t* rowp = O + (size_t)(row0 + ai * HALF + m * 16) * ldc + col0;
#pragma unroll
                for (int bj = 0; bj < 2; ++bj) *(u32x4*)(rowp + bj * HALF) = pack8(acc[ai][bj][m][0], acc[ai][bj][m][1]); }
    }
};
struct EpiResNorm {
    static constexpr bool PERM = true, AFTER_DRAIN = false;
    const float* base; float* out; bf16_t* hg; const float* gain; float* ssq; int ldc;
    __device__ __forceinline__ void operator()(const f32x4 (&acc)[2][2][4][2], const Unit& u, int wr, int wc, int fr, int fq) const {
        const int row0 = u.pm * BM + wr * 64 + fr, col0 = u.pn * BM + wc * 32 + 8 * fq;
        f32x4 gv[2][2];
#pragma unroll
        for (int bj = 0; bj < 2; ++bj)
#pragma unroll
            for (int n = 0; n < 2; ++n) gv[bj][n] = *(const f32x4*)(gain + col0 + bj * HALF + 4 * n);
#pragma unroll
        for (int ai = 0; ai < 2; ++ai)
#pragma unroll
            for (int m = 0; m < 4; ++m) { const int row = row0 + ai * HALF + m * 16; const size_t off = (size_t)row * ldc + col0; float s = 0.f;
#pragma unroll
                for (int bj = 0; bj < 2; ++bj) {
                    const f32x4 h0 = *(const f32x4*)(base + off + bj * HALF) + acc[ai][bj][m][0], h1 = *(const f32x4*)(base + off + bj * HALF + 4) + acc[ai][bj][m][1];
                    *(f32x4*)(out + off + bj * HALF) = h0; *(f32x4*)(out + off + bj * HALF + 4) = h1;
                    s += (h0[0] * h0[0] + h0[1] * h0[1]) + (h0[2] * h0[2] + h0[3] * h0[3]) + (h1[0] * h1[0] + h1[1] * h1[1]) + (h1[2] * h1[2] + h1[3] * h1[3]);
                    *(u32x4*)(hg + off + bj * HALF) = pack8(h0 * gv[bj][0], h1 * gv[bj][1]); }
                s += __shfl_xor(s, 16); s += __shfl_xor(s, 32);
                if (fq == 0) atomicAdd(ssq + row, s);
                if (m & 1) asm volatile("" ::: "memory"); }
    }
};
struct EpiUp {
    static constexpr bool PERM = true, AFTER_DRAIN = false;
    bf16_t* O; int ldc; const float* ssq; float inv_n, eps;
    __device__ __forceinline__ void operator()(const f32x4 (&acc)[2][2][4][2], const Unit& u, int wr, int wc, int fr, int fq) const {
        const int row0 = u.pm * BM + wr * 64 + fr, col0 = u.pn * BM + wc * 32 + 8 * fq;
#pragma unroll
        for (int ai = 0; ai < 2; ++ai)
#pragma unroll
            for (int m = 0; m < 4; ++m) { const int row = row0 + ai * HALF + m * 16; bf16_t* rowp = O + (size_t)row * ldc + col0;
                const float r2 = 1.0f / (ssq[row] * inv_n + eps);
#pragma unroll
                for (int bj = 0; bj < 2; ++bj) { f32x4 v0 = acc[ai][bj][m][0], v1 = acc[ai][bj][m][1];
#pragma unroll
                    for (int e = 0; e < 4; ++e) { const float a = fmaxf(v0[e], 0.f), b = fmaxf(v1[e], 0.f); v0[e] = a * a * r2; v1[e] = b * b * r2; }
                    *(u32x4*)(rowp + bj * HALF) = pack8(v0, v1); } }
    }
};
struct EpiGate {
    static constexpr bool PERM = true, AFTER_DRAIN = false;
    float* out; const bf16_t* E; const float* ssq_in; float* ssq_out; int ldc; float inv_n, eps;
    __device__ __forceinline__ void operator()(const f32x4 (&acc)[2][2][4][2], const Unit& u, int wr, int wc, int fr, int fq) const {
        const int row0 = u.pm * BM + wr * 64 + fr, col0 = u.pn * BM + wc * 32 + 8 * fq;
#pragma unroll
        for (int ai = 0; ai < 2; ++ai)
#pragma unroll
            for (int m = 0; m < 4; ++m) { const int row = row0 + ai * HALF + m * 16; const size_t off = (size_t)row * ldc + col0; float s = 0.f;
                const float nr = -1.4426950408889634f / sqrtf(ssq_in[row] * inv_n + eps);
#pragma unroll
                for (int bj = 0; bj < 2; ++bj) {
                    const u32x4 ew = *(const u32x4*)(E + off + bj * HALF);
                    f32x4 h0 = *(const f32x4*)(out + off + bj * HALF), h1 = *(const f32x4*)(out + off + bj * HALF + 4);
                    const f32x4 a0 = acc[ai][bj][m][0], a1 = acc[ai][bj][m][1];
                    const float e0[4] = {bf_lo(ew.x), bf_hi(ew.x), bf_lo(ew.y), bf_hi(ew.y)}, e1[4] = {bf_lo(ew.z), bf_hi(ew.z), bf_lo(ew.w), bf_hi(ew.w)};
#pragma unroll
                    for (int e = 0; e < 4; ++e) {
                        h0[e] += __builtin_amdgcn_rcpf(1.0f + __builtin_amdgcn_exp2f(nr * a0[e])) * e0[e];
                        h1[e] += __builtin_amdgcn_rcpf(1.0f + __builtin_amdgcn_exp2f(nr * a1[e])) * e1[e]; }
                    *(f32x4*)(out + off + bj * HALF) = h0; *(f32x4*)(out + off + bj * HALF + 4) = h1;
                    s += (h0[0] * h0[0] + h0[1] * h0[1]) + (h0[2] * h0[2] + h0[3] * h0[3]) + (h1[0] * h1[0] + h1[1] * h1[1]) + (h1[2] * h1[2] + h1[3] * h1[3]); }
                s += __shfl_xor(s, 16); s += __shfl_xor(s, 32);
                if (fq == 0) atomicAdd(ssq_out + row, s);
                if (m & 1) asm volatile("" ::: "memory"); }
    }
};
template <class Epi, class Sched, bool ALIGN_EPI = false, bool SP2 = false>
__device__ __forceinline__ void gemm_phase(PG8_LAS unsigned char* lds, const Gemm g, const Sched& S, const Epi& E) {
    const int tid = threadIdx.x, wid = __builtin_amdgcn_readfirstlane(tid >> 6), lane = tid & 63, wr = wid >> 2, wc = wid & 3, fr = lane & 15, fq = lane >> 4;
    const int K = g.K, nt = K / BK;
    unsigned voffA[2], voffB[2];
#pragma unroll
    for (int i = 0; i < 2; ++i) { int R, C; stage_rc(tid * 16 + i * 8192, R, C); const int Rb = Epi::PERM ? ((R & ~31) + perm32(R & 31)) : R;
        voffA[i] = (unsigned)(R * K + C) * 2u; voffB[i] = (unsigned)(Rb * K + C) * 2u; }
    const size_t kstep = (size_t)(BK * 2);
    const size_t hstep = (size_t)HALF * K * 2;
    const size_t tstep = 2 * hstep;
    const unsigned ldsw = (unsigned)wid * 1024u;
    const int aoff = lds_byte(wr * 64 + fr, fq * 8), boff = lds_byte(wc * 32 + fr, fq * 8);
#define PG8_SA(b, h) (((b) * 2 + (h)) * HTB)
#define PG8_SB(b, h) ((4 + (b) * 2 + (h)) * HTB)
#define PG8_STAGE(bufoff, gbase, voff) do { _Pragma("unroll") for (int _i = 0; _i < 2; ++_i) \
        __builtin_amdgcn_global_load_lds((const unsigned*)((const char*)(gbase) + (voff)[_i]), (PG8_LAS unsigned*)(lds + (bufoff) + ldsw + _i * 8192), 16, 0, 0); } while (0)
#define PG8_LDA(dst, b, h) do { _Pragma("unroll") for (int m = 0; m < 4; ++m) _Pragma("unroll") for (int k = 0; k < 2; ++k) dst[m][k] = *(const PG8_LAS bf16x8*)(lds + PG8_SA(b, h) + aoff + m * 2048 + k * 1024); } while (0)
#define PG8_LDB(dst, b, h) do { _Pragma("unroll") for (int n = 0; n < 2; ++n) _Pragma("unroll") for (int k = 0; k < 2; ++k) dst[n][k] = *(const PG8_LAS bf16x8*)(lds + PG8_SB(b, h) + boff + n * 2048 + k * 1024); } while (0)
#define PG8_MMA(ai, bj, At, Bt) do { __builtin_amdgcn_s_setprio(1); _Pragma("unroll") for (int m = 0; m < 4; ++m) _Pragma("unroll") for (int n = 0; n < 2; ++n) _Pragma("unroll") for (int k = 0; k < 2; ++k) \
        acc[ai][bj][m][n] = __builtin_amdgcn_mfma_f32_16x16x32_bf16(Bt[n][k], At[m][k], acc[ai][bj][m][n], 0, 0, 0); __builtin_amdgcn_s_setprio(0); } while (0)
#define PG8_WAIT_V(n) asm volatile("s_waitcnt vmcnt(" #n ")" ::: "memory")
#define PG8_WAIT_L(n) asm volatile("s_waitcnt lgkmcnt(" #n ")" ::: "memory")
#define PG8_BAR __builtin_amdgcn_s_barrier()
#define PG8_SCHED __builtin_amdgcn_sched_barrier(0)
    Unit cur, nxt; int ui = 0;
    if (!S.next(0, cur)) return;
    f32x4 acc[2][2][4][2];
#pragma unroll
    for (int a = 0; a < 2; ++a)
#pragma unroll
        for (int b = 0; b < 2; ++b)
#pragma unroll
            for (int m = 0; m < 4; ++m)
#pragma unroll
                for (int n = 0; n < 2; ++n) acc[a][b][m][n] = (f32x4){0.f, 0.f, 0.f, 0.f};
    bf16x8 At[4][2], B0[2][2], B1[2][2];
    const char* cA = (const char*)g.A + (size_t)cur.pm * tstep; const char* cB = (const char*)g.Bt + (size_t)cur.pn * tstep;
    S.a_ready(cur);
    if constexpr (SP2) {
        PG8_STAGE(PG8_SB(0, 0), cB, voffB); PG8_STAGE(PG8_SB(0, 1), cB + hstep, voffB); PG8_STAGE(PG8_SA(0, 0), cA, voffA); PG8_STAGE(PG8_SA(0, 1), cA + hstep, voffA);
        if (wr == 1) PG8_BAR;
        PG8_WAIT_V(2); PG8_BAR;
        PG8_STAGE(PG8_SB(1, 0), cB + kstep, voffB); PG8_STAGE(PG8_SA(1, 0), cA + kstep, voffA); PG8_STAGE(PG8_SB(1, 1), cB + hstep + kstep, voffB);
        PG8_WAIT_V(6); PG8_BAR;
    } else {
        PG8_STAGE(PG8_SB(0, 0), cB, voffB); PG8_STAGE(PG8_SA(0, 0), cA, voffA); PG8_STAGE(PG8_SB(0, 1), cB + hstep, voffB); PG8_STAGE(PG8_SA(0, 1), cA + hstep, voffA);
        if (wr == 1) PG8_BAR;
        PG8_WAIT_V(4); PG8_BAR;
        PG8_STAGE(PG8_SB(1, 0), cB + kstep, voffB); PG8_STAGE(PG8_SA(1, 0), cA + kstep, voffA); PG8_STAGE(PG8_SB(1, 1), cB + hstep + kstep, voffB);
        PG8_WAIT_V(6); PG8_BAR;
    }
    for (;;) {
        const bool has_next = S.next(ui + 1, nxt);
        const char* nA = has_next ? (const char*)g.A + (size_t)nxt.pm * tstep : cA; const char* nB = has_next ? (const char*)g.Bt + (size_t)nxt.pn * tstep : cB;
        for (int t = 0; t < nt; t += 2) {
            const bool last = (t == nt - 2);
            const char* a1 = cA + (size_t)(t + 1) * kstep;
            const char* a2 = last ? nA : cA + (size_t)(t + 2) * kstep; const char* b2 = last ? nB : cB + (size_t)(t + 2) * kstep;
            const char* a3 = a2 + kstep; const char* b3 = b2 + kstep;
            if (last && has_next) S.a_ready(nxt);
            if constexpr (SP2) {
            PG8_LDB(B0, 0, 0); PG8_LDB(B1, 0, 1); PG8_SCHED; PG8_LDA(At, 0, 0); PG8_STAGE(PG8_SA(1, 1), a1 + hstep, voffA);
            PG8_WAIT_V(8); PG8_WAIT_L(0); PG8_BAR; PG8_MMA(0, 0, At, B0); PG8_MMA(0, 1, At, B1); PG8_BAR; PG8_SCHED;
            PG8_LDA(At, 0, 1); PG8_STAGE(PG8_SB(0, 0), b2, voffB); PG8_STAGE(PG8_SB(0, 1), b2 + hstep, voffB); PG8_STAGE(PG8_SA(0, 0), a2, voffA);
            PG8_WAIT_V(8); PG8_WAIT_L(0); PG8_BAR; PG8_MMA(1, 0, At, B0); PG8_MMA(1, 1, At, B1); PG8_BAR; PG8_SCHED;
            PG8_LDB(B0, 1, 0); PG8_LDB(B1, 1, 1); PG8_SCHED; PG8_LDA(At, 1, 0); PG8_STAGE(PG8_SA(0, 1), a2 + hstep, voffA);
            PG8_WAIT_V(8); PG8_WAIT_L(0); PG8_BAR; PG8_MMA(0, 0, At, B0); PG8_MMA(0, 1, At, B1); PG8_BAR; PG8_SCHED;
            PG8_LDA(At, 1, 1); PG8_STAGE(PG8_SB(1, 0), b3, voffB); PG8_STAGE(PG8_SB(1, 1), b3 + hstep, voffB); PG8_STAGE(PG8_SA(1, 0), a3, voffA);
            PG8_WAIT_V(8); PG8_WAIT_L(0); PG8_BAR; PG8_MMA(1, 0, At, B0); PG8_MMA(1, 1, At, B1); PG8_BAR; PG8_SCHED;
            } else {
            PG8_LDB(B0, 0, 0); PG8_SCHED; PG8_LDA(At, 0, 0); PG8_STAGE(PG8_SA(1, 1), a1 + hstep, voffA);
            PG8_WAIT_L(8); PG8_BAR; PG8_WAIT_L(0); PG8_MMA(0, 0, At, B0); PG8_BAR; PG8_SCHED;
            PG8_LDB(B1, 0, 1); PG8_STAGE(PG8_SB(0, 0), b2, voffB);
            PG8_BAR; PG8_WAIT_L(0); PG8_MMA(0, 1, At, B1); PG8_BAR;
            PG8_LDA(At, 0, 1); PG8_STAGE(PG8_SA(0, 0), a2, voffA);
            PG8_BAR; PG8_WAIT_L(0); PG8_MMA(1, 0, At, B0); PG8_BAR; PG8_SCHED;
            PG8_STAGE(PG8_SB(0, 1), b2 + hstep, voffB);
            PG8_WAIT_V(6); PG8_BAR; PG8_MMA(1, 1, At, B1); PG8_BAR;
            PG8_LDB(B0, 1, 0); PG8_SCHED; PG8_LDA(At, 1, 0); PG8_STAGE(PG8_SA(0, 1), a2 + hstep, voffA);
            PG8_WAIT_L(8); PG8_BAR; PG8_WAIT_L(0); PG8_MMA(0, 0, At, B0); PG8_BAR; PG8_SCHED;
            PG8_LDB(B1, 1, 1); PG8_STAGE(PG8_SB(1, 0), b3, voffB);
            PG8_BAR; PG8_WAIT_L(0); PG8_MMA(0, 1, At, B1); PG8_BAR;
            PG8_LDA(At, 1, 1); PG8_STAGE(PG8_SA(1, 0), a3, voffA);
            PG8_BAR; PG8_WAIT_L(0); PG8_MMA(1, 0, At, B0); PG8_BAR; PG8_SCHED;
            PG8_STAGE(PG8_SB(1, 1), b3 + hstep, voffB);
            PG8_WAIT_V(6); PG8_BAR; PG8_MMA(1, 1, At, B1); PG8_BAR;
            }
        }
        if constexpr (ALIGN_EPI) { if (wr == 0) PG8_BAR; }
        if constexpr (!Epi::AFTER_DRAIN) { E(acc, cur, wr, wc, fr, fq); S.done(cur); }
        if (!has_next) break;
#pragma unroll
        for (int a = 0; a < 2; ++a)
#pragma unroll
            for (int b = 0; b < 2; ++b)
#pragma unroll
                for (int m = 0; m < 4; ++m)
#pragma unroll
                    for (int n = 0; n < 2; ++n) acc[a][b][m][n] = (f32x4){0.f, 0.f, 0.f, 0.f};
        cur = nxt; cA = nA; cB = nB; ++ui;
        if constexpr (ALIGN_EPI) { if (wr == 1) PG8_BAR; }
    }
    PG8_WAIT_V(0);
    if constexpr (!ALIGN_EPI) { if (wr == 0) PG8_BAR; }
    PG8_BAR;
    if constexpr (Epi::AFTER_DRAIN) { E.fused(acc, cur, wr, wc, fr, fq, lds, wid, lane); S.done(cur); }
#undef PG8_SA
#undef PG8_SB
#undef PG8_STAGE
#undef PG8_LDA
#undef PG8_LDB
#undef PG8_MMA
#undef PG8_WAIT_V
#undef PG8_WAIT_L
#undef PG8_BAR
#undef PG8_SCHED
}
}
constexpr int NWAVES = 8;
constexpr int NB = 4, SEQ = 4096, DM = 4096, M = NB * SEQ, DIN = 10240, DFF = 16384, PLE = 256, AW = 2048, NH = 16, HD = 128, CH = 128;
constexpr float EPS = 1e-6f;
constexpr float QSCALE = 0.08838834764831845f;
constexpr size_t MiB = 1u << 20;
constexpr size_t WS_CTL = 0, CTL_ZERO_BYTES = 256 * 1024;
constexpr size_t WS_PBF = 1 * MiB;
constexpr size_t WS_WSB = 9 * MiB;
constexpr size_t WS_WIN = 10 * MiB, WS_WOUT = WS_WIN + 80 * MiB, WS_WUP = WS_WOUT + 32 * MiB, WS_WDN = WS_WUP + 128 * MiB, WS_WGT = WS_WDN + 128 * MiB, WS_WPJ = WS_WGT + 32 * MiB;
constexpr size_t WS_ACT = WS_WPJ + 2 * MiB;
constexpr size_t WS_Z = WS_ACT + 128 * MiB;
constexpr size_t WS_HID = WS_ACT;
constexpr size_t WS_HG = WS_ACT + 512 * MiB;
constexpr size_t WS_END = WS_HG + 128 * MiB;
static_assert(WS_Z + (size_t)M * DIN * 2 <= WS_HG && WS_HID + (size_t)M * DFF * 2 <= WS_HG && WS_WPJ + (size_t)DM * PLE * 2 <= WS_ACT && WS_PBF + (size_t)M * PLE * 2 <= WS_WSB, "d_ws map");
constexpr int CW_TMO = 0, CW_CODE = 1;
constexpr int CW_BAR = 4096;
constexpr int CW_SSQ1 = 16384, CW_SSQ2 = 32768, CW_SSQ3 = 49152;
static_assert((CW_SSQ3 + M) * 4 <= (int)CTL_ZERO_BYTES, "CTL words inside the memset region");
constexpr int RING_OFF = 0, RING_BYTES = 131072;
constexpr int LDS_BYTES = 147456;
constexpr int LDSCTL_OFF = LDS_BYTES - 1024, MISC_OFF = LDSCTL_OFF + 320;
static_assert(MISC_OFF + 128 <= LDS_BYTES, "LDS map");

#define GAS __attribute__((address_space(1)))
#define LAS __attribute__((address_space(3)))
typedef unsigned short bf16;
typedef unsigned v4u __attribute__((ext_vector_type(4)));
typedef float f32x4 __attribute__((ext_vector_type(4)));
typedef short bf16x8 __attribute__((ext_vector_type(8)));
typedef GAS unsigned gu32;
typedef GAS unsigned long long gu64;
#define RLX_AGENT __ATOMIC_RELAXED, __HIP_MEMORY_SCOPE_AGENT
#define LDS_WAIT() asm volatile("s_waitcnt lgkmcnt(0)" ::: "memory")
#define VM_WAIT() asm volatile("s_waitcnt vmcnt(0)" ::: "memory")
__device__ __forceinline__ unsigned long long rt() { return __builtin_amdgcn_s_memrealtime(); }
__device__ __forceinline__ unsigned f2bf(float f) { unsigned u = __builtin_bit_cast(unsigned, f); return (u + 0x7fffu + ((u >> 16) & 1u)) >> 16; }
__device__ __forceinline__ unsigned pk2(float lo, float hi) { return f2bf(lo) | (f2bf(hi) << 16); }
#define XB_TMO      128
#define XB_XCNT(j)  (256  + 64 * (j))
#define XB_XSUB(j)  (1280 + 64 * (j))
#define XB_XGEN(j)  (2304 + 64 * (j))
#define XB_TOP      3328
#define XB_TOPGEN   3392
#define XCD_BAR_WORDS 3456
#define XB_SPIN_CAP (1u << 18)

__device__ __forceinline__ unsigned xb_ld(unsigned* p)              { return __hip_atomic_load(p, __ATOMIC_RELAXED, __HIP_MEMORY_SCOPE_AGENT); }
__device__ __forceinline__ unsigned xb_add(unsigned* p, unsigned v) { return __hip_atomic_fetch_add(p, v, __ATOMIC_RELAXED, __HIP_MEMORY_SCOPE_AGENT); }
__device__ __forceinline__ unsigned xb_xcc_id() { return (unsigned)__builtin_amdgcn_s_getreg((3 << 11) | 20) & 0xFu; }
#define XB_SPIN(cond, bar) do { unsigned _sp = 0; while (cond) { __builtin_amdgcn_s_sleep(1); \
    if ((++_sp & 255u) == 0u) { if (xb_ld(&(bar)[XB_TMO])) break; if (_sp > XB_SPIN_CAP) { atomicAdd(&(bar)[XB_TMO], 1u); break; } } } } while (0)

struct XcdBarrier {
    unsigned* bar; unsigned x;
    volatile LAS unsigned* st;
};

__device__ __forceinline__ XcdBarrier xcd_barrier_post(unsigned* bar, volatile LAS unsigned* st) {
    XcdBarrier b; b.bar = bar; b.x = xb_xcc_id(); b.st = st;
    if (threadIdx.x == 0) (void)xb_add(&bar[XB_XCNT(b.x)], 1u);
    return b;
}
__device__ __forceinline__ void xcd_barrier_complete(unsigned* bar, unsigned x, unsigned& nloc, unsigned& nx) {
    const unsigned G = gridDim.x * gridDim.y * gridDim.z;
    unsigned sum, cnt, mine, sp = 0u;
    for (;;) {
        sum = 0u; cnt = 0u; mine = 0u;
#pragma unroll
        for (unsigned j = 0; j < 16; ++j) { const unsigned c = xb_ld(&bar[XB_XCNT(j)]); sum += c; cnt += (c > 0u) ? 1u : 0u; mine = (j == x) ? c : mine; }
        if (sum == G) break;
        __builtin_amdgcn_s_sleep(1);
        if ((++sp & 255u) == 0u) { if (xb_ld(&bar[XB_TMO])) break; if (sp > XB_SPIN_CAP) { atomicAdd(&bar[XB_TMO], 1u); break; } }
    }
    nloc = mine > 0u ? mine : 1u; nx = cnt > 0u ? cnt : 1u;
}

__device__ __forceinline__ void xcd_barrier(const XcdBarrier& b) {
    asm volatile("s_waitcnt vmcnt(0)" ::: "memory");
    __syncthreads();
    if (threadIdx.x == 0) {
        unsigned* bar = b.bar;
        __builtin_amdgcn_s_waitcnt(0);
        unsigned nloc = b.st[0], nx = b.st[1];
        if (nloc == 0u) { xcd_barrier_complete(bar, b.x, nloc, nx); b.st[0] = nloc; b.st[1] = nx; }
        const unsigned old = xb_add(&bar[XB_XSUB(b.x)], 1u);
        const unsigned gen = old / nloc;
        if (old + 1u == (gen + 1u) * nloc) {
            __builtin_amdgcn_fence(__ATOMIC_RELEASE, "agent");
            asm volatile("s_waitcnt vmcnt(0)" ::: "memory");
            const unsigned og = xb_add(&bar[XB_TOP], 1u);
            const unsigned tg = og / nx;
            if (og + 1u == (tg + 1u) * nx) xb_add(&bar[XB_TOPGEN], 1u);
            else XB_SPIN(xb_ld(&bar[XB_TOPGEN]) == tg, bar);
            __builtin_amdgcn_fence(__ATOMIC_ACQUIRE, "agent");
            xb_add(&bar[XB_XGEN(b.x)], 1u);
            asm volatile("s_waitcnt vmcnt(0)" ::: "memory");
        } else {
            XB_SPIN(xb_ld(&bar[XB_XGEN(b.x)]) == gen, bar);
            __builtin_amdgcn_fence(__ATOMIC_ACQUIRE, "agent");
            asm volatile("s_waitcnt vmcnt(0)" ::: "memory");
        }
    }
    __syncthreads();
}

struct Frame {
    LAS unsigned char* lds;
    volatile LAS unsigned* MISC;
    gu32* ctl;
    int tid, lane, wave;
    int vcu, G;
};
__device__ __forceinline__ float wave_sum(float v) {
#pragma unroll
    for (int o = 1; o < 64; o <<= 1) v += __shfl_xor(v, o);
    return v;
}
__device__ __forceinline__ float bf2f(unsigned short h) { return __builtin_bit_cast(float, (unsigned)h << 16); }
__device__ __forceinline__ void p0_transpose_item(const float* W, int K, int N, bf16* WT, LAS float* scr, int item, int lane) {
    const int nblk = N / 32, kb = item / nblk, nb = item % nblk, k0 = 64 * kb, n0 = 32 * nb;
#pragma unroll 8
    for (int i = 0; i < 32; ++i) { const int kk = 2 * i + (lane >> 5); scr[kk * 33 + (lane & 31)] = W[(size_t)(k0 + kk) * N + n0 + (lane & 31)]; }
    LDS_WAIT(); asm volatile("" ::: "memory");
    const int c = lane & 7;
#pragma unroll
    for (int j = 0; j < 4; ++j) { const int n = (lane >> 3) + 8 * j; const LAS float* s = scr + (8 * c) * 33 + n;
        v4u o; o.x = pk2(s[0 * 33], s[1 * 33]); o.y = pk2(s[2 * 33], s[3 * 33]); o.z = pk2(s[4 * 33], s[5 * 33]); o.w = pk2(s[6 * 33], s[7 * 33]);
        *(GAS v4u*)(WT + (size_t)(n0 + n) * K + k0 + 8 * c) = o; }
    LDS_WAIT(); asm volatile("" ::: "memory");
}
__device__ __forceinline__ void rms_row_to_bf16(int lane, const float* xrow, const float* g, bf16* orow) {
    const GAS f32x4* xr = (const GAS f32x4*)xrow + lane; const GAS f32x4* gr = (const GAS f32x4*)g + lane;
    f32x4 v[16]; float s = 0.f;
#pragma unroll
    for (int j = 0; j < 16; ++j) { v[j] = xr[64 * j]; s += (v[j].x * v[j].x + v[j].y * v[j].y) + (v[j].z * v[j].z + v[j].w * v[j].w); }
    const float rstd = 1.f / sqrtf(wave_sum(s) * (1.f / DM) + EPS);
    GAS unsigned long long* o8 = (GAS unsigned long long*)orow + lane;
#pragma unroll
    for (int j = 0; j < 16; ++j) { const f32x4 gg = gr[64 * j];
        o8[64 * j] = (unsigned long long)pk2(v[j].x * rstd * gg.x, v[j].y * rstd * gg.y) | ((unsigned long long)pk2(v[j].z * rstd * gg.z, v[j].w * rstd * gg.w) << 32); }
}
__device__ __forceinline__ void final_row(int lane, float* xrow, const float* g, float ssq) {
    GAS f32x4* xr = (GAS f32x4*)xrow + lane; const GAS f32x4* gr = (const GAS f32x4*)g + lane;
    const float rstd = 1.f / sqrtf(ssq * (1.f / DM) + EPS);
#pragma unroll
    for (int j = 0; j < 16; ++j) { f32x4 v = xr[64 * j]; const f32x4 gg = gr[64 * j]; v = v * rstd * gg; xr[64 * j] = v; }
}

typedef float f32x16 __attribute__((ext_vector_type(16)));
typedef short s16x4 __attribute__((ext_vector_type(4)));
typedef short v4i16_t __attribute__((ext_vector_type(4)));
typedef float f32x2_t __attribute__((ext_vector_type(2))); typedef __bf16 bf16x2_t __attribute__((ext_vector_type(2)));
__device__ __forceinline__ unsigned cvtpk_s(float lo, float hi) { f32x2_t v = {lo, hi}; bf16x2_t b = __builtin_convertvector(v, bf16x2_t); return __builtin_bit_cast(unsigned, b); }
__device__ __forceinline__ s16x4 vtr(LAS const unsigned char* p) { return __builtin_bit_cast(s16x4, __builtin_amdgcn_ds_read_tr16_b64_v4i16((LAS v4i16_t*)p)); }
__device__ __forceinline__ int crow(int r, int hi) { return (r & 3) + 8 * (r >> 2) + 4 * hi; }
#define MFMA32(a, b, c) __builtin_amdgcn_mfma_f32_32x32x16_bf16((a), (b), (c), 0, 0, 0)
__device__ __forceinline__ float half_swap_sum(float v) { auto rr = __builtin_amdgcn_permlane32_swap(__float_as_uint(v), __float_as_uint(v), false, false); return __uint_as_float(rr[0]) + __uint_as_float(rr[1]); }
constexpr int KST = 272, VST = 320;
constexpr int WREG = 32 * VST;

__device__ __forceinline__ void head_norm_store(f32x16 (&o)[4], int lane, LAS unsigned char* wl, const float* gain, bf16* ydst) {
    const int tl = lane & 31, hh = lane >> 5, r4 = lane >> 4, c16 = lane & 15;
    float ss = 0.f;
#pragma unroll
    for (int dt = 0; dt < 4; ++dt)
#pragma unroll
        for (int r = 0; r < 16; ++r) ss += o[dt][r] * o[dt][r];
    ss = half_swap_sum(ss);
    const float rstd = 1.0f / sqrtf(ss * (1.0f / 128.0f) + EPS);
#pragma unroll
    for (int dt = 0; dt < 4; ++dt)
#pragma unroll
        for (int G = 0; G < 4; ++G) { const int d0 = 32 * dt + 8 * G + 4 * hh; const f32x4 g4 = *(const GAS f32x4*)(gain + d0);
            const unsigned w0 = cvtpk_s(o[dt][4 * G] * rstd * g4.x, o[dt][4 * G + 1] * rstd * g4.y), w1 = cvtpk_s(o[dt][4 * G + 2] * rstd * g4.z, o[dt][4 * G + 3] * rstd * g4.w);
            *(LAS unsigned long long*)(wl + tl * KST + 2 * d0) = (unsigned long long)w0 | ((unsigned long long)w1 << 32); }
#pragma unroll
    for (int i = 0; i < 8; ++i) { const int row = 4 * i + r4; const v4u w = *(LAS const v4u*)(wl + row * KST + 16 * c16);
        *(GAS v4u*)(ydst + (size_t)row * DM + 8 * c16) = w; }
}

__device__ __forceinline__ void attn_unit(int unit, int lane, LAS unsigned char* wl, const bf16* Z, const float* gb, bf16* Y) {
    const int qb = unit & 127, h = (unit >> 7) & 15, b = unit >> 11;
    const int t0 = qb * 32, tl = lane & 31, hh = lane >> 5, r4 = lane >> 4, c16 = lane & 15;
    const size_t rowb = (size_t)b * SEQ;
    bf16x8 qf[8];
    { const bf16* Qp = Z + (rowb + t0 + tl) * DIN + 2 * AW + h * HD + 8 * hh;
#pragma unroll
      for (int ks = 0; ks < 8; ++ks) qf[ks] = *(const GAS bf16x8*)(Qp + 16 * ks); }
    f32x16 o[4];
#pragma unroll
    for (int dt = 0; dt < 4; ++dt)
#pragma unroll
        for (int r = 0; r < 16; ++r) o[dt][r] = 0.f;
    float L2 = 0.f;
    const bf16* Kp = Z + (rowb + r4) * DIN + 3 * AW + h * HD + 8 * c16;
    const unsigned kw = r4 * KST + c16 * 16, kr = tl * KST + hh * 16, vw = r4 * VST + c16 * 16;
    const int q4 = (lane & 15) >> 2, p4 = lane & 3, blk = (lane >> 4) & 1;
    const unsigned vr = (4 * hh + q4) * VST + 2 * (16 * blk + 4 * p4);
    for (int j = 0; ; ++j) {
        const int s0 = t0 - 32 * j; if (s0 < 0) break;
        v4u kreg[8], vreg[8];
#pragma unroll
        for (int i = 0; i < 8; ++i) { kreg[i] = *(const GAS v4u*)(Kp + (size_t)(s0 + 4 * i) * DIN); vreg[i] = *(const GAS v4u*)(Kp + (size_t)(s0 + 4 * i) * DIN + AW); }
#pragma unroll
        for (int i = 0; i < 8; ++i) *(LAS v4u*)(wl + kw + i * 4 * KST) = kreg[i];
        f32x16 st;
#pragma unroll
        for (int r = 0; r < 16; ++r) st[r] = 0.f;
#pragma unroll
        for (int ks = 0; ks < 8; ++ks) { const bf16x8 kf = *(LAS const bf16x8*)(wl + kr + 32 * ks); st = MFMA32(kf, qf[ks], st); }
#pragma unroll
        for (int i = 0; i < 8; ++i) *(LAS v4u*)(wl + vw + i * 4 * VST) = vreg[i];
        const bool diag = (j == 0);
        float lk[16], ls[16];
#pragma unroll
        for (int r = 0; r < 16; ++r) { const float z = st[r];
            const float sp = fmaxf(z, 0.f) + __builtin_amdgcn_logf(1.0f + __builtin_amdgcn_exp2f(-fabsf(z)));
            const bool valid = !diag || (crow(r, hh) < tl);
            lk[r] = valid ? -sp : 0.f; ls[r] = z - sp; }
        float gs[4], T[4];
#pragma unroll
        for (int G = 0; G < 4; ++G) { gs[G] = (lk[4 * G] + lk[4 * G + 1]) + (lk[4 * G + 2] + lk[4 * G + 3]); T[G] = half_swap_sum(gs[G]); }
        const float SG2 = T[3], SG1 = SG2 + T[2], SG0 = SG1 + T[1];
        const float SG[4] = {SG0, SG1, SG2, 0.f};
        unsigned pw[8];
#pragma unroll
        for (int G = 0; G < 4; ++G) {
            float run = L2 + SG[G] + (hh == 0 ? (T[G] - gs[G]) : 0.f); float a[4];
#pragma unroll
            for (int i = 3; i >= 0; --i) { const int r = 4 * G + i; const float e = __builtin_amdgcn_exp2f(ls[r] + run);
                const bool valid = !diag || (crow(r, hh) < tl); a[i] = valid ? e : 0.f; run += lk[r]; }
            pw[2 * G] = cvtpk_s(a[0], a[1]); pw[2 * G + 1] = cvtpk_s(a[2], a[3]); }
        L2 += SG0 + T[0];
#pragma unroll
        for (int s2 = 0; s2 < 2; ++s2) { const v4u pv4 = {pw[4 * s2], pw[4 * s2 + 1], pw[4 * s2 + 2], pw[4 * s2 + 3]}; const bf16x8 pb = __builtin_bit_cast(bf16x8, pv4);
#pragma unroll
            for (int dt = 0; dt < 4; ++dt) { const s16x4 lo = vtr(wl + vr + (16 * s2) * VST + 64 * dt), hi = vtr(wl + vr + (16 * s2 + 8) * VST + 64 * dt);
                const bf16x8 va = __builtin_shufflevector(lo, hi, 0, 1, 2, 3, 4, 5, 6, 7);
                o[dt] = MFMA32(va, pb, o[dt]); } }
        if (__all(L2 < -150.5f)) break;
    }
    head_norm_store(o, lane, wl, gb + h * HD, Y + (rowb + t0) * DM + AW + h * HD);
}

__device__ __forceinline__ void sgu_unit(bool active, int unit, int wq, int lane, LAS unsigned char* vn, LAS unsigned char* wl, const bf16* Z, const bf16* WSB, const float* bs, const float* ga, bf16* Y) {
    const int h = unit % NH, nc = (unit / NH) % (SEQ / CH), b = unit / (NH * (SEQ / CH));
    const int tl = lane & 31, hh = lane >> 5, r4 = lane >> 4, c16 = lane & 15;
    const size_t row0 = (size_t)b * SEQ + nc * CH;
    if (active) {
#pragma unroll
        for (int i = 0; i < 8; ++i) { const int s = 32 * wq + 4 * i + r4;
            const v4u w = *(const GAS v4u*)(Z + (row0 + s) * DIN + AW + h * HD + 8 * c16);
            float v[8] = {pg8::bf_lo(w.x), pg8::bf_hi(w.x), pg8::bf_lo(w.y), pg8::bf_hi(w.y), pg8::bf_lo(w.z), pg8::bf_hi(w.z), pg8::bf_lo(w.w), pg8::bf_hi(w.w)};
            float s1 = ((v[0] + v[1]) + (v[2] + v[3])) + ((v[4] + v[5]) + (v[6] + v[7]));
#pragma unroll
            for (int o = 1; o < 16; o <<= 1) s1 += __shfl_xor(s1, o);
            const float mu = s1 * (1.0f / 128.0f); float s2 = 0.f;
#pragma unroll
            for (int e = 0; e < 8; ++e) { v[e] -= mu; s2 += v[e] * v[e]; }
#pragma unroll
            for (int o = 1; o < 16; o <<= 1) s2 += __shfl_xor(s2, o);
            const float rs = 1.0f / sqrtf(s2 * (1.0f / 128.0f) + EPS);
            v4u ow; ow.x = cvtpk_s(v[0] * rs, v[1] * rs); ow.y = cvtpk_s(v[2] * rs, v[3] * rs); ow.z = cvtpk_s(v[4] * rs, v[5] * rs); ow.w = cvtpk_s(v[6] * rs, v[7] * rs);
            *(LAS v4u*)(vn + s * 256 + ((16 * c16) ^ ((s & 3) << 6))) = ow; }
    }
    LDS_WAIT(); __syncthreads();
    if (active) {
        f32x16 o[4];
#pragma unroll
        for (int dt = 0; dt < 4; ++dt)
#pragma unroll
            for (int r = 0; r < 16; ++r) o[dt][r] = 0.f;
        const int q4 = (lane & 15) >> 2, p4 = lane & 3, blk = (lane >> 4) & 1;
        const bf16* Wrow = WSB + ((size_t)h * CH + 32 * wq + tl) * CH + 8 * hh;
        for (int sb = 0; sb <= wq; ++sb) {
#pragma unroll
            for (int s2 = 0; s2 < 2; ++s2) { const bf16x8 wf = *(const GAS bf16x8*)(Wrow + 32 * sb + 16 * s2);
                const int R = 32 * sb + 16 * s2 + 8 * hh + q4;
#pragma unroll
                for (int dt = 0; dt < 4; ++dt) { const unsigned xo = (unsigned)(64 * (dt ^ q4) + 32 * blk + 8 * p4);
                    const s16x4 lo = vtr(vn + R * 256 + xo), hi = vtr(vn + (R + 4) * 256 + xo);
                    const bf16x8 va = __builtin_shufflevector(lo, hi, 0, 1, 2, 3, 4, 5, 6, 7);
                    o[dt] = MFMA32(va, wf, o[dt]); } } }
#pragma unroll
        for (int i = 0; i < 8; ++i) { const int t = 4 * i + r4; const v4u w = *(const GAS v4u*)(Z + (row0 + 32 * wq + t) * DIN + h * HD + 8 * c16); *(LAS v4u*)(wl + t * KST + 16 * c16) = w; }
        const float bias = bs[h * CH + 32 * wq + tl];
#pragma unroll
        for (int dt = 0; dt < 4; ++dt)
#pragma unroll
            for (int G = 0; G < 4; ++G) { const int d0 = 32 * dt + 8 * G + 4 * hh; const unsigned long long uw = *(LAS const unsigned long long*)(wl + tl * KST + 2 * d0);
                const unsigned u0 = (unsigned)uw, u1 = (unsigned)(uw >> 32);
                o[dt][4 * G] = pg8::bf_lo(u0) * (o[dt][4 * G] + bias); o[dt][4 * G + 1] = pg8::bf_hi(u0) * (o[dt][4 * G + 1] + bias);
                o[dt][4 * G + 2] = pg8::bf_lo(u1) * (o[dt][4 * G + 2] + bias); o[dt][4 * G + 3] = pg8::bf_hi(u1) * (o[dt][4 * G + 3] + bias); }
        head_norm_store(o, lane, wl, ga + h * HD, Y + (row0 + 32 * wq) * DM + h * HD);
    }
    LDS_WAIT(); __syncthreads();
}

constexpr int N_PHASES = 9;
struct Args { const float* in[16]; float* out; unsigned char* ws; int ph_lo, ph_hi; };
__global__ void __launch_bounds__(NWAVES * 64, 2) mk_fwd(Args args) {
    extern __shared__ __attribute__((aligned(16))) unsigned char lds[];
    Frame F;
    F.lds = (LAS unsigned char*)lds;
    F.MISC = (volatile LAS unsigned*)(F.lds + MISC_OFF);
    F.tid = threadIdx.x; F.lane = F.tid & 63; F.wave = __builtin_amdgcn_readfirstlane(F.tid >> 6);
    F.G = gridDim.x; { const int bx = blockIdx.x; F.vcu = (F.G % 8 == 0) ? (bx % 8) * (F.G / 8) + bx / 8 : bx; }
    unsigned char* ws = args.ws;
    F.ctl = (gu32*)(ws + WS_CTL);
    const float* x = args.in[0]; const float* p = args.in[1]; const float* norm_mix = args.in[2]; const float* w_in = args.in[3];
    const float* w_s = args.in[4]; const float* b_s = args.in[5]; const float* norm_a = args.in[6]; const float* norm_b = args.in[7];
    const float* w_out = args.in[8]; const float* norm_ffn = args.in[9]; const float* w_up = args.in[10]; const float* w_down = args.in[11];
    const float* norm_ple = args.in[12]; const float* w_gate = args.in[13]; const float* w_proj = args.in[14]; const float* norm_final = args.in[15];
    float* out = args.out;
    bf16* PBF = (bf16*)(ws + WS_PBF); bf16* WSB = (bf16*)(ws + WS_WSB);
    bf16 *Wi = (bf16*)(ws + WS_WIN), *Wo = (bf16*)(ws + WS_WOUT), *Wu = (bf16*)(ws + WS_WUP), *Wd = (bf16*)(ws + WS_WDN), *Wg = (bf16*)(ws + WS_WGT), *Wp = (bf16*)(ws + WS_WPJ);
    bf16 *ACT = (bf16*)(ws + WS_ACT), *Z = (bf16*)(ws + WS_Z), *HID = (bf16*)(ws + WS_HID), *HG = (bf16*)(ws + WS_HG);
    float* ssq1 = (float*)(ws + WS_CTL) + CW_SSQ1; float* ssq2 = (float*)(ws + WS_CTL) + CW_SSQ2; float* ssq3 = (float*)(ws + WS_CTL) + CW_SSQ3;
    for (int u = F.tid; u < (LDS_BYTES - LDSCTL_OFF) / 4; u += NWAVES * 64) ((LAS unsigned*)(F.lds + LDSCTL_OFF))[u] = 0u;
    __syncthreads();
    const int lo = args.ph_lo, hi = args.ph_hi;
    const bool one_launch = (lo == 0 && hi == N_PHASES);
    XcdBarrier bar; bar.bar = (unsigned*)(F.ctl + CW_BAR); bar.x = 0; bar.st = nullptr;
    if (one_launch) bar = xcd_barrier_post((unsigned*)(F.ctl + CW_BAR), F.MISC + 8);
#define IN(k) (lo <= (k) && (k) < hi)
#define GRID_BAR(k) do { if (IN(k) && IN((k) + 1)) xcd_barrier(bar); } while (0)
    const int gw = F.vcu * NWAVES + F.wave, NGW = F.G * NWAVES;

    if (IN(0)) {
        LAS float* scr = (LAS float*)(F.lds + RING_OFF + F.wave * 16384);
        constexpr int I_IN = (DM / 64) * (DIN / 32), I_OUT = (DM / 64) * (DM / 32), I_UP = (DM / 64) * (DFF / 32), I_DN = (DFF / 64) * (DM / 32), I_GT = I_OUT, I_PJ = (PLE / 64) * (DM / 32);
        constexpr int NITEMS = I_IN + I_OUT + I_UP + I_DN + I_GT + I_PJ;
        for (int it = gw; it < NITEMS; it += NGW) {
            int r = it;
            if (r < I_IN) { p0_transpose_item(w_in, DM, DIN, Wi, scr, r, F.lane); continue; } r -= I_IN;
            if (r < I_OUT) { p0_transpose_item(w_out, DM, DM, Wo, scr, r, F.lane); continue; } r -= I_OUT;
            if (r < I_UP) { p0_transpose_item(w_up, DM, DFF, Wu, scr, r, F.lane); continue; } r -= I_UP;
            if (r < I_DN) { p0_transpose_item(w_down, DFF, DM, Wd, scr, r, F.lane); continue; } r -= I_DN;
            if (r < I_GT) { p0_transpose_item(w_gate, DM, DM, Wg, scr, r, F.lane); continue; } r -= I_GT;
            p0_transpose_item(w_proj, PLE, DM, Wp, scr, r, F.lane);
        }
        for (int i = gw; i < M * PLE / 256; i += NGW) {
            const f32x4 v = ((const GAS f32x4*)p)[(size_t)i * 64 + F.lane];
            ((GAS unsigned long long*)PBF)[(size_t)i * 64 + F.lane] = (unsigned long long)pk2(v.x, v.y) | ((unsigned long long)pk2(v.z, v.w) << 32); }
        for (int i = gw; i < NH * CH * CH / 256; i += NGW) {
            const f32x4 v = ((const GAS f32x4*)w_s)[(size_t)i * 64 + F.lane]; const int e0 = i * 256 + F.lane * 4, s = e0 & 127, t = (e0 >> 7) & 127;
            ((GAS unsigned long long*)WSB)[(size_t)i * 64 + F.lane] = (unsigned long long)pk2(s <= t ? v.x : 0.f, s + 1 <= t ? v.y : 0.f) | ((unsigned long long)pk2(s + 2 <= t ? v.z : 0.f, s + 3 <= t ? v.w : 0.f) << 32); }
        for (int m = gw; m < M; m += NGW) rms_row_to_bf16(F.lane, x + (size_t)m * DM, norm_mix, ACT + (size_t)m * DM);
    }
    GRID_BAR(0);
    if (IN(1)) {
        pg8::Gemm g{ACT, Wi, M, DIN, DM}; pg8::StaticOrder S; S.init(M, DIN, F.G, (int)blockIdx.x);
        pg8::EpiInProj E{Z, DIN, (2 * AW) / 256, (3 * AW) / 256, QSCALE * 1.4426950408889634f};
        pg8::gemm_phase<pg8::EpiInProj, pg8::StaticOrder, true, true>(F.lds + RING_OFF, g, S, E);
    }
    GRID_BAR(1);
    if (IN(2)) {
        const int hw = F.wave >> 2, wq = F.wave & 3;
        LAS unsigned char* vn = F.lds + hw * 32768; LAS unsigned char* wls = F.lds + 65536 + F.wave * (32 * KST);
        constexpr int NSGU = NB * (SEQ / CH) * NH;
        for (int it = 0; it * (2 * F.G) < NSGU; ++it) { const int unit = it * (2 * F.G) + 2 * (int)blockIdx.x + hw;
            sgu_unit(unit < NSGU, unit < NSGU ? unit : 0, wq, F.lane, vn, wls, Z, WSB, b_s, norm_a, ACT); }
        LAS unsigned char* wl2 = F.lds + F.wave * WREG;
        constexpr int NATT = NB * NH * (SEQ / 32);
        for (int i = 0; ; ++i) { const int unit = (i * F.G + (int)blockIdx.x) * NWAVES + F.wave; if (unit >= NATT) break;
            attn_unit(unit, F.lane, wl2, Z, norm_b, ACT); }
    }
    GRID_BAR(2);
    if (IN(3)) {
        pg8::Gemm g{ACT, Wo, M, DM, DM}; pg8::StaticOrder S; S.init(M, DM, F.G, (int)blockIdx.x);
        pg8::EpiResNorm E{x, out, HG, norm_ffn, ssq1, DM};
        pg8::gemm_phase<pg8::EpiResNorm, pg8::StaticOrder, true, true>(F.lds + RING_OFF, g, S, E);
    }
    GRID_BAR(3);
    if (IN(4)) {
        pg8::Gemm g{HG, Wu, M, DFF, DM}; pg8::StaticOrder S; S.init(M, DFF, F.G, (int)blockIdx.x);
        pg8::EpiUp E{HID, DFF, ssq1, 1.0f / DM, EPS};
        pg8::gemm_phase<pg8::EpiUp, pg8::StaticOrder, true, true>(F.lds + RING_OFF, g, S, E);
    }
    GRID_BAR(4);
    if (IN(5)) {
        pg8::Gemm g{HID, Wd, M, DM, DFF}; pg8::StaticOrder S; S.init(M, DM, F.G, (int)blockIdx.x);
        pg8::EpiResNorm E{out, out, HG, norm_ple, ssq2, DM};
        pg8::gemm_phase<pg8::EpiResNorm, pg8::StaticOrder, true, true>(F.lds + RING_OFF, g, S, E);
    }
    GRID_BAR(5);
    if (IN(6)) {
        pg8::Gemm g{PBF, Wp, M, DM, PLE}; pg8::StaticOrder S; S.init(M, DM, F.G, (int)blockIdx.x);
        pg8::EpiPlainBf16 E{ACT, DM};
        pg8::gemm_phase<pg8::EpiPlainBf16, pg8::StaticOrder, true, true>(F.lds + RING_OFF, g, S, E);
        VM_WAIT(); __syncthreads();
    }
    if (IN(7)) {
        pg8::Gemm g{HG, Wg, M, DM, DM}; pg8::StaticOrder S; S.init(M, DM, F.G, (int)blockIdx.x);
        pg8::EpiGate E{out, ACT, ssq2, ssq3, DM, 1.0f / DM, EPS};
        pg8::gemm_phase<pg8::EpiGate, pg8::StaticOrder, true, true>(F.lds + RING_OFF, g, S, E);
    }
    GRID_BAR(7);
    if (IN(8)) {
        for (int m = gw; m < M; m += NGW) final_row(F.lane, out + (size_t)m * DM, norm_final, ssq3[m]);
    }
#undef IN
#undef GRID_BAR
}

#ifndef MK_PER_PHASE
#define MK_PER_PHASE 0
#endif
extern "C" void kernel_launch(void* const* d_in, const int* in_sizes, int n_in, void* d_out, int out_size, void* d_ws, size_t ws_size, hipStream_t stream) {
    static int grid = 0;
    if (grid == 0) {
        if (n_in != 16 || in_sizes[0] != M * DM || out_size != M * DM || ws_size < WS_END) { fprintf(stderr, "kernel_launch: unexpected shapes: n_in %d, in0 %d, out %d, ws %zu (need %zu); nothing launched\n", n_in, n_in > 0 ? in_sizes[0] : -1, out_size, ws_size, (size_t)WS_END); grid = -1; return; }
        int dev = 0, cus = 0, per_cu = 0;
        if (hipGetDevice(&dev) != hipSuccess || hipDeviceGetAttribute(&cus, hipDeviceAttributeMultiprocessorCount, dev) != hipSuccess) { fprintf(stderr, "kernel_launch: device query failed\n"); grid = -1; return; }
        if (hipFuncSetAttribute((const void*)mk_fwd, hipFuncAttributeMaxDynamicSharedMemorySize, LDS_BYTES) != hipSuccess) { fprintf(stderr, "kernel_launch: hipFuncSetAttribute failed\n"); grid = -1; return; }
        if (hipOccupancyMaxActiveBlocksPerMultiprocessor(&per_cu, (const void*)mk_fwd, NWAVES * 64, LDS_BYTES) != hipSuccess || per_cu < 1) { fprintf(stderr, "kernel_launch: occupancy query reports %d workgroups per CU\n", per_cu); }
        (void)hipGetLastError();
        grid = cus;
    }
    if (grid < 0) return;
    if (hipMemsetAsync((char*)d_ws + WS_CTL, 0, CTL_ZERO_BYTES, stream) != hipSuccess) { fprintf(stderr, "kernel_launch: hipMemsetAsync failed\n"); return; }
    Args a{};
    for (int i = 0; i < 16; ++i) a.in[i] = (const float*)d_in[i];
    a.out = (float*)d_out; a.ws = (unsigned char*)d_ws;
#if MK_PER_PHASE
    for (int ph = 0; ph < N_PHASES; ++ph) { a.ph_lo = ph; a.ph_hi = ph + 1; hipLaunchKernelGGL(mk_fwd, dim3(grid), dim3(NWAVES * 64), LDS_BYTES, stream, a); }
#else
    a.ph_lo = 0; a.ph_hi = N_PHASES;
    hipLaunchKernelGGL(mk_fwd, dim3(grid), dim3(NWAVES * 64), LDS_BYTES, stream, a);
#endif
    const hipError_t le = hipPeekAtLastError();
    if (le != hipSuccess) fprintf(stderr, "kernel_launch: launch failed: %s\n", hipGetErrorName(le));
}
```

```cpp
#include <hip/hip_runtime.h>
#include <cstdio>
#include <cstdint>
namespace pg8 {
#define PG8_LAS __attribute__((address_space(3)))
typedef unsigned short bf16_t;
typedef short bf16x8 __attribute__((ext_vector_type(8)));
typedef float f32x4 __attribute__((ext_vector_type(4)));
typedef unsigned u32x4 __attribute__((ext_vector_type(4)));
constexpr int BM = 256, BK = 64, HALF = 128, HTB = HALF * BK * 2  , STAGE_BYTES = 8 * HTB, NXCD = 8, WGM = 8;

__host__ __device__ __forceinline__ int lds_byte(int r, int c) { const int st = (r >> 4) * 2 + (c >> 5), rr = r & 15, cc = c & 31, ob = rr * 64 + cc * 2; return st * 1024 + (ob ^ (((ob >> 9) & 1) << 5)); }
__host__ __device__ __forceinline__ void stage_rc(int b, int& R, int& C) { const int st = b / 1024, sb = b % 1024, swz = sb ^ (((sb >> 9) & 1) << 5); R = (st >> 1) * 16 + swz / 64; C = (st & 1) * 32 + (swz % 64) / 2; }
__host__ __device__ __forceinline__ int perm32(int rho) { const int n = rho >> 4, i = rho & 15; return 8 * (i >> 2) + 4 * n + (i & 3); }

struct Unit { int pm, pn; };
struct Gemm { const bf16_t* A; const bf16_t* Bt; int M, N, K; };

struct StaticOrder {
    int nM, nN, nwg, G, c;
    __host__ __device__ void init(int M, int N, int G_, int c_) { nM = M / BM; nN = N / BM; nwg = nM * nN; G = G_; c = c_; }
    __host__ __device__ bool next(int i, Unit& u) const {
        const long L = (long)i * G + c; if (L >= nwg) return false;
        int wgid = (int)L; { const int q = nwg / NXCD, r = nwg % NXCD, xcd = wgid % NXCD, off = wgid / NXCD; wgid = (xcd < r ? xcd * (q + 1) : r * (q + 1) + (xcd - r) * q) + off; }
        const int nig = WGM * nN, gid = wgid / nig, fm = gid * WGM, gsz = (nM - fm) < WGM ? (nM - fm) : WGM;
        u.pm = fm + ((wgid % nig) % gsz); u.pn = (wgid % nig) / gsz; return true;
    }
    __device__ __forceinline__ void a_ready(const Unit&) const {}
    __device__ __forceinline__ void done(const Unit&) const {}
};

__device__ __forceinline__ unsigned cvt_pk_bf16(float lo, float hi) { unsigned r; asm volatile("v_cvt_pk_bf16_f32 %0, %1, %2" : "=v"(r) : "v"(lo), "v"(hi)); return r; }
typedef float f32x2 __attribute__((ext_vector_type(2)));
typedef unsigned u32x2 __attribute__((ext_vector_type(2)));
__device__ __forceinline__ float bf_lo(unsigned w) { return __builtin_bit_cast(float, w << 16); }
__device__ __forceinline__ float bf_hi(unsigned w) { return __builtin_bit_cast(float, w & 0xffff0000u); }
__device__ __forceinline__ float gelu_tanh_f(float x) {
    const float x2 = x * x, t = x * (-2.302208198f + (-0.1029432397f) * x2);
    return x * __builtin_amdgcn_rcpf(1.0f + __builtin_amdgcn_exp2f(t));
}
__device__ __forceinline__ u32x4 pack8(const f32x4 v0, const f32x4 v1) { u32x4 w; w.x = cvt_pk_bf16(v0[0], v0[1]); w.y = cvt_pk_bf16(v0[2], v0[3]); w.z = cvt_pk_bf16(v1[0], v1[1]); w.w = cvt_pk_bf16(v1[2], v1[3]); return w; }
struct EpiInProj {
    static constexpr bool PERM = true, AFTER_DRAIN = false;
    bf16_t* O; int ldc; int gelu_tiles, q_tiles; float qscale;
    __device__ __forceinline__ void operator()(const f32x4 (&acc)[2][2][4][2], const Unit& u, int wr, int wc, int fr, int fq) const {
        const int row0 = u.pm * BM + wr * 64 + fr, col0 = u.pn * BM + wc * 32 + 8 * fq;
        const int mode = u.pn < gelu_tiles ? 1 : (u.pn < q_tiles ? 2 : 0);
#pragma unroll
        for (int ai = 0; ai < 2; ++ai)
#pragma unroll
            for (int m = 0; m < 4; ++m) { bf16_t* rowp = O + (size_t)(row0 + ai * HALF + m * 16) * ldc + col0;
#pragma unroll
                for (int bj = 0; bj < 2; ++bj) { f32x4 v0 = acc[ai][bj][m][0], v1 = acc[ai][bj][m][1];
                    if (mode == 1) {
#pragma unroll
                        for (int e = 0; e < 4; ++e) { v0[e] = gelu_tanh_f(v0[e]); v1[e] = gelu_tanh_f(v1[e]); } }
                    else if (mode == 2) { v0 = v0 * qscale; v1 = v1 * qscale; }
                    *(u32x4*)(rowp + bj * HALF) = pack8(v0, v1); } }
    }
};
struct EpiPlainBf16 {
    static constexpr bool PERM = true, AFTER_DRAIN = false;
    bf16_t* O; int ldc;
    __device__ __forceinline__ void operator()(const f32x4 (&acc)[2][2][4][2], const Unit& u, int wr, int wc, int fr, int fq) const {
        const int row0 = u.pm * BM + wr * 64 + fr, col0 = u.pn * BM + wc * 32 + 8 * fq;
#pragma unroll
        for (int ai = 0; ai < 2; ++ai)
#pragma unroll
            for (int m = 0; m < 4; ++m) { bf16_t* rowp = O + (size_t)(row0 + ai * HALF + m * 16) * ldc + col0;
#pragma unroll
                for (int bj = 0; bj < 2; ++bj) *(u32x4*)(rowp + bj * HALF) = pack8(acc[ai][bj][m][0], acc[ai][bj][m][1]); }
    }
};
struct EpiRes1 {
    static constexpr bool PERM = true, AFTER_DRAIN = false;
    const float* base; bf16_t* hb; float* ssq; int ldc;
    __device__ __forceinline__ void operator()(const f32x4 (&acc)[2][2][4][2], const Unit& u, int wr, int wc, int fr, int fq) const {
        const int row0 = u.pm * BM + wr * 64 + fr, col0 = u.pn * BM + wc * 32 + 8 * fq;
#pragma unroll
        for (int ai = 0; ai < 2; ++ai)
#pragma unroll
            for (int m = 0; m < 4; ++m) { const int row = row0 + ai * HALF + m * 16; const size_t off = (size_t)row * ldc + col0; float s = 0.f;
#pragma unroll
                for (int bj = 0; bj < 2; ++bj) {
                    const f32x4 h0 = *(const f32x4*)(base + off + bj * HALF) + acc[ai][bj][m][0], h1 = *(const f32x4*)(base + off + bj * HALF + 4) + acc[ai][bj][m][1];
                    s += (h0[0] * h0[0] + h0[1] * h0[1]) + (h0[2] * h0[2] + h0[3] * h0[3]) + (h1[0] * h1[0] + h1[1] * h1[1]) + (h1[2] * h1[2] + h1[3] * h1[3]);
                    *(u32x4*)(hb + off + bj * HALF) = pack8(h0, h1); }
                s += __shfl_xor(s, 16); s += __shfl_xor(s, 32);
                if (fq == 0) atomicAdd(ssq + row, s);
                if (m & 1) asm volatile("" ::: "memory"); }
    }
};
struct EpiRes2 {
    static constexpr bool PERM = true, AFTER_DRAIN = false;
    bf16_t* hb; float* ssq; int ldc;
    __device__ __forceinline__ void operator()(const f32x4 (&acc)[2][2][4][2], const Unit& u, int wr, int wc, int fr, int fq) const {
        const int row0 = u.pm * BM + wr * 64 + fr, col0 = u.pn * BM + wc * 32 + 8 * fq;
#pragma unroll
        for (int ai = 0; ai < 2; ++ai)
#pragma unroll
            for (int m = 0; m < 4; ++m) { const int row = row0 + ai * HALF + m * 16; const size_t off = (size_t)row * ldc + col0; float s = 0.f;
#pragma unroll
                for (int bj = 0; bj < 2; ++bj) { const u32x4 bw = *(const u32x4*)(hb + off + bj * HALF);
                    const f32x4 h0 = (f32x4){bf_lo(bw.x), bf_hi(bw.x), bf_lo(bw.y), bf_hi(bw.y)} + acc[ai][bj][m][0], h1 = (f32x4){bf_lo(bw.z), bf_hi(bw.z), bf_lo(bw.w), bf_hi(bw.w)} + acc[ai][bj][m][1];
                    s += (h0[0] * h0[0] + h0[1] * h0[1]) + (h0[2] * h0[2] + h0[3] * h0[3]) + (h1[0] * h1[0] + h1[1] * h1[1]) + (h1[2] * h1[2] + h1[3] * h1[3]);
                    *(u32x4*)(hb + off + bj * HALF) = pack8(h0, h1); }
                s += __shfl_xor(s, 16); s += __shfl_xor(s, 32);
                if (fq == 0) atomicAdd(ssq + row, s);
                if (m & 1) asm volatile("" ::: "memory"); }
    }
};
struct EpiUp {
    static constexpr bool PERM = true, AFTER_DRAIN = false;
    bf16_t* O; int ldc; const float* ssq; float inv_n, eps;
    __device__ __forceinline__ void operator()(const f32x4 (&acc)[2][2][4][2], const Unit& u, int wr, int wc, int fr, int fq) const {
        const int row0 = u.pm * BM + wr * 64 + fr, col0 = u.pn * BM + wc * 32 + 8 * fq;
#pragma unroll
        for (int ai = 0; ai < 2; ++ai)
#pragma unroll
            for (int m = 0; m < 4; ++m) { const int row = row0 + ai * HALF + m * 16; bf16_t* rowp = O + (size_t)row * ldc + col0;
                const float r2 = 1.0f / (ssq[row] * inv_n + eps);
#pragma unroll
                for (int bj = 0; bj < 2; ++bj) { f32x4 v0 = acc[ai][bj][m][0], v1 = acc[ai][bj][m][1];
#pragma unroll
                    for (int e = 0; e < 4; ++e) { const float a = fmaxf(v0[e], 0.f), b = fmaxf(v1[e], 0.f); v0[e] = a * a * r2; v1[e] = b * b * r2; }
                    *(u32x4*)(rowp + bj * HALF) = pack8(v0, v1); } }
    }
};
struct EpiGate {
    static constexpr bool PERM = true, AFTER_DRAIN = false;
    float* out; const bf16_t* hb; const bf16_t* E; const float* ssq_in; float* ssq_out; int ldc; float inv_n, eps;
    __device__ __forceinline__ void operator()(const f32x4 (&acc)[2][2][4][2], const Unit& u, int wr, int wc, int fr, int fq) const {
        const int row0 = u.pm * BM + wr * 64 + fr, col0 = u.pn * BM + wc * 32 + 8 * fq;
#pragma unroll
        for (int ai = 0; ai < 2; ++ai)
#pragma unroll
            for (int m = 0; m < 4; ++m) { const int row = row0 + ai * HALF + m * 16; const size_t off = (size_t)row * ldc + col0; float s = 0.f;
                const float nr = -1.4426950408889634f / sqrtf(ssq_in[row] * inv_n + eps);
#pragma unroll
                for (int bj = 0; bj < 2; ++bj) {
                    const u32x4 ew = *(const u32x4*)(E + off + bj * HALF), bw = *(const u32x4*)(hb + off + bj * HALF);
                    f32x4 h0 = (f32x4){bf_lo(bw.x), bf_hi(bw.x), bf_lo(bw.y), bf_hi(bw.y)}, h1 = (f32x4){bf_lo(bw.z), bf_hi(bw.z), bf_lo(bw.w), bf_hi(bw.w)};
                    const f32x4 a0 = acc[ai][bj][m][0], a1 = acc[ai][bj][m][1];
                    const float e0[4] = {bf_lo(ew.x), bf_hi(ew.x), bf_lo(ew.y), bf_hi(ew.y)}, e1[4] = {bf_lo(ew.z), bf_hi(ew.z), bf_lo(ew.w), bf_hi(ew.w)};
#pragma unroll
                    for (int e = 0; e < 4; ++e) {
                        h0[e] += __builtin_amdgcn_rcpf(1.0f + __builtin_amdgcn_exp2f(nr * a0[e])) * e0[e];
                        h1[e] += __builtin_amdgcn_rcpf(1.0f + __builtin_amdgcn_exp2f(nr * a1[e])) * e1[e]; }
                    *(f32x4*)(out + off + bj * HALF) = h0; *(f32x4*)(out + off + bj * HALF + 4) = h1;
                    s += (h0[0] * h0[0] + h0[1] * h0[1]) + (h0[2] * h0[2] + h0[3] * h0[3]) + (h1[0] * h1[0] + h1[1] * h1[1]) + (h1[2] * h1[2] + h1[3] * h1[3]); }
                s += __shfl_xor(s, 16); s += __shfl_xor(s, 32);
                if (fq == 0) atomicAdd(ssq_out + row, s);
                if (m & 1) asm volatile("" ::: "memory"); }
    }
};
template <class Epi, class Sched, bool ALIGN_EPI = false, bool SP2 = false, bool TILED = false>
__device__ __forceinline__ void gemm_phase(PG8_LAS unsigned char* lds, const Gemm g, const Sched& S, const Epi& E) {
    const int tid = threadIdx.x, wid = __builtin_amdgcn_readfirstlane(tid >> 6), lane = tid & 63, wr = wid >> 2, wc = wid & 3, fr = lane & 15, fq = lane >> 4;
    const int K = g.K, nt = K / BK;
    unsigned voffA[2], voffB[2];
#pragma unroll
    for (int i = 0; i < 2; ++i) { int R, C; stage_rc(tid * 16 + i * 8192, R, C); const int Rb = Epi::PERM ? ((R & ~31) + perm32(R & 31)) : R;
        voffA[i] = (unsigned)(R * K + C) * 2u; voffB[i] = (unsigned)(Rb * K + C) * 2u;
        if (TILED) { voffA[i] = voffB[i] = (unsigned)(tid * 16 + i * 8192); } }
    const size_t kstep = TILED ? (size_t)HTB : (size_t)(BK * 2);
    const size_t hstep = (size_t)HALF * K * 2;
    const size_t tstep = 2 * hstep;
    const unsigned ldsw = (unsigned)wid * 1024u;
    const int aoff = lds_byte(wr * 64 + fr, fq * 8), boff = lds_byte(wc * 32 + fr, fq * 8);
#define PG8_SA(b, h) (((b) * 2 + (h)) * HTB)
#define PG8_SB(b, h) ((4 + (b) * 2 + (h)) * HTB)
#define PG8_STAGE(bufoff, gbase, voff) do { _Pragma("unroll") for (int _i = 0; _i < 2; ++_i) \
        __builtin_amdgcn_global_load_lds((const unsigned*)((const char*)(gbase) + (voff)[_i]), (PG8_LAS unsigned*)(lds + (bufoff) + ldsw + _i * 8192), 16, 0, 0); } while (0)
#define PG8_LDA(dst, b, h) do { _Pragma("unroll") for (int m = 0; m < 4; ++m) _Pragma("unroll") for (int k = 0; k < 2; ++k) dst[m][k] = *(const PG8_LAS bf16x8*)(lds + PG8_SA(b, h) + aoff + m * 2048 + k * 1024); } while (0)
#define PG8_LDB(dst, b, h) do { _Pragma("unroll") for (int n = 0; n < 2; ++n) _Pragma("unroll") for (int k = 0; k < 2; ++k) dst[n][k] = *(const PG8_LAS bf16x8*)(lds + PG8_SB(b, h) + boff + n * 2048 + k * 1024); } while (0)
#define PG8_MMA(ai, bj, At, Bt) do { __builtin_amdgcn_s_setprio(1); _Pragma("unroll") for (int m = 0; m < 4; ++m) _Pragma("unroll") for (int n = 0; n < 2; ++n) _Pragma("unroll") for (int k = 0; k < 2; ++k) \
        acc[ai][bj][m][n] = __builtin_amdgcn_mfma_f32_16x16x32_bf16(Bt[n][k], At[m][k], acc[ai][bj][m][n], 0, 0, 0); __builtin_amdgcn_s_setprio(0); } while (0)
#define PG8_WAIT_V(n) asm volatile("s_waitcnt vmcnt(" #n ")" ::: "memory")
#define PG8_WAIT_L(n) asm volatile("s_waitcnt lgkmcnt(" #n ")" ::: "memory")
#define PG8_BAR __builtin_amdgcn_s_barrier()
#define PG8_SCHED __builtin_amdgcn_sched_barrier(0)
    Unit cur, nxt; int ui = 0;
    if (!S.next(0, cur)) return;
    f32x4 acc[2][2][4][2];
#pragma unroll
    for (int a = 0; a < 2; ++a)
#pragma unroll
        for (int b = 0; b < 2; ++b)
#pragma unroll
            for (int m = 0; m < 4; ++m)
#pragma unroll
                for (int n = 0; n < 2; ++n) acc[a][b][m][n] = (f32x4){0.f, 0.f, 0.f, 0.f};
    bf16x8 At[4][2], B0[2][2], B1[2][2];
    const char* cA = (const char*)g.A + (size_t)cur.pm * tstep; const char* cB = (const char*)g.Bt + (size_t)cur.pn * tstep;
    S.a_ready(cur);
    if constexpr (SP2) {
        PG8_STAGE(PG8_SB(0, 0), cB, voffB); PG8_STAGE(PG8_SB(0, 1), cB + hstep, voffB); PG8_STAGE(PG8_SA(0, 0), cA, voffA); PG8_STAGE(PG8_SA(0, 1), cA + hstep, voffA);
        if (wr == 1) PG8_BAR;
        PG8_WAIT_V(2); PG8_BAR;
        PG8_STAGE(PG8_SB(1, 0), cB + kstep, voffB); PG8_STAGE(PG8_SA(1, 0), cA + kstep, voffA); PG8_STAGE(PG8_SB(1, 1), cB + hstep + kstep, voffB);
        PG8_WAIT_V(6); PG8_BAR;
    } else {
        PG8_STAGE(PG8_SB(0, 0), cB, voffB); PG8_STAGE(PG8_SA(0, 0), cA, voffA); PG8_STAGE(PG8_SB(0, 1), cB + hstep, voffB); PG8_STAGE(PG8_SA(0, 1), cA + hstep, voffA);
        if (wr == 1) PG8_BAR;
        PG8_WAIT_V(4); PG8_BAR;
        PG8_STAGE(PG8_SB(1, 0), cB + kstep, voffB); PG8_STAGE(PG8_SA(1, 0), cA + kstep, voffA); PG8_STAGE(PG8_SB(1, 1), cB + hstep + kstep, voffB);
        PG8_WAIT_V(6); PG8_BAR;
    }
    for (;;) {
        const bool has_next = S.next(ui + 1, nxt);
        const char* nA = has_next ? (const char*)g.A + (size_t)nxt.pm * tstep : cA; const char* nB = has_next ? (const char*)g.Bt + (size_t)nxt.pn * tstep : cB;
        for (int t = 0; t < nt; t += 2) {
            const bool last = (t == nt - 2);
            const char* a1 = cA + (size_t)(t + 1) * kstep;
            const char* a2 = last ? nA : cA + (size_t)(t + 2) * kstep; const char* b2 = last ? nB : cB + (size_t)(t + 2) * kstep;
            const char* a3 = a2 + kstep; const char* b3 = b2 + kstep;
            if (last && has_next) S.a_ready(nxt);
            if constexpr (SP2) {
            PG8_LDB(B0, 0, 0); PG8_LDB(B1, 0, 1); PG8_SCHED; PG8_LDA(At, 0, 0); PG8_STAGE(PG8_SA(1, 1), a1 + hstep, voffA);
            PG8_WAIT_V(8); PG8_WAIT_L(0); PG8_BAR; PG8_MMA(0, 0, At, B0); PG8_MMA(0, 1, At, B1); PG8_BAR; PG8_SCHED;
            PG8_LDA(At, 0, 1); PG8_STAGE(PG8_SB(0, 0), b2, voffB); PG8_STAGE(PG8_SB(0, 1), b2 + hstep, voffB); PG8_STAGE(PG8_SA(0, 0), a2, voffA);
            PG8_WAIT_V(8); PG8_WAIT_L(0); PG8_BAR; PG8_MMA(1, 0, At, B0); PG8_MMA(1, 1, At, B1); PG8_BAR; PG8_SCHED;
            PG8_LDB(B0, 1, 0); PG8_LDB(B1, 1, 1); PG8_SCHED; PG8_LDA(At, 1, 0); PG8_STAGE(PG8_SA(0, 1), a2 + hstep, voffA);
            PG8_WAIT_V(8); PG8_WAIT_L(0); PG8_BAR; PG8_MMA(0, 0, At, B0); PG8_MMA(0, 1, At, B1); PG8_BAR; PG8_SCHED;
            PG8_LDA(At, 1, 1); PG8_STAGE(PG8_SB(1, 0), b3, voffB); PG8_STAGE(PG8_SB(1, 1), b3 + hstep, voffB); PG8_STAGE(PG8_SA(1, 0), a3, voffA);
            PG8_WAIT_V(8); PG8_WAIT_L(0); PG8_BAR; PG8_MMA(1, 0, At, B0); PG8_MMA(1, 1, At, B1); PG8_BAR; PG8_SCHED;
            } else {
            PG8_LDB(B0, 0, 0); PG8_SCHED; PG8_LDA(At, 0, 0); PG8_STAGE(PG8_SA(1, 1), a1 + hstep, voffA);
            PG8_WAIT_L(8); PG8_BAR; PG8_WAIT_L(0); PG8_MMA(0, 0, At, B0); PG8_BAR; PG8_SCHED;
            PG8_LDB(B1, 0, 1); PG8_STAGE(PG8_SB(0, 0), b2, voffB);
            PG8_BAR; PG8_WAIT_L(0); PG8_MMA(0, 1, At, B1); PG8_BAR;
            PG8_LDA(At, 0, 1); PG8_STAGE(PG8_SA(0, 0), a2, voffA);
            PG8_BAR; PG8_WAIT_L(0); PG8_MMA(1, 0, At, B0); PG8_BAR; PG8_SCHED;
            PG8_STAGE(PG8_SB(0, 1), b2 + hstep, voffB);
            PG8_WAIT_V(6); PG8_BAR; PG8_MMA(1, 1, At, B1); PG8_BAR;
            PG8_LDB(B0, 1, 0); PG8_SCHED; PG8_LDA(At, 1, 0); PG8_STAGE(PG8_SA(0, 1), a2 + hstep, voffA);
            PG8_WAIT_L(8); PG8_BAR; PG8_WAIT_L(0); PG8_MMA(0, 0, At, B0); PG8_BAR; PG8_SCHED;
            PG8_LDB(B1, 1, 1); PG8_STAGE(PG8_SB(1, 0), b3, voffB);
            PG8_BAR; PG8_WAIT_L(0); PG8_MMA(0, 1, At, B1); PG8_BAR;
            PG8_LDA(At, 1, 1); PG8_STAGE(PG8_SA(1, 0), a3, voffA);
            PG8_BAR; PG8_WAIT_L(0); PG8_MMA(1, 0, At, B0); PG8_BAR; PG8_SCHED;
            PG8_STAGE(PG8_SB(1, 1), b3 + hstep, voffB);
            PG8_WAIT_V(6); PG8_BAR; PG8_MMA(1, 1, At, B1); PG8_BAR;
            }
        }
        if constexpr (ALIGN_EPI) { if (wr == 0) PG8_BAR; }
        if constexpr (!Epi::AFTER_DRAIN) { E(acc, cur, wr, wc, fr, fq); S.done(cur); }
        if (!has_next) break;
#pragma unroll
        for (int a = 0; a < 2; ++a)
#pragma unroll
            for (int b = 0; b < 2; ++b)
#pragma unroll
                for (int m = 0; m < 4; ++m)
#pragma unroll
                    for (int n = 0; n < 2; ++n) acc[a][b][m][n] = (f32x4){0.f, 0.f, 0.f, 0.f};
        cur = nxt; cA = nA; cB = nB; ++ui;
        if constexpr (ALIGN_EPI) { if (wr == 1) PG8_BAR; }
    }
    PG8_WAIT_V(0);
    if constexpr (!ALIGN_EPI) { if (wr == 0) PG8_BAR; }
    PG8_BAR;
    if constexpr (Epi::AFTER_DRAIN) { E.fused(acc, cur, wr, wc, fr, fq, lds, wid, lane); S.done(cur); }
#undef PG8_SA
#undef PG8_SB
#undef PG8_STAGE
#undef PG8_LDA
#undef PG8_LDB
#undef PG8_MMA
#undef PG8_WAIT_V
#undef PG8_WAIT_L
#undef PG8_BAR
#undef PG8_SCHED
}
}
constexpr int NWAVES = 8;
constexpr int NB = 4, SEQ = 4096, DM = 4096, M = NB * SEQ, DIN = 10240, DFF = 16384, PLE = 256, AW = 2048, NH = 16, HD = 128, CH = 128;
constexpr float EPS = 1e-6f;
constexpr float QSCALE = 0.08838834764831845f;
constexpr size_t MiB = 1u << 20;
constexpr size_t WS_CTL = 0, CTL_ZERO_BYTES = 256 * 1024;
constexpr size_t WS_PBF = 1 * MiB;
constexpr size_t WS_WSB = 9 * MiB;
constexpr size_t WS_WIN = 10 * MiB, WS_WOUT = WS_WIN + 80 * MiB, WS_WUP = WS_WOUT + 32 * MiB, WS_WDN = WS_WUP + 128 * MiB, WS_WGT = WS_WDN + 128 * MiB, WS_WPJ = WS_WGT + 32 * MiB;
constexpr size_t WS_ACT = WS_WPJ + 2 * MiB;
constexpr size_t WS_Z = WS_ACT + 128 * MiB;
constexpr size_t WS_HID = WS_ACT;
constexpr size_t WS_HG = WS_ACT + 512 * MiB;
constexpr size_t WS_END = WS_HG + 128 * MiB;
static_assert(WS_Z + (size_t)M * DIN * 2 <= WS_HG && WS_HID + (size_t)M * DFF * 2 <= WS_HG && WS_WPJ + (size_t)DM * PLE * 2 <= WS_ACT && WS_PBF + (size_t)M * PLE * 2 <= WS_WSB, "d_ws map");
constexpr int CW_TMO = 0, CW_CODE = 1;
constexpr int CW_BAR = 4096;
constexpr int CW_SSQ1 = 16384, CW_SSQ2 = 32768, CW_SSQ3 = 49152;
static_assert((CW_SSQ3 + M) * 4 <= (int)CTL_ZERO_BYTES, "CTL words inside the memset region");
constexpr int RING_OFF = 0, RING_BYTES = 131072;
constexpr int LDS_BYTES = 147456;
constexpr int LDSCTL_OFF = LDS_BYTES - 1024, MISC_OFF = LDSCTL_OFF + 320;
static_assert(MISC_OFF + 128 <= LDS_BYTES, "LDS map");

#define GAS __attribute__((address_space(1)))
#define LAS __attribute__((address_space(3)))
typedef unsigned short bf16;
typedef unsigned v4u __attribute__((ext_vector_type(4)));
typedef float f32x4 __attribute__((ext_vector_type(4)));
typedef short bf16x8 __attribute__((ext_vector_type(8)));
typedef GAS unsigned gu32;
typedef GAS unsigned long long gu64;
#define RLX_AGENT __ATOMIC_RELAXED, __HIP_MEMORY_SCOPE_AGENT
#define LDS_WAIT() asm volatile("s_waitcnt lgkmcnt(0)" ::: "memory")
#define VM_WAIT() asm volatile("s_waitcnt vmcnt(0)" ::: "memory")
__device__ __forceinline__ unsigned long long rt() { return __builtin_amdgcn_s_memrealtime(); }
__device__ __forceinline__ unsigned f2bf(float f) { unsigned u = __builtin_bit_cast(unsigned, f); return (u + 0x7fffu + ((u >> 16) & 1u)) >> 16; }
__device__ __forceinline__ unsigned pk2(float lo, float hi) { return f2bf(lo) | (f2bf(hi) << 16); }
#define XB_TMO      128
#define XB_XCNT(j)  (256  + 64 * (j))
#define XB_XSUB(j)  (1280 + 64 * (j))
#define XB_XGEN(j)  (2304 + 64 * (j))
#define XB_TOP      3328
#define XB_TOPGEN   3392
#define XCD_BAR_WORDS 3456
#define XB_SPIN_CAP (1u << 18)

__device__ __forceinline__ unsigned xb_ld(unsigned* p)              { return __hip_atomic_load(p, __ATOMIC_RELAXED, __HIP_MEMORY_SCOPE_AGENT); }
__device__ __forceinline__ unsigned xb_add(unsigned* p, unsigned v) { return __hip_atomic_fetch_add(p, v, __ATOMIC_RELAXED, __HIP_MEMORY_SCOPE_AGENT); }
__device__ __forceinline__ unsigned xb_xcc_id() { return (unsigned)__builtin_amdgcn_s_getreg((3 << 11) | 20) & 0xFu; }
#define XB_SPIN(cond, bar) do { unsigned _sp = 0; while (cond) { __builtin_amdgcn_s_sleep(1); \
    if ((++_sp & 255u) == 0u) { if (xb_ld(&(bar)[XB_TMO])) break; if (_sp > XB_SPIN_CAP) { atomicAdd(&(bar)[XB_TMO], 1u); break; } } } } while (0)

struct XcdBarrier {
    unsigned* bar; unsigned x;
    volatile LAS unsigned* st;
};

__device__ __forceinline__ XcdBarrier xcd_barrier_post(unsigned* bar, volatile LAS unsigned* st) {
    XcdBarrier b; b.bar = bar; b.x = xb_xcc_id(); b.st = st;
    if (threadIdx.x == 0) (void)xb_add(&bar[XB_XCNT(b.x)], 1u);
    return b;
}
__device__ __forceinline__ void xcd_barrier_complete(unsigned* bar, unsigned x, unsigned& nloc, unsigned& nx) {
    const unsigned G = gridDim.x * gridDim.y * gridDim.z;
    unsigned sum, cnt, mine, sp = 0u;
    for (;;) {
        sum = 0u; cnt = 0u; mine = 0u;
#pragma unroll
        for (unsigned j = 0; j < 16; ++j) { const unsigned c = xb_ld(&bar[XB_XCNT(j)]); sum += c; cnt += (c > 0u) ? 1u : 0u; mine = (j == x) ? c : mine; }
        if (sum == G) break;
        __builtin_amdgcn_s_sleep(1);
        if ((++sp & 255u) == 0u) { if (xb_ld(&bar[XB_TMO])) break; if (sp > XB_SPIN_CAP) { atomicAdd(&bar[XB_TMO], 1u); break; } }
    }
    nloc = mine > 0u ? mine : 1u; nx = cnt > 0u ? cnt : 1u;
}

__device__ __forceinline__ void xcd_barrier(const XcdBarrier& b) {
    asm volatile("s_waitcnt vmcnt(0)" ::: "memory");
    __syncthreads();
    if (threadIdx.x == 0) {
        unsigned* bar = b.bar;
        __builtin_amdgcn_s_waitcnt(0);
        unsigned nloc = b.st[0], nx = b.st[1];
        if (nloc == 0u) { xcd_barrier_complete(bar, b.x, nloc, nx); b.st[0] = nloc; b.st[1] = nx; }
        const unsigned old = xb_add(&bar[XB_XSUB(b.x)], 1u);
        const unsigned gen = old / nloc;
        if (old + 1u == (gen + 1u) * nloc) {
            __builtin_amdgcn_fence(__ATOMIC_RELEASE, "agent");
            asm volatile("s_waitcnt vmcnt(0)" ::: "memory");
            const unsigned og = xb_add(&bar[XB_TOP], 1u);
            const unsigned tg = og / nx;
            if (og + 1u == (tg + 1u) * nx) xb_add(&bar[XB_TOPGEN], 1u);
            else XB_SPIN(xb_ld(&bar[XB_TOPGEN]) == tg, bar);
            __builtin_amdgcn_fence(__ATOMIC_ACQUIRE, "agent");
            xb_add(&bar[XB_XGEN(b.x)], 1u);
            asm volatile("s_waitcnt vmcnt(0)" ::: "memory");
        } else {
            XB_SPIN(xb_ld(&bar[XB_XGEN(b.x)]) == gen, bar);
            __builtin_amdgcn_fence(__ATOMIC_ACQUIRE, "agent");
            asm volatile("s_waitcnt vmcnt(0)" ::: "memory");
        }
    }
    __syncthreads();
}

struct Frame {
    LAS unsigned char* lds;
    volatile LAS unsigned* MISC;
    gu32* ctl;
    int tid, lane, wave;
    int vcu, G;
};
__device__ __forceinline__ float wave_sum(float v) {
#pragma unroll
    for (int o = 1; o < 64; o <<= 1) v += __shfl_xor(v, o);
    return v;
}
__device__ __forceinline__ float bf2f(unsigned short h) { return __builtin_bit_cast(float, (unsigned)h << 16); }
__device__ __forceinline__ void p0_transpose_item(const float* W, int K, int N, bf16* WT, LAS float* scr, int item, int lane, const float* kg = nullptr) {
    const int nblk = N / 32, kb = item / nblk, nb = item % nblk, k0 = 64 * kb, n0 = 32 * nb;
#pragma unroll 8
    for (int i = 0; i < 32; ++i) { const int kk = 2 * i + (lane >> 5); scr[kk * 33 + (lane & 31)] = W[(size_t)(k0 + kk) * N + n0 + (lane & 31)]; }
    LDS_WAIT(); asm volatile("" ::: "memory");
    const int c = lane & 7;
#pragma unroll
    for (int j = 0; j < 4; ++j) { const int n = (lane >> 3) + 8 * j; const LAS float* s = scr + (8 * c) * 33 + n;
        f32x4 g0 = {1.f, 1.f, 1.f, 1.f}, g1 = g0; if (kg) { g0 = *(const GAS f32x4*)(kg + k0 + 8 * c); g1 = *(const GAS f32x4*)(kg + k0 + 8 * c + 4); }
        v4u o; o.x = pk2(s[0 * 33] * g0.x, s[1 * 33] * g0.y); o.y = pk2(s[2 * 33] * g0.z, s[3 * 33] * g0.w); o.z = pk2(s[4 * 33] * g1.x, s[5 * 33] * g1.y); o.w = pk2(s[6 * 33] * g1.z, s[7 * 33] * g1.w);
        *(GAS v4u*)(WT + (size_t)(n0 + n) * K + k0 + 8 * c) = o; }
    LDS_WAIT(); asm volatile("" ::: "memory");
}
__device__ __forceinline__ void rms_row_to_bf16(int lane, const float* xrow, const float* g, bf16* orow) {
    const GAS f32x4* xr = (const GAS f32x4*)xrow + lane; const GAS f32x4* gr = (const GAS f32x4*)g + lane;
    f32x4 v[16]; float s = 0.f;
#pragma unroll
    for (int j = 0; j < 16; ++j) { v[j] = xr[64 * j]; s += (v[j].x * v[j].x + v[j].y * v[j].y) + (v[j].z * v[j].z + v[j].w * v[j].w); }
    const float rstd = 1.f / sqrtf(wave_sum(s) * (1.f / DM) + EPS);
    GAS unsigned long long* o8 = (GAS unsigned long long*)orow + lane;
#pragma unroll
    for (int j = 0; j < 16; ++j) { const f32x4 gg = gr[64 * j];
        o8[64 * j] = (unsigned long long)pk2(v[j].x * rstd * gg.x, v[j].y * rstd * gg.y) | ((unsigned long long)pk2(v[j].z * rstd * gg.z, v[j].w * rstd * gg.w) << 32); }
}
__device__ __forceinline__ void final_row(int lane, float* xrow, const float* g, float ssq, float addv) {
    GAS f32x4* xr = (GAS f32x4*)xrow + lane; const GAS f32x4* gr = (const GAS f32x4*)g + lane;
    const float rstd = 1.f / sqrtf(ssq * (1.f / DM) + EPS);
#pragma unroll
    for (int j = 0; j < 16; ++j) { f32x4 v = xr[64 * j]; const f32x4 gg = gr[64 * j]; v = v * rstd * gg + addv; xr[64 * j] = v; }
}

typedef float f32x16 __attribute__((ext_vector_type(16)));
typedef short s16x4 __attribute__((ext_vector_type(4)));
typedef short v4i16_t __attribute__((ext_vector_type(4)));
typedef float f32x2_t __attribute__((ext_vector_type(2))); typedef __bf16 bf16x2_t __attribute__((ext_vector_type(2)));
__device__ __forceinline__ unsigned cvtpk_s(float lo, float hi) { f32x2_t v = {lo, hi}; bf16x2_t b = __builtin_convertvector(v, bf16x2_t); return __builtin_bit_cast(unsigned, b); }
__device__ __forceinline__ s16x4 vtr(LAS const unsigned char* p) { return __builtin_bit_cast(s16x4, __builtin_amdgcn_ds_read_tr16_b64_v4i16((LAS v4i16_t*)p)); }
__device__ __forceinline__ int crow(int r, int hi) { return (r & 3) + 8 * (r >> 2) + 4 * hi; }
#define MFMA32(a, b, c) __builtin_amdgcn_mfma_f32_32x32x16_bf16((a), (b), (c), 0, 0, 0)
__device__ __forceinline__ float half_swap_sum(float v) { auto rr = __builtin_amdgcn_permlane32_swap(__float_as_uint(v), __float_as_uint(v), false, false); return __uint_as_float(rr[0]) + __uint_as_float(rr[1]); }
constexpr int KST = 272, VST = 320;
constexpr int WREG = 32 * VST;

__device__ __forceinline__ void head_norm_store(f32x16 (&o)[4], int lane, LAS unsigned char* wl, const float* gain, bf16* ydst) {
    const int tl = lane & 31, hh = lane >> 5, r4 = lane >> 4, c16 = lane & 15;
    float ss = 0.f;
#pragma unroll
    for (int dt = 0; dt < 4; ++dt)
#pragma unroll
        for (int r = 0; r < 16; ++r) ss += o[dt][r] * o[dt][r];
    ss = half_swap_sum(ss);
    const float rstd = 1.0f / sqrtf(ss * (1.0f / 128.0f) + EPS);
#pragma unroll
    for (int dt = 0; dt < 4; ++dt)
#pragma unroll
        for (int G = 0; G < 4; ++G) { const int d0 = 32 * dt + 8 * G + 4 * hh; const f32x4 g4 = *(const GAS f32x4*)(gain + d0);
            const unsigned w0 = cvtpk_s(o[dt][4 * G] * rstd * g4.x, o[dt][4 * G + 1] * rstd * g4.y), w1 = cvtpk_s(o[dt][4 * G + 2] * rstd * g4.z, o[dt][4 * G + 3] * rstd * g4.w);
            *(LAS unsigned long long*)(wl + tl * KST + 2 * d0) = (unsigned long long)w0 | ((unsigned long long)w1 << 32); }
#pragma unroll
    for (int i = 0; i < 8; ++i) { const int row = 4 * i + r4; const v4u w = *(LAS const v4u*)(wl + row * KST + 16 * c16);
        *(GAS v4u*)(ydst + (size_t)row * DM + 8 * c16) = w; }
}

__device__ __forceinline__ void attn_unit(int unit, int lane, LAS unsigned char* wl, const bf16* Z, const float* gb, bf16* Y) {
    const int qb = unit & 127, h = (unit >> 7) & 15, b = unit >> 11;
    const int t0 = qb * 32, tl = lane & 31, hh = lane >> 5, r4 = lane >> 4, c16 = lane & 15;
    const size_t rowb = (size_t)b * SEQ;
    bf16x8 qf[8];
    { const bf16* Qp = Z + (rowb + t0 + tl) * DIN + 2 * AW + h * HD + 8 * hh;
#pragma unroll
      for (int ks = 0; ks < 8; ++ks) qf[ks] = *(const GAS bf16x8*)(Qp + 16 * ks); }
    f32x16 o[4];
#pragma unroll
    for (int dt = 0; dt < 4; ++dt)
#pragma unroll
        for (int r = 0; r < 16; ++r) o[dt][r] = 0.f;
    float L2 = 0.f;
    const bf16* Kp = Z + (rowb + r4) * DIN + 3 * AW + h * HD + 8 * c16;
    const unsigned kw = r4 * KST + c16 * 16, kr = tl * KST + hh * 16, vw = r4 * VST + c16 * 16;
    const int q4 = (lane & 15) >> 2, p4 = lane & 3, blk = (lane >> 4) & 1;
    const unsigned vr = (4 * hh + q4) * VST + 2 * (16 * blk + 4 * p4);
    for (int j = 0; ; ++j) {
        const int s0 = t0 - 32 * j; if (s0 < 0) break;
        v4u kreg[8], vreg[8];
#pragma unroll
        for (int i = 0; i < 8; ++i) { kreg[i] = *(const GAS v4u*)(Kp + (size_t)(s0 + 4 * i) * DIN); vreg[i] = *(const GAS v4u*)(Kp + (size_t)(s0 + 4 * i) * DIN + AW); }
#pragma unroll
        for (int i = 0; i < 8; ++i) *(LAS v4u*)(wl + kw + i * 4 * KST) = kreg[i];
        f32x16 st;
#pragma unroll
        for (int r = 0; r < 16; ++r) st[r] = 0.f;
#pragma unroll
        for (int ks = 0; ks < 8; ++ks) { const bf16x8 kf = *(LAS const bf16x8*)(wl + kr + 32 * ks); st = MFMA32(kf, qf[ks], st); }
#pragma unroll
        for (int i = 0; i < 8; ++i) *(LAS v4u*)(wl + vw + i * 4 * VST) = vreg[i];
        const bool diag = (j == 0);
        float lk[16], ls[16];
#pragma unroll
        for (int r = 0; r < 16; ++r) { const float z = st[r];
            const float sp = fmaxf(z, 0.f) + __builtin_amdgcn_logf(1.0f + __builtin_amdgcn_exp2f(-fabsf(z)));
            const bool valid = !diag || (crow(r, hh) < tl);
            lk[r] = valid ? -sp : 0.f; ls[r] = z - sp; }
        float gs[4], T[4];
#pragma unroll
        for (int G = 0; G < 4; ++G) { gs[G] = (lk[4 * G] + lk[4 * G + 1]) + (lk[4 * G + 2] + lk[4 * G + 3]); T[G] = half_swap_sum(gs[G]); }
        const float SG2 = T[3], SG1 = SG2 + T[2], SG0 = SG1 + T[1];
        const float SG[4] = {SG0, SG1, SG2, 0.f};
        unsigned pw[8];
#pragma unroll
        for (int G = 0; G < 4; ++G) {
            float run = L2 + SG[G] + (hh == 0 ? (T[G] - gs[G]) : 0.f); float a[4];
#pragma unroll
            for (int i = 3; i >= 0; --i) { const int r = 4 * G + i; const float e = __builtin_amdgcn_exp2f(ls[r] + run);
                const bool valid = !diag || (crow(r, hh) < tl); a[i] = valid ? e : 0.f; run += lk[r]; }
            pw[2 * G] = cvtpk_s(a[0], a[1]); pw[2 * G + 1] = cvtpk_s(a[2], a[3]); }
        L2 += SG0 + T[0];
#pragma unroll
        for (int s2 = 0; s2 < 2; ++s2) { const v4u pv4 = {pw[4 * s2], pw[4 * s2 + 1], pw[4 * s2 + 2], pw[4 * s2 + 3]}; const bf16x8 pb = __builtin_bit_cast(bf16x8, pv4);
#pragma unroll
            for (int dt = 0; dt < 4; ++dt) { const s16x4 lo = vtr(wl + vr + (16 * s2) * VST + 64 * dt), hi = vtr(wl + vr + (16 * s2 + 8) * VST + 64 * dt);
                const bf16x8 va = __builtin_shufflevector(lo, hi, 0, 1, 2, 3, 4, 5, 6, 7);
                o[dt] = MFMA32(va, pb, o[dt]); } }
        if (__all(L2 < -150.5f)) break;
    }
    head_norm_store(o, lane, wl, gb + h * HD, Y + (rowb + t0) * DM + AW + h * HD);
}

__device__ __forceinline__ void sgu_unit(bool active, int unit, int wq, int lane, LAS unsigned char* vn, LAS unsigned char* wl, const bf16* Z, const bf16* WSB, const float* bs, const float* ga, bf16* Y) {
    const int h = unit % NH, nc = (unit / NH) % (SEQ / CH), b = unit / (NH * (SEQ / CH));
    const int tl = lane & 31, hh = lane >> 5, r4 = lane >> 4, c16 = lane & 15;
    const size_t row0 = (size_t)b * SEQ + nc * CH;
    if (active) {
#pragma unroll
        for (int i = 0; i < 8; ++i) { const int s = 32 * wq + 4 * i + r4;
            const v4u w = *(const GAS v4u*)(Z + (row0 + s) * DIN + AW + h * HD + 8 * c16);
            float v[8] = {pg8::bf_lo(w.x), pg8::bf_hi(w.x), pg8::bf_lo(w.y), pg8::bf_hi(w.y), pg8::bf_lo(w.z), pg8::bf_hi(w.z), pg8::bf_lo(w.w), pg8::bf_hi(w.w)};
            float s1 = ((v[0] + v[1]) + (v[2] + v[3])) + ((v[4] + v[5]) + (v[6] + v[7]));
#pragma unroll
            for (int o = 1; o < 16; o <<= 1) s1 += __shfl_xor(s1, o);
            const float mu = s1 * (1.0f / 128.0f); float s2 = 0.f;
#pragma unroll
            for (int e = 0; e < 8; ++e) { v[e] -= mu; s2 += v[e] * v[e]; }
#pragma unroll
            for (int o = 1; o < 16; o <<= 1) s2 += __shfl_xor(s2, o);
            const float rs = 1.0f / sqrtf(s2 * (1.0f / 128.0f) + EPS);
            v4u ow; ow.x = cvtpk_s(v[0] * rs, v[1] * rs); ow.y = cvtpk_s(v[2] * rs, v[3] * rs); ow.z = cvtpk_s(v[4] * rs, v[5] * rs); ow.w = cvtpk_s(v[6] * rs, v[7] * rs);
            *(LAS v4u*)(vn + s * 256 + ((16 * c16) ^ ((s & 3) << 6))) = ow; }
    }
    LDS_WAIT(); __syncthreads();
    if (active) {
        f32x16 o[4];
#pragma unroll
        for (int dt = 0; dt < 4; ++dt)
#pragma unroll
            for (int r = 0; r < 16; ++r) o[dt][r] = 0.f;
        const int q4 = (lane & 15) >> 2, p4 = lane & 3, blk = (lane >> 4) & 1;
        const bf16* Wrow = WSB + ((size_t)h * CH + 32 * wq + tl) * CH + 8 * hh;
        for (int sb = 0; sb <= wq; ++sb) {
#pragma unroll
            for (int s2 = 0; s2 < 2; ++s2) { const bf16x8 wf = *(const GAS bf16x8*)(Wrow + 32 * sb + 16 * s2);
                const int R = 32 * sb + 16 * s2 + 8 * hh + q4;
#pragma unroll
                for (int dt = 0; dt < 4; ++dt) { const unsigned xo = (unsigned)(64 * (dt ^ q4) + 32 * blk + 8 * p4);
                    const s16x4 lo = vtr(vn + R * 256 + xo), hi = vtr(vn + (R + 4) * 256 + xo);
                    const bf16x8 va = __builtin_shufflevector(lo, hi, 0, 1, 2, 3, 4, 5, 6, 7);
                    o[dt] = MFMA32(va, wf, o[dt]); } } }
#pragma unroll
        for (int i = 0; i < 8; ++i) { const int t = 4 * i + r4; const v4u w = *(const GAS v4u*)(Z + (row0 + 32 * wq + t) * DIN + h * HD + 8 * c16); *(LAS v4u*)(wl + t * KST + 16 * c16) = w; }
        const float bias = bs[h * CH + 32 * wq + tl];
#pragma unroll
        for (int dt = 0; dt < 4; ++dt)
#pragma unroll
            for (int G = 0; G < 4; ++G) { const int d0 = 32 * dt + 8 * G + 4 * hh; const unsigned long long uw = *(LAS const unsigned long long*)(wl + tl * KST + 2 * d0);
                const unsigned u0 = (unsigned)uw, u1 = (unsigned)(uw >> 32);
                o[dt][4 * G] = pg8::bf_lo(u0) * (o[dt][4 * G] + bias); o[dt][4 * G + 1] = pg8::bf_hi(u0) * (o[dt][4 * G + 1] + bias);
                o[dt][4 * G + 2] = pg8::bf_lo(u1) * (o[dt][4 * G + 2] + bias); o[dt][4 * G + 3] = pg8::bf_hi(u1) * (o[dt][4 * G + 3] + bias); }
        head_norm_store(o, lane, wl, ga + h * HD, Y + (row0 + 32 * wq) * DM + h * HD);
    }
    LDS_WAIT(); __syncthreads();
}

#if defined(MK_EXP)
constexpr int N_PHASES = 10;
#else
constexpr int N_PHASES = 9;
#endif
struct Args { const float* in[16]; float* out; unsigned char* ws; int ph_lo, ph_hi, li, pad; };
__global__ void __launch_bounds__(NWAVES * 64, 2) mk_fwd(Args args) {
    extern __shared__ __attribute__((aligned(16))) unsigned char lds[];
    Frame F;
    F.lds = (LAS unsigned char*)lds;
    F.MISC = (volatile LAS unsigned*)(F.lds + MISC_OFF);
    F.tid = threadIdx.x; F.lane = F.tid & 63; F.wave = __builtin_amdgcn_readfirstlane(F.tid >> 6);
    F.G = gridDim.x; { const int bx = blockIdx.x; F.vcu = (F.G % 8 == 0) ? (bx % 8) * (F.G / 8) + bx / 8 : bx; }
    unsigned char* ws = args.ws;
    F.ctl = (gu32*)(ws + WS_CTL);
    const float* x = args.in[0]; const float* p = args.in[1]; const float* norm_mix = args.in[2]; const float* w_in = args.in[3];
    const float* w_s = args.in[4]; const float* b_s = args.in[5]; const float* norm_a = args.in[6]; const float* norm_b = args.in[7];
    const float* w_out = args.in[8]; const float* norm_ffn = args.in[9]; const float* w_up = args.in[10]; const float* w_down = args.in[11];
    const float* norm_ple = args.in[12]; const float* w_gate = args.in[13]; const float* w_proj = args.in[14]; const float* norm_final = args.in[15];
    float* out = args.out;
    bf16* PBF = (bf16*)(ws + WS_PBF); bf16* WSB = (bf16*)(ws + WS_WSB);
    bf16 *Wi = (bf16*)(ws + WS_WIN), *Wo = (bf16*)(ws + WS_WOUT), *Wu = (bf16*)(ws + WS_WUP), *Wd = (bf16*)(ws + WS_WDN), *Wg = (bf16*)(ws + WS_WGT), *Wp = (bf16*)(ws + WS_WPJ);
    bf16 *ACT = (bf16*)(ws + WS_ACT), *Z = (bf16*)(ws + WS_Z), *HID = (bf16*)(ws + WS_HID), *HG = (bf16*)(ws + WS_HG);
    float* ssq1 = (float*)(ws + WS_CTL) + CW_SSQ1; float* ssq2 = (float*)(ws + WS_CTL) + CW_SSQ2; float* ssq3 = (float*)(ws + WS_CTL) + CW_SSQ3;
    for (int u = F.tid; u < (LDS_BYTES - LDSCTL_OFF) / 4; u += NWAVES * 64) ((LAS unsigned*)(F.lds + LDSCTL_OFF))[u] = 0u;
    __syncthreads();
    const int lo = args.ph_lo, hi = args.ph_hi;
    XcdBarrier bar; bar.bar = (unsigned*)(F.ctl + CW_BAR) + args.li * XCD_BAR_WORDS; bar.x = 0; bar.st = nullptr;
    if (hi - lo > 1) bar = xcd_barrier_post((unsigned*)(F.ctl + CW_BAR) + args.li * XCD_BAR_WORDS, F.MISC + 8);
#define IN(k) (lo <= (k) && (k) < hi)
#define GRID_BAR(k) do { if (IN(k) && IN((k) + 1)) xcd_barrier(bar); } while (0)
    const int gw = F.vcu * NWAVES + F.wave, NGW = F.G * NWAVES;
#if defined(MK_PA)
    GAS unsigned long long* stamps = (GAS unsigned long long*)(ws + WS_CTL + 1024);
#define STAMP(k) do { if (blockIdx.x == 0 && F.tid == 0) stamps[k] = rt(); } while (0)
#else
#define STAMP(k) do { } while (0)
#endif
    STAMP(0);
#ifndef MK_REP0
#define MK_REP0 1
#endif
    if (IN(0))
_Pragma("unroll")
    for (int rep0 = 0; rep0 < MK_REP0; ++rep0) {
        LAS float* scr = (LAS float*)(F.lds + RING_OFF + F.wave * 16384);
        constexpr int I_IN = (DM / 64) * (DIN / 32), I_OUT = (DM / 64) * (DM / 32), I_UP = (DM / 64) * (DFF / 32), I_DN = (DFF / 64) * (DM / 32), I_GT = I_OUT, I_PJ = (PLE / 64) * (DM / 32);
        constexpr int NITEMS = I_IN + I_OUT + I_UP + I_DN + I_GT + I_PJ;
        for (int it = gw; it < NITEMS; it += NGW) {
            int r = it;
            if (r < I_IN) { p0_transpose_item(w_in, DM, DIN, Wi, scr, r, F.lane); continue; } r -= I_IN;
            if (r < I_OUT) { p0_transpose_item(w_out, DM, DM, Wo, scr, r, F.lane); continue; } r -= I_OUT;
            if (r < I_UP) { p0_transpose_item(w_up, DM, DFF, Wu, scr, r, F.lane, norm_ffn); continue; } r -= I_UP;
            if (r < I_DN) { p0_transpose_item(w_down, DFF, DM, Wd, scr, r, F.lane); continue; } r -= I_DN;
            if (r < I_GT) { p0_transpose_item(w_gate, DM, DM, Wg, scr, r, F.lane, norm_ple); continue; } r -= I_GT;
            p0_transpose_item(w_proj, PLE, DM, Wp, scr, r, F.lane);
        }
        for (int i = gw; i < M * PLE / 256; i += NGW) {
            const f32x4 v = ((const GAS f32x4*)p)[(size_t)i * 64 + F.lane];
            ((GAS unsigned long long*)PBF)[(size_t)i * 64 + F.lane] = (unsigned long long)pk2(v.x, v.y) | ((unsigned long long)pk2(v.z, v.w) << 32); }
        for (int i = gw; i < NH * CH * CH / 256; i += NGW) {
            const f32x4 v = ((const GAS f32x4*)w_s)[(size_t)i * 64 + F.lane]; const int e0 = i * 256 + F.lane * 4, s = e0 & 127, t = (e0 >> 7) & 127;
            ((GAS unsigned long long*)WSB)[(size_t)i * 64 + F.lane] = (unsigned long long)pk2(s <= t ? v.x : 0.f, s + 1 <= t ? v.y : 0.f) | ((unsigned long long)pk2(s + 2 <= t ? v.z : 0.f, s + 3 <= t ? v.w : 0.f) << 32); }
        for (int m = gw; m < M; m += NGW) rms_row_to_bf16(F.lane, x + (size_t)m * DM, norm_mix, ACT + (size_t)m * DM);
    }
    GRID_BAR(0); STAMP(1);
    if (IN(1)) {
        pg8::Gemm g{ACT, Wi, M, DIN, DM}; pg8::StaticOrder S; S.init(M, DIN, F.G, (int)blockIdx.x);
        pg8::EpiInProj E{Z, DIN, (2 * AW) / 256, (3 * AW) / 256, QSCALE * 1.4426950408889634f};
        pg8::gemm_phase<pg8::EpiInProj, pg8::StaticOrder, true, true>(F.lds + RING_OFF, g, S, E);
    }
    GRID_BAR(1); STAMP(2);
#ifndef MK_REP2
#define MK_REP2 1
#endif
    if (IN(2))
_Pragma("unroll")
    for (int rep2 = 0; rep2 < MK_REP2; ++rep2) {
        const int hw = F.wave >> 2, wq = F.wave & 3;
        LAS unsigned char* vn = F.lds + hw * 32768; LAS unsigned char* wls = F.lds + 65536 + F.wave * (32 * KST);
        constexpr int NSGU = NB * (SEQ / CH) * NH;
        for (int it = 0; it * (2 * F.G) < NSGU; ++it) { const int unit = it * (2 * F.G) + 2 * (int)blockIdx.x + hw;
            sgu_unit(unit < NSGU, unit < NSGU ? unit : 0, wq, F.lane, vn, wls, Z, WSB, b_s, norm_a, ACT); }
        LAS unsigned char* wl2 = F.lds + F.wave * WREG;
        constexpr int NATT = NB * NH * (SEQ / 32);
        for (int i = 0; ; ++i) { const int unit = (i * F.G + (int)blockIdx.x) * NWAVES + F.wave; if (unit >= NATT) break;
            attn_unit(unit, F.lane, wl2, Z, norm_b, ACT); }
    }
    GRID_BAR(2); STAMP(3);
    if (IN(3)) {
        pg8::Gemm g{ACT, Wo, M, DM, DM}; pg8::StaticOrder S; S.init(M, DM, F.G, (int)blockIdx.x);
        pg8::EpiRes1 E{x, HG, ssq1, DM};
        pg8::gemm_phase<pg8::EpiRes1, pg8::StaticOrder, true, true>(F.lds + RING_OFF, g, S, E);
    }
    GRID_BAR(3); STAMP(4);
    if (IN(4)) {
        pg8::Gemm g{HG, Wu, M, DFF, DM}; pg8::StaticOrder S; S.init(M, DFF, F.G, (int)blockIdx.x);
        pg8::EpiUp E{HID, DFF, ssq1, 1.0f / DM, EPS};
        pg8::gemm_phase<pg8::EpiUp, pg8::StaticOrder, true, true>(F.lds + RING_OFF, g, S, E);
    }
    GRID_BAR(4); STAMP(5);
    if (IN(5)) {
        pg8::Gemm g{HID, Wd, M, DM, DFF}; pg8::StaticOrder S; S.init(M, DM, F.G, (int)blockIdx.x);
        pg8::EpiRes2 E{HG, ssq2, DM};
        pg8::gemm_phase<pg8::EpiRes2, pg8::StaticOrder, true, true>(F.lds + RING_OFF, g, S, E);
    }
    GRID_BAR(5); STAMP(6);
    if (IN(6)) {
        pg8::Gemm g{PBF, Wp, M, DM, PLE}; pg8::StaticOrder S; S.init(M, DM, F.G, (int)blockIdx.x);
        pg8::EpiPlainBf16 E{ACT, DM};
        pg8::gemm_phase<pg8::EpiPlainBf16, pg8::StaticOrder, true, true>(F.lds + RING_OFF, g, S, E);
        VM_WAIT(); __syncthreads();
    }
    STAMP(7);
    if (IN(7)) {
        pg8::Gemm g{HG, Wg, M, DM, DM}; pg8::StaticOrder S; S.init(M, DM, F.G, (int)blockIdx.x);
        pg8::EpiGate E{out, HG, ACT, ssq2, ssq3, DM, 1.0f / DM, EPS};
        pg8::gemm_phase<pg8::EpiGate, pg8::StaticOrder, true, true>(F.lds + RING_OFF, g, S, E);
    }
    GRID_BAR(7); STAMP(8);
    if (IN(8)) {
#if defined(MK_PA)
        const float probe_b = (float)(stamps[MK_PB + 1] - stamps[MK_PB]) * 0.01f;
        for (int m = gw; m < M; m += NGW) final_row(F.lane, out + (size_t)m * DM, norm_final, ssq3[m], probe_b);
        VM_WAIT(); STAMP(9);
        if (blockIdx.x == 0 && F.tid == 0) { VM_WAIT(); out[0] = 1000.0f * (float)(stamps[MK_PA + 1] - stamps[MK_PA]) * 0.01f; }
#else
        for (int m = gw; m < M; m += NGW) final_row(F.lane, out + (size_t)m * DM, norm_final, ssq3[m], 0.f);
#endif
    }
#if defined(MK_EXP)
    if (IN(9)) {
        pg8::Gemm g{HG, Wu, M, DFF, DM}; pg8::StaticOrder S; S.init(M, DFF, F.G, (int)blockIdx.x);
        pg8::EpiUp E{HID, DFF, ssq1, 1.0f / DM, EPS};
#if MK_EXP == 2
        struct SameUnit { int c; __device__ bool next(int i, pg8::Unit& u) const { if (i >= 16) return false; u.pm = c & 7; u.pn = (c >> 3) & 1; return true; }
            __device__ __forceinline__ void a_ready(const pg8::Unit&) const {} __device__ __forceinline__ void done(const pg8::Unit&) const {} } SU{(int)blockIdx.x};
        pg8::gemm_phase<pg8::EpiUp, SameUnit, true, true, false>(F.lds + RING_OFF, g, SU, E);
#else
        pg8::gemm_phase<pg8::EpiUp, pg8::StaticOrder, true, true, (MK_EXP == 1)>(F.lds + RING_OFF, g, S, E);
#endif
    }
#endif
#undef IN
#undef GRID_BAR
}

extern "C" void kernel_launch(void* const* d_in, const int* in_sizes, int n_in, void* d_out, int out_size, void* d_ws, size_t ws_size, hipStream_t stream) {
    static int grid = 0;
    if (grid == 0) {
        if (n_in != 16 || in_sizes[0] != M * DM || out_size != M * DM || ws_size < WS_END) { fprintf(stderr, "kernel_launch: unexpected shapes: n_in %d, in0 %d, out %d, ws %zu (need %zu); nothing launched\n", n_in, n_in > 0 ? in_sizes[0] : -1, out_size, ws_size, (size_t)WS_END); grid = -1; return; }
        int dev = 0, cus = 0, per_cu = 0;
        if (hipGetDevice(&dev) != hipSuccess || hipDeviceGetAttribute(&cus, hipDeviceAttributeMultiprocessorCount, dev) != hipSuccess) { fprintf(stderr, "kernel_launch: device query failed\n"); grid = -1; return; }
        if (hipFuncSetAttribute((const void*)mk_fwd, hipFuncAttributeMaxDynamicSharedMemorySize, LDS_BYTES) != hipSuccess) { fprintf(stderr, "kernel_launch: hipFuncSetAttribute failed\n"); grid = -1; return; }
        if (hipOccupancyMaxActiveBlocksPerMultiprocessor(&per_cu, (const void*)mk_fwd, NWAVES * 64, LDS_BYTES) != hipSuccess || per_cu < 1) { fprintf(stderr, "kernel_launch: occupancy query reports %d workgroups per CU\n", per_cu); }
        (void)hipGetLastError();
        grid = cus;
    }
    if (grid < 0) return;
    if (hipMemsetAsync((char*)d_ws + WS_CTL, 0, CTL_ZERO_BYTES, stream) != hipSuccess) { fprintf(stderr, "kernel_launch: hipMemsetAsync failed\n"); return; }
    Args a{};
    for (int i = 0; i < 16; ++i) a.in[i] = (const float*)d_in[i];
    a.out = (float*)d_out; a.ws = (unsigned char*)d_ws;
#if defined(MK_PLAN)
    { const int plan[] = MK_PLAN; int li = 0;
      for (unsigned i = 0; i + 1 < sizeof(plan) / sizeof(plan[0]); i += 2) { a.ph_lo = plan[i]; a.ph_hi = plan[i + 1]; a.li = li; if (plan[i + 1] - plan[i] > 1) ++li;
          hipLaunchKernelGGL(mk_fwd, dim3(grid), dim3(NWAVES * 64), LDS_BYTES, stream, a); } }
#else
    a.ph_lo = 0; a.ph_hi = N_PHASES; a.li = 0;
    hipLaunchKernelGGL(mk_fwd, dim3(grid), dim3(NWAVES * 64), LDS_BYTES, stream, a);
#endif
    const hipError_t le = hipPeekAtLastError();
    if (le != hipSuccess) fprintf(stderr, "kernel_launch: launch failed: %s\n", hipGetErrorName(le));
}
```

```cpp
#include <hip/hip_runtime.h>
#include <cstdio>
#include <cstdint>
namespace pg8 {
#define PG8_LAS __attribute__((address_space(3)))
typedef unsigned short bf16_t;
typedef short bf16x8 __attribute__((ext_vector_type(8)));
typedef float f32x4 __attribute__((ext_vector_type(4)));
typedef unsigned u32x4 __attribute__((ext_vector_type(4)));
constexpr int BM = 256, BK = 64, HALF = 128, HTB = HALF * BK * 2  , STAGE_BYTES = 8 * HTB, NXCD = 8, WGM = 8;

__host__ __device__ __forceinline__ int lds_byte(int r, int c) { const int st = (r >> 4) * 2 + (c >> 5), rr = r & 15, cc = c & 31, ob = rr * 64 + cc * 2; return st * 1024 + (ob ^ (((ob >> 9) & 1) << 5)); }
__host__ __device__ __forceinline__ void stage_rc(int b, int& R, int& C) { const int st = b / 1024, sb = b % 1024, swz = sb ^ (((sb >> 9) & 1) << 5); R = (st >> 1) * 16 + swz / 64; C = (st & 1) * 32 + (swz % 64) / 2; }
__host__ __device__ __forceinline__ int perm32(int rho) { const int n = rho >> 4, i = rho & 15; return 8 * (i >> 2) + 4 * n + (i & 3); }

struct Unit { int pm, pn; };
struct Gemm { const bf16_t* A; const bf16_t* Bt; int M, N, K; };

struct StaticOrder {
    int nM, nN, nwg, G, c;
    __host__ __device__ void init(int M, int N, int G_, int c_) { nM = M / BM; nN = N / BM; nwg = nM * nN; G = G_; c = c_; }
    __host__ __device__ bool next(int i, Unit& u) const {
        const long L = (long)i * G + c; if (L >= nwg) return false;
        int wgid = (int)L; { const int q = nwg / NXCD, r = nwg % NXCD, xcd = wgid % NXCD, off = wgid / NXCD; wgid = (xcd < r ? xcd * (q + 1) : r * (q + 1) + (xcd - r) * q) + off; }
        const int nig = WGM * nN, gid = wgid / nig, fm = gid * WGM, gsz = (nM - fm) < WGM ? (nM - fm) : WGM;
        u.pm = fm + ((wgid % nig) % gsz); u.pn = (wgid % nig) / gsz; return true;
    }
    __device__ __forceinline__ void a_ready(const Unit&) const {}
    __device__ __forceinline__ void done(const Unit&) const {}
};

__device__ __forceinline__ unsigned cvt_pk_bf16(float lo, float hi) { unsigned r; asm volatile("v_cvt_pk_bf16_f32 %0, %1, %2" : "=v"(r) : "v"(lo), "v"(hi)); return r; }
typedef float f32x2 __attribute__((ext_vector_type(2)));
typedef unsigned u32x2 __attribute__((ext_vector_type(2)));
__device__ __forceinline__ float bf_lo(unsigned w) { return __builtin_bit_cast(float, w << 16); }
__device__ __forceinline__ float bf_hi(unsigned w) { return __builtin_bit_cast(float, w & 0xffff0000u); }
__device__ __forceinline__ float gelu_tanh_f(float x) {
    const float x2 = x * x, t = x * (-2.302208198f + (-0.1029432397f) * x2);
    return x * __builtin_amdgcn_rcpf(1.0f + __builtin_amdgcn_exp2f(t));
}
__device__ __forceinline__ u32x4 pack8(const f32x4 v0, const f32x4 v1) { u32x4 w; w.x = cvt_pk_bf16(v0[0], v0[1]); w.y = cvt_pk_bf16(v0[2], v0[3]); w.z = cvt_pk_bf16(v1[0], v1[1]); w.w = cvt_pk_bf16(v1[2], v1[3]); return w; }
struct EpiInProj {
    static constexpr bool PERM = true, AFTER_DRAIN = false;
    bf16_t* O; int ldc; int gelu_tiles, q_tiles; float qscale;
    __device__ __forceinline__ void operator()(const f32x4 (&acc)[2][2][4][2], const Unit& u, int wr, int wc, int fr, int fq) const {
        const int row0 = u.pm * BM + wr * 64 + fr, col0 = u.pn * BM + wc * 32 + 8 * fq;
        const int mode = u.pn < gelu_tiles ? 1 : (u.pn < q_tiles ? 2 : 0);
#pragma unroll
        for (int ai = 0; ai < 2; ++ai)
#pragma unroll
            for (int m = 0; m < 4; ++m) { bf16_t* rowp = O + (size_t)(row0 + ai * HALF + m * 16) * ldc + col0;
#pragma unroll
                for (int bj = 0; bj < 2; ++bj) { f32x4 v0 = acc[ai][bj][m][0], v1 = acc[ai][bj][m][1];
                    if (mode == 1) {
#pragma unroll
                        for (int e = 0; e < 4; ++e) { v0[e] = gelu_tanh_f(v0[e]); v1[e] = gelu_tanh_f(v1[e]); } }
                    else if (mode == 2) { v0 = v0 * qscale; v1 = v1 * qscale; }
                    *(u32x4*)(rowp + bj * HALF) = pack8(v0, v1); } }
    }
};
struct EpiPlainBf16 {
    static constexpr bool PERM = true, AFTER_DRAIN = false;
    bf16_t* O; int ldc;
    __device__ __forceinline__ void operator()(const f32x4 (&acc)[2][2][4][2], const Unit& u, int wr, int wc, int fr, int fq) const {
        const int row0 = u.pm * BM + wr * 64 + fr, col0 = u.pn * BM + wc * 32 + 8 * fq;
#pragma unroll
        for (int ai = 0; ai < 2; ++ai)
#pragma unroll
            for (int m = 0; m < 4; ++m) { bf16_t* rowp = O + (size_t)(row0 + ai * HALF + m * 16) * ldc + col0;
#pragma unroll
                for (int bj = 0; bj < 2; ++bj) *(u32x4*)(rowp + bj * HALF) = pack8(acc[ai][bj][m][0], acc[ai][bj][m][1]); }
    }
};
#define SQ8(h0, h1) ((h0[0] * h0[0] + h0[1] * h0[1]) + (h0[2] * h0[2] + h0[3] * h0[3]) + (h1[0] * h1[0] + h1[1] * h1[1]) + (h1[2] * h1[2] + h1[3] * h1[3]))
struct EpiRes1 {
    static constexpr bool PERM = true, AFTER_DRAIN = false;
    const float* base; bf16_t* hb; float* ssq; int ldc;
    __device__ __forceinline__ void operator()(const f32x4 (&acc)[2][2][4][2], const Unit& u, int wr, int wc, int fr, int fq) const {
        const int row0 = u.pm * BM + wr * 64 + fr, col0 = u.pn * BM + wc * 32 + 8 * fq;
#pragma unroll
        for (int ai = 0; ai < 2; ++ai) {
            f32x4 pre[4][2][2];
#pragma unroll
            for (int m = 0; m < 4; ++m) { const size_t off = (size_t)(row0 + ai * HALF + m * 16) * ldc + col0;
#pragma unroll
                for (int bj = 0; bj < 2; ++bj) { pre[m][bj][0] = *(const f32x4*)(base + off + bj * HALF); pre[m][bj][1] = *(const f32x4*)(base + off + bj * HALF + 4); } }
            asm volatile("" ::: "memory");
#pragma unroll
            for (int m = 0; m < 4; ++m) { const int row = row0 + ai * HALF + m * 16; const size_t off = (size_t)row * ldc + col0; float s = 0.f;
#pragma unroll
                for (int bj = 0; bj < 2; ++bj) { const f32x4 h0 = pre[m][bj][0] + acc[ai][bj][m][0], h1 = pre[m][bj][1] + acc[ai][bj][m][1];
                    s += SQ8(h0, h1); *(u32x4*)(hb + off + bj * HALF) = pack8(h0, h1); }
                s += __shfl_xor(s, 16); s += __shfl_xor(s, 32);
                if (fq == 0) atomicAdd(ssq + row, s); }
            asm volatile("" ::: "memory"); }
    }
};
struct EpiRes2 {
    static constexpr bool PERM = true, AFTER_DRAIN = false;
    bf16_t* hb; float* ssq; int ldc;
    __device__ __forceinline__ void operator()(const f32x4 (&acc)[2][2][4][2], const Unit& u, int wr, int wc, int fr, int fq) const {
        const int row0 = u.pm * BM + wr * 64 + fr, col0 = u.pn * BM + wc * 32 + 8 * fq;
        u32x4 pre[2][4][2];
#pragma unroll
        for (int ai = 0; ai < 2; ++ai)
#pragma unroll
            for (int m = 0; m < 4; ++m) { const size_t off = (size_t)(row0 + ai * HALF + m * 16) * ldc + col0;
#pragma unroll
                for (int bj = 0; bj < 2; ++bj) pre[ai][m][bj] = *(const u32x4*)(hb + off + bj * HALF); }
        asm volatile("" ::: "memory");
#pragma unroll
        for (int ai = 0; ai < 2; ++ai)
#pragma unroll
            for (int m = 0; m < 4; ++m) { const int row = row0 + ai * HALF + m * 16; const size_t off = (size_t)row * ldc + col0; float s = 0.f;
#pragma unroll
                for (int bj = 0; bj < 2; ++bj) { const u32x4 bw = pre[ai][m][bj];
                    const f32x4 h0 = (f32x4){bf_lo(bw.x), bf_hi(bw.x), bf_lo(bw.y), bf_hi(bw.y)} + acc[ai][bj][m][0], h1 = (f32x4){bf_lo(bw.z), bf_hi(bw.z), bf_lo(bw.w), bf_hi(bw.w)} + acc[ai][bj][m][1];
                    s += SQ8(h0, h1); *(u32x4*)(hb + off + bj * HALF) = pack8(h0, h1); }
                s += __shfl_xor(s, 16); s += __shfl_xor(s, 32);
                if (fq == 0) atomicAdd(ssq + row, s); }
    }
};
struct EpiUp {
    static constexpr bool PERM = true, AFTER_DRAIN = false;
    bf16_t* O; int ldc; const float* ssq; float inv_n, eps;
    __device__ __forceinline__ void operator()(const f32x4 (&acc)[2][2][4][2], const Unit& u, int wr, int wc, int fr, int fq) const {
        const int row0 = u.pm * BM + wr * 64 + fr, col0 = u.pn * BM + wc * 32 + 8 * fq;
#pragma unroll
        for (int ai = 0; ai < 2; ++ai)
#pragma unroll
            for (int m = 0; m < 4; ++m) { const int row = row0 + ai * HALF + m * 16; bf16_t* rowp = O + (size_t)row * ldc + col0;
                const float r2 = 1.0f / (ssq[row] * inv_n + eps);
#pragma unroll
                for (int bj = 0; bj < 2; ++bj) { f32x4 v0 = acc[ai][bj][m][0], v1 = acc[ai][bj][m][1];
#pragma unroll
                    for (int e = 0; e < 4; ++e) { const float a = fmaxf(v0[e], 0.f), b = fmaxf(v1[e], 0.f); v0[e] = a * a * r2; v1[e] = b * b * r2; }
                    *(u32x4*)(rowp + bj * HALF) = pack8(v0, v1); } }
    }
};
struct EpiGate {
    static constexpr bool PERM = true, AFTER_DRAIN = false;
    bf16_t* h3b; const bf16_t* hb; const bf16_t* E; const float* ssq_in; float* ssq_out; int ldc; float inv_n, eps;
    __device__ __forceinline__ void operator()(const f32x4 (&acc)[2][2][4][2], const Unit& u, int wr, int wc, int fr, int fq) const {
        const int row0 = u.pm * BM + wr * 64 + fr, col0 = u.pn * BM + wc * 32 + 8 * fq;
#pragma unroll
        for (int ai = 0; ai < 2; ++ai) {
            u32x4 preh[4][2], pree[4][2]; float nrs[4];
#pragma unroll
            for (int m = 0; m < 4; ++m) { const int row = row0 + ai * HALF + m * 16; const size_t off = (size_t)row * ldc + col0; nrs[m] = ssq_in[row];
#pragma unroll
                for (int bj = 0; bj < 2; ++bj) { preh[m][bj] = *(const u32x4*)(hb + off + bj * HALF); pree[m][bj] = *(const u32x4*)(E + off + bj * HALF); } }
            asm volatile("" ::: "memory");
#pragma unroll
            for (int m = 0; m < 4; ++m) { const int row = row0 + ai * HALF + m * 16; const size_t off = (size_t)row * ldc + col0; float s = 0.f;
                const float nr = -1.4426950408889634f / sqrtf(nrs[m] * inv_n + eps);
#pragma unroll
                for (int bj = 0; bj < 2; ++bj) { const u32x4 ew = pree[m][bj], bw = preh[m][bj];
                    f32x4 h0 = (f32x4){bf_lo(bw.x), bf_hi(bw.x), bf_lo(bw.y), bf_hi(bw.y)}, h1 = (f32x4){bf_lo(bw.z), bf_hi(bw.z), bf_lo(bw.w), bf_hi(bw.w)};
                    const f32x4 a0 = acc[ai][bj][m][0], a1 = acc[ai][bj][m][1];
                    const float e0[4] = {bf_lo(ew.x), bf_hi(ew.x), bf_lo(ew.y), bf_hi(ew.y)}, e1[4] = {bf_lo(ew.z), bf_hi(ew.z), bf_lo(ew.w), bf_hi(ew.w)};
#pragma unroll
                    for (int e = 0; e < 4; ++e) {
                        h0[e] += __builtin_amdgcn_rcpf(1.0f + __builtin_amdgcn_exp2f(nr * a0[e])) * e0[e];
                        h1[e] += __builtin_amdgcn_rcpf(1.0f + __builtin_amdgcn_exp2f(nr * a1[e])) * e1[e]; }
                    s += SQ8(h0, h1); *(u32x4*)(h3b + off + bj * HALF) = pack8(h0, h1); }
                s += __shfl_xor(s, 16); s += __shfl_xor(s, 32);
                if (fq == 0) atomicAdd(ssq_out + row, s); }
            asm volatile("" ::: "memory"); }
    }
};
template <class Epi, class Sched, bool ALIGN_EPI = false, bool SP2 = false, bool TILED = false>
__device__ __forceinline__ void gemm_phase(PG8_LAS unsigned char* lds, const Gemm g, const Sched& S, const Epi& E) {
    const int tid = threadIdx.x, wid = __builtin_amdgcn_readfirstlane(tid >> 6), lane = tid & 63, wr = wid >> 2, wc = wid & 3, fr = lane & 15, fq = lane >> 4;
    const int K = g.K, nt = K / BK;
    unsigned voffA[2], voffB[2];
#pragma unroll
    for (int i = 0; i < 2; ++i) { int R, C; stage_rc(tid * 16 + i * 8192, R, C); const int Rb = Epi::PERM ? ((R & ~31) + perm32(R & 31)) : R;
        voffA[i] = (unsigned)(R * K + C) * 2u; voffB[i] = (unsigned)(Rb * K + C) * 2u;
        if (TILED) { voffA[i] = voffB[i] = (unsigned)(tid * 16 + i * 8192); } }
    const size_t kstep = TILED ? (size_t)HTB : (size_t)(BK * 2);
    const size_t hstep = (size_t)HALF * K * 2;
    const size_t tstep = 2 * hstep;
    const unsigned ldsw = (unsigned)wid * 1024u;
    const int aoff = lds_byte(wr * 64 + fr, fq * 8), boff = lds_byte(wc * 32 + fr, fq * 8);
#define PG8_SA(b, h) (((b) * 2 + (h)) * HTB)
#define PG8_SB(b, h) ((4 + (b) * 2 + (h)) * HTB)
#define PG8_STAGE(bufoff, gbase, voff) do { _Pragma("unroll") for (int _i = 0; _i < 2; ++_i) \
        __builtin_amdgcn_global_load_lds((const unsigned*)((const char*)(gbase) + (voff)[_i]), (PG8_LAS unsigned*)(lds + (bufoff) + ldsw + _i * 8192), 16, 0, 0); } while (0)
#define PG8_LDA(dst, b, h) do { _Pragma("unroll") for (int m = 0; m < 4; ++m) _Pragma("unroll") for (int k = 0; k < 2; ++k) dst[m][k] = *(const PG8_LAS bf16x8*)(lds + PG8_SA(b, h) + aoff + m * 2048 + k * 1024); } while (0)
#define PG8_LDB(dst, b, h) do { _Pragma("unroll") for (int n = 0; n < 2; ++n) _Pragma("unroll") for (int k = 0; k < 2; ++k) dst[n][k] = *(const PG8_LAS bf16x8*)(lds + PG8_SB(b, h) + boff + n * 2048 + k * 1024); } while (0)
#define PG8_MMA(ai, bj, At, Bt) do { __builtin_amdgcn_s_setprio(1); _Pragma("unroll") for (int m = 0; m < 4; ++m) _Pragma("unroll") for (int n = 0; n < 2; ++n) _Pragma("unroll") for (int k = 0; k < 2; ++k) \
        acc[ai][bj][m][n] = __builtin_amdgcn_mfma_f32_16x16x32_bf16(Bt[n][k], At[m][k], acc[ai][bj][m][n], 0, 0, 0); __builtin_amdgcn_s_setprio(0); } while (0)
#define PG8_WAIT_V(n) asm volatile("s_waitcnt vmcnt(" #n ")" ::: "memory")
#define PG8_WAIT_L(n) asm volatile("s_waitcnt lgkmcnt(" #n ")" ::: "memory")
#define PG8_BAR __builtin_amdgcn_s_barrier()
#define PG8_SCHED __builtin_amdgcn_sched_barrier(0)
    Unit cur, nxt; int ui = 0;
    if (!S.next(0, cur)) return;
    f32x4 acc[2][2][4][2];
#pragma unroll
    for (int a = 0; a < 2; ++a)
#pragma unroll
        for (int b = 0; b < 2; ++b)
#pragma unroll
            for (int m = 0; m < 4; ++m)
#pragma unroll
                for (int n = 0; n < 2; ++n) acc[a][b][m][n] = (f32x4){0.f, 0.f, 0.f, 0.f};
    bf16x8 At[4][2], B0[2][2], B1[2][2];
    const char* cA = (const char*)g.A + (size_t)cur.pm * tstep; const char* cB = (const char*)g.Bt + (size_t)cur.pn * tstep;
    S.a_ready(cur);
    if constexpr (SP2) {
        PG8_STAGE(PG8_SB(0, 0), cB, voffB); PG8_STAGE(PG8_SB(0, 1), cB + hstep, voffB); PG8_STAGE(PG8_SA(0, 0), cA, voffA); PG8_STAGE(PG8_SA(0, 1), cA + hstep, voffA);
        if (wr == 1) PG8_BAR;
        PG8_WAIT_V(2); PG8_BAR;
        PG8_STAGE(PG8_SB(1, 0), cB + kstep, voffB); PG8_STAGE(PG8_SA(1, 0), cA + kstep, voffA); PG8_STAGE(PG8_SB(1, 1), cB + hstep + kstep, voffB);
        PG8_WAIT_V(6); PG8_BAR;
    } else {
        PG8_STAGE(PG8_SB(0, 0), cB, voffB); PG8_STAGE(PG8_SA(0, 0), cA, voffA); PG8_STAGE(PG8_SB(0, 1), cB + hstep, voffB); PG8_STAGE(PG8_SA(0, 1), cA + hstep, voffA);
        if (wr == 1) PG8_BAR;
        PG8_WAIT_V(4); PG8_BAR;
        PG8_STAGE(PG8_SB(1, 0), cB + kstep, voffB); PG8_STAGE(PG8_SA(1, 0), cA + kstep, voffA); PG8_STAGE(PG8_SB(1, 1), cB + hstep + kstep, voffB);
        PG8_WAIT_V(6); PG8_BAR;
    }
    for (;;) {
        const bool has_next = S.next(ui + 1, nxt);
        const char* nA = has_next ? (const char*)g.A + (size_t)nxt.pm * tstep : cA; const char* nB = has_next ? (const char*)g.Bt + (size_t)nxt.pn * tstep : cB;
        for (int t = 0; t < nt; t += 2) {
            const bool last = (t == nt - 2);
            const char* a1 = cA + (size_t)(t + 1) * kstep;
            const char* a2 = last ? nA : cA + (size_t)(t + 2) * kstep; const char* b2 = last ? nB : cB + (size_t)(t + 2) * kstep;
            const char* a3 = a2 + kstep; const char* b3 = b2 + kstep;
            if (last && has_next) S.a_ready(nxt);
            if constexpr (SP2) {
            PG8_LDB(B0, 0, 0); PG8_LDB(B1, 0, 1); PG8_SCHED; PG8_LDA(At, 0, 0); PG8_STAGE(PG8_SA(1, 1), a1 + hstep, voffA);
            PG8_WAIT_V(8); PG8_WAIT_L(0); PG8_BAR; PG8_MMA(0, 0, At, B0); PG8_MMA(0, 1, At, B1); PG8_BAR; PG8_SCHED;
            PG8_LDA(At, 0, 1); PG8_STAGE(PG8_SB(0, 0), b2, voffB); PG8_STAGE(PG8_SB(0, 1), b2 + hstep, voffB); PG8_STAGE(PG8_SA(0, 0), a2, voffA);
            PG8_WAIT_V(8); PG8_WAIT_L(0); PG8_BAR; PG8_MMA(1, 0, At, B0); PG8_MMA(1, 1, At, B1); PG8_BAR; PG8_SCHED;
            PG8_LDB(B0, 1, 0); PG8_LDB(B1, 1, 1); PG8_SCHED; PG8_LDA(At, 1, 0); PG8_STAGE(PG8_SA(0, 1), a2 + hstep, voffA);
            PG8_WAIT_V(8); PG8_WAIT_L(0); PG8_BAR; PG8_MMA(0, 0, At, B0); PG8_MMA(0, 1, At, B1); PG8_BAR; PG8_SCHED;
            PG8_LDA(At, 1, 1); PG8_STAGE(PG8_SB(1, 0), b3, voffB); PG8_STAGE(PG8_SB(1, 1), b3 + hstep, voffB); PG8_STAGE(PG8_SA(1, 0), a3, voffA);
            PG8_WAIT_V(8); PG8_WAIT_L(0); PG8_BAR; PG8_MMA(1, 0, At, B0); PG8_MMA(1, 1, At, B1); PG8_BAR; PG8_SCHED;
            } else {
            PG8_LDB(B0, 0, 0); PG8_SCHED; PG8_LDA(At, 0, 0); PG8_STAGE(PG8_SA(1, 1), a1 + hstep, voffA);
            PG8_WAIT_L(8); PG8_BAR; PG8_WAIT_L(0); PG8_MMA(0, 0, At, B0); PG8_BAR; PG8_SCHED;
            PG8_LDB(B1, 0, 1); PG8_STAGE(PG8_SB(0, 0), b2, voffB);
            PG8_BAR; PG8_WAIT_L(0); PG8_MMA(0, 1, At, B1); PG8_BAR;
            PG8_LDA(At, 0, 1); PG8_STAGE(PG8_SA(0, 0), a2, voffA);
            PG8_BAR; PG8_WAIT_L(0); PG8_MMA(1, 0, At, B0); PG8_BAR; PG8_SCHED;
            PG8_STAGE(PG8_SB(0, 1), b2 + hstep, voffB);
            PG8_WAIT_V(6); PG8_BAR; PG8_MMA(1, 1, At, B1); PG8_BAR;
            PG8_LDB(B0, 1, 0); PG8_SCHED; PG8_LDA(At, 1, 0); PG8_STAGE(PG8_SA(0, 1), a2 + hstep, voffA);
            PG8_WAIT_L(8); PG8_BAR; PG8_WAIT_L(0); PG8_MMA(0, 0, At, B0); PG8_BAR; PG8_SCHED;
            PG8_LDB(B1, 1, 1); PG8_STAGE(PG8_SB(1, 0), b3, voffB);
            PG8_BAR; PG8_WAIT_L(0); PG8_MMA(0, 1, At, B1); PG8_BAR;
            PG8_LDA(At, 1, 1); PG8_STAGE(PG8_SA(1, 0), a3, voffA);
            PG8_BAR; PG8_WAIT_L(0); PG8_MMA(1, 0, At, B0); PG8_BAR; PG8_SCHED;
            PG8_STAGE(PG8_SB(1, 1), b3 + hstep, voffB);
            PG8_WAIT_V(6); PG8_BAR; PG8_MMA(1, 1, At, B1); PG8_BAR;
            }
        }
        if constexpr (ALIGN_EPI) { if (wr == 0) PG8_BAR; }
        if constexpr (!Epi::AFTER_DRAIN) { E(acc, cur, wr, wc, fr, fq); S.done(cur); }
        if (!has_next) break;
#pragma unroll
        for (int a = 0; a < 2; ++a)
#pragma unroll
            for (int b = 0; b < 2; ++b)
#pragma unroll
                for (int m = 0; m < 4; ++m)
#pragma unroll
                    for (int n = 0; n < 2; ++n) acc[a][b][m][n] = (f32x4){0.f, 0.f, 0.f, 0.f};
        cur = nxt; cA = nA; cB = nB; ++ui;
        if constexpr (ALIGN_EPI) { if (wr == 1) PG8_BAR; }
    }
    PG8_WAIT_V(0);
    if constexpr (!ALIGN_EPI) { if (wr == 0) PG8_BAR; }
    PG8_BAR;
    if constexpr (Epi::AFTER_DRAIN) { E.fused(acc, cur, wr, wc, fr, fq, lds, wid, lane); S.done(cur); }
#undef PG8_SA
#undef PG8_SB
#undef PG8_STAGE
#undef PG8_LDA
#undef PG8_LDB
#undef PG8_MMA
#undef PG8_WAIT_V
#undef PG8_WAIT_L
#undef PG8_BAR
#undef PG8_SCHED
}
}
constexpr int NWAVES = 8;
constexpr int NB = 4, SEQ = 4096, DM = 4096, M = NB * SEQ, DIN = 10240, DFF = 16384, PLE = 256, AW = 2048, NH = 16, HD = 128, CH = 128;
constexpr float EPS = 1e-6f;
constexpr float QSCALE = 0.08838834764831845f;
constexpr size_t MiB = 1u << 20;
constexpr size_t WS_CTL = 0, CTL_ZERO_BYTES = 256 * 1024;
constexpr size_t WS_PBF = 1 * MiB;
constexpr size_t WS_WSB = 9 * MiB;
constexpr size_t WS_WIN = 10 * MiB, WS_WOUT = WS_WIN + 80 * MiB, WS_WUP = WS_WOUT + 32 * MiB, WS_WDN = WS_WUP + 128 * MiB, WS_WGT = WS_WDN + 128 * MiB, WS_WPJ = WS_WGT + 32 * MiB;
constexpr size_t WS_ACT = WS_WPJ + 2 * MiB;
constexpr size_t WS_Z = WS_ACT + 128 * MiB;
constexpr size_t WS_HID = WS_ACT;
constexpr size_t WS_HG = WS_ACT + 512 * MiB;
constexpr size_t WS_END = WS_HG + 128 * MiB;
static_assert(WS_Z + (size_t)M * DIN * 2 <= WS_HG && WS_HID + (size_t)M * DFF * 2 <= WS_HG && WS_WPJ + (size_t)DM * PLE * 2 <= WS_ACT && WS_PBF + (size_t)M * PLE * 2 <= WS_WSB, "d_ws map");
constexpr int CW_TMO = 0, CW_CODE = 1;
constexpr int CW_BAR = 4096;
constexpr int CW_SSQ1 = 16384, CW_SSQ2 = 32768, CW_SSQ3 = 49152;
static_assert((CW_SSQ3 + M) * 4 <= (int)CTL_ZERO_BYTES, "CTL words inside the memset region");
constexpr int RING_OFF = 0, RING_BYTES = 131072;
constexpr int LDS_BYTES = 147456;
constexpr int LDSCTL_OFF = LDS_BYTES - 1024, MISC_OFF = LDSCTL_OFF + 320;
static_assert(MISC_OFF + 128 <= LDS_BYTES, "LDS map");

#define GAS __attribute__((address_space(1)))
#define LAS __attribute__((address_space(3)))
typedef unsigned short bf16;
typedef unsigned v4u __attribute__((ext_vector_type(4)));
typedef float f32x4 __attribute__((ext_vector_type(4)));
typedef short bf16x8 __attribute__((ext_vector_type(8)));
typedef GAS unsigned gu32;
typedef GAS unsigned long long gu64;
#define RLX_AGENT __ATOMIC_RELAXED, __HIP_MEMORY_SCOPE_AGENT
#define LDS_WAIT() asm volatile("s_waitcnt lgkmcnt(0)" ::: "memory")
#define VM_WAIT() asm volatile("s_waitcnt vmcnt(0)" ::: "memory")
__device__ __forceinline__ unsigned long long rt() { return __builtin_amdgcn_s_memrealtime(); }
__device__ __forceinline__ unsigned f2bf(float f) { unsigned u = __builtin_bit_cast(unsigned, f); return (u + 0x7fffu + ((u >> 16) & 1u)) >> 16; }
__device__ __forceinline__ unsigned pk2(float lo, float hi) { return f2bf(lo) | (f2bf(hi) << 16); }
#define XB_TMO      128
#define XB_XCNT(j)  (256  + 64 * (j))
#define XB_XSUB(j)  (1280 + 64 * (j))
#define XB_XGEN(j)  (2304 + 64 * (j))
#define XB_TOP      3328
#define XB_TOPGEN   3392
#define XCD_BAR_WORDS 3456
#define XB_SPIN_CAP (1u << 18)

__device__ __forceinline__ unsigned xb_ld(unsigned* p)              { return __hip_atomic_load(p, __ATOMIC_RELAXED, __HIP_MEMORY_SCOPE_AGENT); }
__device__ __forceinline__ unsigned xb_add(unsigned* p, unsigned v) { return __hip_atomic_fetch_add(p, v, __ATOMIC_RELAXED, __HIP_MEMORY_SCOPE_AGENT); }
__device__ __forceinline__ unsigned xb_xcc_id() { return (unsigned)__builtin_amdgcn_s_getreg((3 << 11) | 20) & 0xFu; }
#define XB_SPIN(cond, bar) do { unsigned _sp = 0; while (cond) { __builtin_amdgcn_s_sleep(1); \
    if ((++_sp & 255u) == 0u) { if (xb_ld(&(bar)[XB_TMO])) break; if (_sp > XB_SPIN_CAP) { atomicAdd(&(bar)[XB_TMO], 1u); break; } } } } while (0)

struct XcdBarrier {
    unsigned* bar; unsigned x;
    volatile LAS unsigned* st;
};

__device__ __forceinline__ XcdBarrier xcd_barrier_post(unsigned* bar, volatile LAS unsigned* st) {
    XcdBarrier b; b.bar = bar; b.x = xb_xcc_id(); b.st = st;
    if (threadIdx.x == 0) (void)xb_add(&bar[XB_XCNT(b.x)], 1u);
    return b;
}
__device__ __forceinline__ void xcd_barrier_complete(unsigned* bar, unsigned x, unsigned& nloc, unsigned& nx) {
    const unsigned G = gridDim.x * gridDim.y * gridDim.z;
    unsigned sum, cnt, mine, sp = 0u;
    for (;;) {
        sum = 0u; cnt = 0u; mine = 0u;
#pragma unroll
        for (unsigned j = 0; j < 16; ++j) { const unsigned c = xb_ld(&bar[XB_XCNT(j)]); sum += c; cnt += (c > 0u) ? 1u : 0u; mine = (j == x) ? c : mine; }
        if (sum == G) break;
        __builtin_amdgcn_s_sleep(1);
        if ((++sp & 255u) == 0u) { if (xb_ld(&bar[XB_TMO])) break; if (sp > XB_SPIN_CAP) { atomicAdd(&bar[XB_TMO], 1u); break; } }
    }
    nloc = mine > 0u ? mine : 1u; nx = cnt > 0u ? cnt : 1u;
}

__device__ __forceinline__ void xcd_barrier(const XcdBarrier& b) {
    asm volatile("s_waitcnt vmcnt(0)" ::: "memory");
    __syncthreads();
    if (threadIdx.x == 0) {
        unsigned* bar = b.bar;
        __builtin_amdgcn_s_waitcnt(0);
        unsigned nloc = b.st[0], nx = b.st[1];
        if (nloc == 0u) { xcd_barrier_complete(bar, b.x, nloc, nx); b.st[0] = nloc; b.st[1] = nx; }
        const unsigned old = xb_add(&bar[XB_XSUB(b.x)], 1u);
        const unsigned gen = old / nloc;
        if (old + 1u == (gen + 1u) * nloc) {
            __builtin_amdgcn_fence(__ATOMIC_RELEASE, "agent");
            asm volatile("s_waitcnt vmcnt(0)" ::: "memory");
            const unsigned og = xb_add(&bar[XB_TOP], 1u);
            const unsigned tg = og / nx;
            if (og + 1u == (tg + 1u) * nx) xb_add(&bar[XB_TOPGEN], 1u);
            else XB_SPIN(xb_ld(&bar[XB_TOPGEN]) == tg, bar);
            __builtin_amdgcn_fence(__ATOMIC_ACQUIRE, "agent");
            xb_add(&bar[XB_XGEN(b.x)], 1u);
            asm volatile("s_waitcnt vmcnt(0)" ::: "memory");
        } else {
            XB_SPIN(xb_ld(&bar[XB_XGEN(b.x)]) == gen, bar);
            __builtin_amdgcn_fence(__ATOMIC_ACQUIRE, "agent");
            asm volatile("s_waitcnt vmcnt(0)" ::: "memory");
        }
    }
    __syncthreads();
}

struct Frame {
    LAS unsigned char* lds;
    volatile LAS unsigned* MISC;
    gu32* ctl;
    int tid, lane, wave;
    int vcu, G;
};
__device__ __forceinline__ float wave_sum(float v) {
#pragma unroll
    for (int o = 1; o < 64; o <<= 1) v += __shfl_xor(v, o);
    return v;
}
__device__ __forceinline__ float bf2f(unsigned short h) { return __builtin_bit_cast(float, (unsigned)h << 16); }
__device__ __forceinline__ void p0_transpose_item(const float* W, int K, int N, bf16* WT, LAS float* scr, int item, int lane, const float* kg = nullptr) {
    const int nblk = N / 32, kb = item / nblk, nb = item % nblk, k0 = 64 * kb, n0 = 32 * nb;
#pragma unroll 8
    for (int i = 0; i < 32; ++i) { const int kk = 2 * i + (lane >> 5); scr[kk * 33 + (lane & 31)] = W[(size_t)(k0 + kk) * N + n0 + (lane & 31)]; }
    LDS_WAIT(); asm volatile("" ::: "memory");
    const int c = lane & 7;
#pragma unroll
    for (int j = 0; j < 4; ++j) { const int n = (lane >> 3) + 8 * j; const LAS float* s = scr + (8 * c) * 33 + n;
        f32x4 g0 = {1.f, 1.f, 1.f, 1.f}, g1 = g0; if (kg) { g0 = *(const GAS f32x4*)(kg + k0 + 8 * c); g1 = *(const GAS f32x4*)(kg + k0 + 8 * c + 4); }
        v4u o; o.x = pk2(s[0 * 33] * g0.x, s[1 * 33] * g0.y); o.y = pk2(s[2 * 33] * g0.z, s[3 * 33] * g0.w); o.z = pk2(s[4 * 33] * g1.x, s[5 * 33] * g1.y); o.w = pk2(s[6 * 33] * g1.z, s[7 * 33] * g1.w);
        *(GAS v4u*)(WT + (size_t)(n0 + n) * K + k0 + 8 * c) = o; }
    LDS_WAIT(); asm volatile("" ::: "memory");
}
__device__ __forceinline__ void rms_row_to_bf16(int lane, const float* xrow, const float* g, bf16* orow) {
    const GAS f32x4* xr = (const GAS f32x4*)xrow + lane; const GAS f32x4* gr = (const GAS f32x4*)g + lane;
    f32x4 v[16]; float s = 0.f;
#pragma unroll
    for (int j = 0; j < 16; ++j) { v[j] = xr[64 * j]; s += (v[j].x * v[j].x + v[j].y * v[j].y) + (v[j].z * v[j].z + v[j].w * v[j].w); }
    const float rstd = 1.f / sqrtf(wave_sum(s) * (1.f / DM) + EPS);
    GAS unsigned long long* o8 = (GAS unsigned long long*)orow + lane;
#pragma unroll
    for (int j = 0; j < 16; ++j) { const f32x4 gg = gr[64 * j];
        o8[64 * j] = (unsigned long long)pk2(v[j].x * rstd * gg.x, v[j].y * rstd * gg.y) | ((unsigned long long)pk2(v[j].z * rstd * gg.z, v[j].w * rstd * gg.w) << 32); }
}
__device__ __forceinline__ void final_row(int lane, const bf16* hrow, float* orow, const float* g, float ssq) {
    const GAS v4u* hr = (const GAS v4u*)hrow + lane; const GAS f32x4* gr = (const GAS f32x4*)g + 2 * lane; GAS f32x4* xr = (GAS f32x4*)orow + 2 * lane;
    const float rstd = 1.f / sqrtf(ssq * (1.f / DM) + EPS);
    v4u w[8];
#pragma unroll
    for (int j = 0; j < 8; ++j) w[j] = hr[64 * j];
#pragma unroll
    for (int j = 0; j < 8; ++j) { const f32x4 g0 = gr[128 * j], g1 = gr[128 * j + 1];
        xr[128 * j] = (f32x4){pg8::bf_lo(w[j].x) * rstd * g0.x, pg8::bf_hi(w[j].x) * rstd * g0.y, pg8::bf_lo(w[j].y) * rstd * g0.z, pg8::bf_hi(w[j].y) * rstd * g0.w};
        xr[128 * j + 1] = (f32x4){pg8::bf_lo(w[j].z) * rstd * g1.x, pg8::bf_hi(w[j].z) * rstd * g1.y, pg8::bf_lo(w[j].w) * rstd * g1.z, pg8::bf_hi(w[j].w) * rstd * g1.w}; }
}

typedef float f32x16 __attribute__((ext_vector_type(16)));
typedef short s16x4 __attribute__((ext_vector_type(4)));
typedef short v4i16_t __attribute__((ext_vector_type(4)));
typedef float f32x2_t __attribute__((ext_vector_type(2))); typedef __bf16 bf16x2_t __attribute__((ext_vector_type(2)));
__device__ __forceinline__ unsigned cvtpk_s(float lo, float hi) { f32x2_t v = {lo, hi}; bf16x2_t b = __builtin_convertvector(v, bf16x2_t); return __builtin_bit_cast(unsigned, b); }
__device__ __forceinline__ s16x4 vtr(LAS const unsigned char* p) { return __builtin_bit_cast(s16x4, __builtin_amdgcn_ds_read_tr16_b64_v4i16((LAS v4i16_t*)p)); }
__device__ __forceinline__ int crow(int r, int hi) { return (r & 3) + 8 * (r >> 2) + 4 * hi; }
#define MFMA32(a, b, c) __builtin_amdgcn_mfma_f32_32x32x16_bf16((a), (b), (c), 0, 0, 0)
__device__ __forceinline__ float half_swap_sum(float v) { auto rr = __builtin_amdgcn_permlane32_swap(__float_as_uint(v), __float_as_uint(v), false, false); return __uint_as_float(rr[0]) + __uint_as_float(rr[1]); }
constexpr int KST = 272, VST = 320;
constexpr int WREG = 32 * VST;

__device__ __forceinline__ void head_norm_store(f32x16 (&o)[4], int lane, LAS unsigned char* wl, const float* gain, bf16* ydst) {
    const int tl = lane & 31, hh = lane >> 5, r4 = lane >> 4, c16 = lane & 15;
    float ss = 0.f;
#pragma unroll
    for (int dt = 0; dt < 4; ++dt)
#pragma unroll
        for (int r = 0; r < 16; ++r) ss += o[dt][r] * o[dt][r];
    ss = half_swap_sum(ss);
    const float rstd = 1.0f / sqrtf(ss * (1.0f / 128.0f) + EPS);
#pragma unroll
    for (int dt = 0; dt < 4; ++dt)
#pragma unroll
        for (int G = 0; G < 4; ++G) { const int d0 = 32 * dt + 8 * G + 4 * hh; const f32x4 g4 = *(const GAS f32x4*)(gain + d0);
            const unsigned w0 = cvtpk_s(o[dt][4 * G] * rstd * g4.x, o[dt][4 * G + 1] * rstd * g4.y), w1 = cvtpk_s(o[dt][4 * G + 2] * rstd * g4.z, o[dt][4 * G + 3] * rstd * g4.w);
            *(LAS unsigned long long*)(wl + tl * KST + 2 * d0) = (unsigned long long)w0 | ((unsigned long long)w1 << 32); }
#pragma unroll
    for (int i = 0; i < 8; ++i) { const int row = 4 * i + r4; const v4u w = *(LAS const v4u*)(wl + row * KST + 16 * c16);
        *(GAS v4u*)(ydst + (size_t)row * DM + 8 * c16) = w; }
}

__device__ __forceinline__ void attn_unit(int unit, int lane, LAS unsigned char* wl, const bf16* Z, const float* gb, bf16* Y) {
    const int qb = unit & 127, h = (unit >> 7) & 15, b = unit >> 11;
    const int t0 = qb * 32, tl = lane & 31, hh = lane >> 5, r4 = lane >> 4, c16 = lane & 15;
    const size_t rowb = (size_t)b * SEQ;
    bf16x8 qf[8];
    { const bf16* Qp = Z + (rowb + t0 + tl) * DIN + 2 * AW + h * HD + 8 * hh;
#pragma unroll
      for (int ks = 0; ks < 8; ++ks) qf[ks] = *(const GAS bf16x8*)(Qp + 16 * ks); }
    f32x16 o[4];
#pragma unroll
    for (int dt = 0; dt < 4; ++dt)
#pragma unroll
        for (int r = 0; r < 16; ++r) o[dt][r] = 0.f;
    float L2 = 0.f;
    const bf16* Kp = Z + (rowb + r4) * DIN + 3 * AW + h * HD + 8 * c16;
    const unsigned kw = r4 * KST + c16 * 16, kr = tl * KST + hh * 16, vw = r4 * VST + c16 * 16;
    const int q4 = (lane & 15) >> 2, p4 = lane & 3, blk = (lane >> 4) & 1;
    const unsigned vr = (4 * hh + q4) * VST + 2 * (16 * blk + 4 * p4);
    for (int j = 0; ; ++j) {
        const int s0 = t0 - 32 * j; if (s0 < 0) break;
        v4u kreg[8], vreg[8];
#pragma unroll
        for (int i = 0; i < 8; ++i) { kreg[i] = *(const GAS v4u*)(Kp + (size_t)(s0 + 4 * i) * DIN); vreg[i] = *(const GAS v4u*)(Kp + (size_t)(s0 + 4 * i) * DIN + AW); }
#pragma unroll
        for (int i = 0; i < 8; ++i) *(LAS v4u*)(wl + kw + i * 4 * KST) = kreg[i];
        f32x16 st;
#pragma unroll
        for (int r = 0; r < 16; ++r) st[r] = 0.f;
#pragma unroll
        for (int ks = 0; ks < 8; ++ks) { const bf16x8 kf = *(LAS const bf16x8*)(wl + kr + 32 * ks); st = MFMA32(kf, qf[ks], st); }
#pragma unroll
        for (int i = 0; i < 8; ++i) *(LAS v4u*)(wl + vw + i * 4 * VST) = vreg[i];
        const bool diag = (j == 0);
        float lk[16], ls[16];
#pragma unroll
        for (int r = 0; r < 16; ++r) { const float z = st[r];
            const float sp = fmaxf(z, 0.f) + __builtin_amdgcn_logf(1.0f + __builtin_amdgcn_exp2f(-fabsf(z)));
            const bool valid = !diag || (crow(r, hh) < tl);
            lk[r] = valid ? -sp : 0.f; ls[r] = z - sp; }
        float gs[4], T[4];
#pragma unroll
        for (int G = 0; G < 4; ++G) { gs[G] = (lk[4 * G] + lk[4 * G + 1]) + (lk[4 * G + 2] + lk[4 * G + 3]); T[G] = half_swap_sum(gs[G]); }
        const float SG2 = T[3], SG1 = SG2 + T[2], SG0 = SG1 + T[1];
        const float SG[4] = {SG0, SG1, SG2, 0.f};
        unsigned pw[8];
#pragma unroll
        for (int G = 0; G < 4; ++G) {
            float run = L2 + SG[G] + (hh == 0 ? (T[G] - gs[G]) : 0.f); float a[4];
#pragma unroll
            for (int i = 3; i >= 0; --i) { const int r = 4 * G + i; const float e = __builtin_amdgcn_exp2f(ls[r] + run);
                const bool valid = !diag || (crow(r, hh) < tl); a[i] = valid ? e : 0.f; run += lk[r]; }
            pw[2 * G] = cvtpk_s(a[0], a[1]); pw[2 * G + 1] = cvtpk_s(a[2], a[3]); }
        L2 += SG0 + T[0];
#pragma unroll
        for (int s2 = 0; s2 < 2; ++s2) { const v4u pv4 = {pw[4 * s2], pw[4 * s2 + 1], pw[4 * s2 + 2], pw[4 * s2 + 3]}; const bf16x8 pb = __builtin_bit_cast(bf16x8, pv4);
#pragma unroll
            for (int dt = 0; dt < 4; ++dt) { const s16x4 lo = vtr(wl + vr + (16 * s2) * VST + 64 * dt), hi = vtr(wl + vr + (16 * s2 + 8) * VST + 64 * dt);
                const bf16x8 va = __builtin_shufflevector(lo, hi, 0, 1, 2, 3, 4, 5, 6, 7);
                o[dt] = MFMA32(va, pb, o[dt]); } }
        if (__all(L2 < -150.5f)) break;
    }
    head_norm_store(o, lane, wl, gb + h * HD, Y + (rowb + t0) * DM + AW + h * HD);
}

__device__ __forceinline__ void sgu_unit(bool active, int unit, int wq, int lane, LAS unsigned char* vn, LAS unsigned char* wl, const bf16* Z, const bf16* WSB, const float* bs, const float* ga, bf16* Y) {
    const int h = unit % NH, nc = (unit / NH) % (SEQ / CH), b = unit / (NH * (SEQ / CH));
    const int tl = lane & 31, hh = lane >> 5, r4 = lane >> 4, c16 = lane & 15;
    const size_t row0 = (size_t)b * SEQ + nc * CH;
    if (active) {
#pragma unroll
        for (int i = 0; i < 8; ++i) { const int s = 32 * wq + 4 * i + r4;
            const v4u w = *(const GAS v4u*)(Z + (row0 + s) * DIN + AW + h * HD + 8 * c16);
            float v[8] = {pg8::bf_lo(w.x), pg8::bf_hi(w.x), pg8::bf_lo(w.y), pg8::bf_hi(w.y), pg8::bf_lo(w.z), pg8::bf_hi(w.z), pg8::bf_lo(w.w), pg8::bf_hi(w.w)};
            float s1 = ((v[0] + v[1]) + (v[2] + v[3])) + ((v[4] + v[5]) + (v[6] + v[7]));
#pragma unroll
            for (int o = 1; o < 16; o <<= 1) s1 += __shfl_xor(s1, o);
            const float mu = s1 * (1.0f / 128.0f); float s2 = 0.f;
#pragma unroll
            for (int e = 0; e < 8; ++e) { v[e] -= mu; s2 += v[e] * v[e]; }
#pragma unroll
            for (int o = 1; o < 16; o <<= 1) s2 += __shfl_xor(s2, o);
            const float rs = 1.0f / sqrtf(s2 * (1.0f / 128.0f) + EPS);
            v4u ow; ow.x = cvtpk_s(v[0] * rs, v[1] * rs); ow.y = cvtpk_s(v[2] * rs, v[3] * rs); ow.z = cvtpk_s(v[4] * rs, v[5] * rs); ow.w = cvtpk_s(v[6] * rs, v[7] * rs);
            *(LAS v4u*)(vn + s * 256 + ((16 * c16) ^ ((s & 3) << 6))) = ow; }
    }
    LDS_WAIT(); __syncthreads();
    if (active) {
        f32x16 o[4];
#pragma unroll
        for (int dt = 0; dt < 4; ++dt)
#pragma unroll
            for (int r = 0; r < 16; ++r) o[dt][r] = 0.f;
        const int q4 = (lane & 15) >> 2, p4 = lane & 3, blk = (lane >> 4) & 1;
        const bf16* Wrow = WSB + ((size_t)h * CH + 32 * wq + tl) * CH + 8 * hh;
        for (int sb = 0; sb <= wq; ++sb) {
#pragma unroll
            for (int s2 = 0; s2 < 2; ++s2) { const bf16x8 wf = *(const GAS bf16x8*)(Wrow + 32 * sb + 16 * s2);
                const int R = 32 * sb + 16 * s2 + 8 * hh + q4;
#pragma unroll
                for (int dt = 0; dt < 4; ++dt) { const unsigned xo = (unsigned)(64 * (dt ^ q4) + 32 * blk + 8 * p4);
                    const s16x4 lo = vtr(vn + R * 256 + xo), hi = vtr(vn + (R + 4) * 256 + xo);
                    const bf16x8 va = __builtin_shufflevector(lo, hi, 0, 1, 2, 3, 4, 5, 6, 7);
                    o[dt] = MFMA32(va, wf, o[dt]); } } }
#pragma unroll
        for (int i = 0; i < 8; ++i) { const int t = 4 * i + r4; const v4u w = *(const GAS v4u*)(Z + (row0 + 32 * wq + t) * DIN + h * HD + 8 * c16); *(LAS v4u*)(wl + t * KST + 16 * c16) = w; }
        const float bias = bs[h * CH + 32 * wq + tl];
#pragma unroll
        for (int dt = 0; dt < 4; ++dt)
#pragma unroll
            for (int G = 0; G < 4; ++G) { const int d0 = 32 * dt + 8 * G + 4 * hh; const unsigned long long uw = *(LAS const unsigned long long*)(wl + tl * KST + 2 * d0);
                const unsigned u0 = (unsigned)uw, u1 = (unsigned)(uw >> 32);
                o[dt][4 * G] = pg8::bf_lo(u0) * (o[dt][4 * G] + bias); o[dt][4 * G + 1] = pg8::bf_hi(u0) * (o[dt][4 * G + 1] + bias);
                o[dt][4 * G + 2] = pg8::bf_lo(u1) * (o[dt][4 * G + 2] + bias); o[dt][4 * G + 3] = pg8::bf_hi(u1) * (o[dt][4 * G + 3] + bias); }
        head_norm_store(o, lane, wl, ga + h * HD, Y + (row0 + 32 * wq) * DM + h * HD);
    }
    LDS_WAIT(); __syncthreads();
}

#if defined(MK_EXP)
constexpr int N_PHASES = 10;
#else
constexpr int N_PHASES = 9;
#endif
struct Args { const float* in[16]; float* out; unsigned char* ws; int ph_lo, ph_hi, li, pad; };
__global__ void __launch_bounds__(NWAVES * 64, 2) mk_fwd(Args args) {
    extern __shared__ __attribute__((aligned(16))) unsigned char lds[];
    Frame F;
    F.lds = (LAS unsigned char*)lds;
    F.MISC = (volatile LAS unsigned*)(F.lds + MISC_OFF);
    F.tid = threadIdx.x; F.lane = F.tid & 63; F.wave = __builtin_amdgcn_readfirstlane(F.tid >> 6);
    F.G = gridDim.x; { const int bx = blockIdx.x; F.vcu = (F.G % 8 == 0) ? (bx % 8) * (F.G / 8) + bx / 8 : bx; }
    unsigned char* ws = args.ws;
    F.ctl = (gu32*)(ws + WS_CTL);
    const float* x = args.in[0]; const float* p = args.in[1]; const float* norm_mix = args.in[2]; const float* w_in = args.in[3];
    const float* w_s = args.in[4]; const float* b_s = args.in[5]; const float* norm_a = args.in[6]; const float* norm_b = args.in[7];
    const float* w_out = args.in[8]; const float* norm_ffn = args.in[9]; const float* w_up = args.in[10]; const float* w_down = args.in[11];
    const float* norm_ple = args.in[12]; const float* w_gate = args.in[13]; const float* w_proj = args.in[14]; const float* norm_final = args.in[15];
    float* out = args.out;
    bf16* PBF = (bf16*)(ws + WS_PBF); bf16* WSB = (bf16*)(ws + WS_WSB);
    bf16 *Wi = (bf16*)(ws + WS_WIN), *Wo = (bf16*)(ws + WS_WOUT), *Wu = (bf16*)(ws + WS_WUP), *Wd = (bf16*)(ws + WS_WDN), *Wg = (bf16*)(ws + WS_WGT), *Wp = (bf16*)(ws + WS_WPJ);
    bf16 *ACT = (bf16*)(ws + WS_ACT), *Z = (bf16*)(ws + WS_Z), *HID = (bf16*)(ws + WS_HID), *HG = (bf16*)(ws + WS_HG);
    float* ssq1 = (float*)(ws + WS_CTL) + CW_SSQ1; float* ssq2 = (float*)(ws + WS_CTL) + CW_SSQ2; float* ssq3 = (float*)(ws + WS_CTL) + CW_SSQ3;
    for (int u = F.tid; u < (LDS_BYTES - LDSCTL_OFF) / 4; u += NWAVES * 64) ((LAS unsigned*)(F.lds + LDSCTL_OFF))[u] = 0u;
    __syncthreads();
    const int lo = args.ph_lo, hi = args.ph_hi;
    XcdBarrier bar; bar.bar = (unsigned*)(F.ctl + CW_BAR) + args.li * XCD_BAR_WORDS; bar.x = 0; bar.st = nullptr;
    if (hi - lo > 1) bar = xcd_barrier_post((unsigned*)(F.ctl + CW_BAR) + args.li * XCD_BAR_WORDS, F.MISC + 8);
#define IN(k) (lo <= (k) && (k) < hi)
#define GRID_BAR(k) do { if (IN(k) && IN((k) + 1)) xcd_barrier(bar); } while (0)
    const int gw = F.vcu * NWAVES + F.wave, NGW = F.G * NWAVES;
#ifndef MK_REP0
#define MK_REP0 1
#endif
    if (IN(0))
_Pragma("unroll")
    for (int rep0 = 0; rep0 < MK_REP0; ++rep0) {
        LAS float* scr = (LAS float*)(F.lds + RING_OFF + F.wave * 16384);
        constexpr int I_IN = (DM / 64) * (DIN / 32), I_OUT = (DM / 64) * (DM / 32), I_UP = (DM / 64) * (DFF / 32), I_DN = (DFF / 64) * (DM / 32), I_GT = I_OUT, I_PJ = (PLE / 64) * (DM / 32);
        constexpr int NITEMS = I_IN + I_OUT + I_UP + I_DN + I_GT + I_PJ;
        for (int it = gw; it < NITEMS; it += NGW) {
            int r = it;
            if (r < I_IN) { p0_transpose_item(w_in, DM, DIN, Wi, scr, r, F.lane); continue; } r -= I_IN;
            if (r < I_OUT) { p0_transpose_item(w_out, DM, DM, Wo, scr, r, F.lane); continue; } r -= I_OUT;
            if (r < I_UP) { p0_transpose_item(w_up, DM, DFF, Wu, scr, r, F.lane, norm_ffn); continue; } r -= I_UP;
            if (r < I_DN) { p0_transpose_item(w_down, DFF, DM, Wd, scr, r, F.lane); continue; } r -= I_DN;
            if (r < I_GT) { p0_transpose_item(w_gate, DM, DM, Wg, scr, r, F.lane, norm_ple); continue; } r -= I_GT;
            p0_transpose_item(w_proj, PLE, DM, Wp, scr, r, F.lane);
        }
        for (int i = gw; i < M * PLE / 256; i += NGW) {
            const f32x4 v = ((const GAS f32x4*)p)[(size_t)i * 64 + F.lane];
            ((GAS unsigned long long*)PBF)[(size_t)i * 64 + F.lane] = (unsigned long long)pk2(v.x, v.y) | ((unsigned long long)pk2(v.z, v.w) << 32); }
        for (int i = gw; i < NH * CH * CH / 256; i += NGW) {
            const f32x4 v = ((const GAS f32x4*)w_s)[(size_t)i * 64 + F.lane]; const int e0 = i * 256 + F.lane * 4, s = e0 & 127, t = (e0 >> 7) & 127;
            ((GAS unsigned long long*)WSB)[(size_t)i * 64 + F.lane] = (unsigned long long)pk2(s <= t ? v.x : 0.f, s + 1 <= t ? v.y : 0.f) | ((unsigned long long)pk2(s + 2 <= t ? v.z : 0.f, s + 3 <= t ? v.w : 0.f) << 32); }
        for (int m = gw; m < M; m += NGW) rms_row_to_bf16(F.lane, x + (size_t)m * DM, norm_mix, ACT + (size_t)m * DM);
    }
    GRID_BAR(0);
    if (IN(1)) {
        pg8::Gemm g{ACT, Wi, M, DIN, DM}; pg8::StaticOrder S; S.init(M, DIN, F.G, (int)blockIdx.x);
        pg8::EpiInProj E{Z, DIN, (2 * AW) / 256, (3 * AW) / 256, QSCALE * 1.4426950408889634f};
        pg8::gemm_phase<pg8::EpiInProj, pg8::StaticOrder, true, true>(F.lds + RING_OFF, g, S, E);
    }
    GRID_BAR(1);
#ifndef MK_REP2
#define MK_REP2 1
#endif
    if (IN(2))
_Pragma("unroll")
    for (int rep2 = 0; rep2 < MK_REP2; ++rep2) {
        const int hw = F.wave >> 2, wq = F.wave & 3;
        LAS unsigned char* vn = F.lds + hw * 32768; LAS unsigned char* wls = F.lds + 65536 + F.wave * (32 * KST);
        constexpr int NSGU = NB * (SEQ / CH) * NH;
        for (int it = 0; it * (2 * F.G) < NSGU; ++it) { const int unit = it * (2 * F.G) + 2 * (int)blockIdx.x + hw;
            sgu_unit(unit < NSGU, unit < NSGU ? unit : 0, wq, F.lane, vn, wls, Z, WSB, b_s, norm_a, ACT); }
        LAS unsigned char* wl2 = F.lds + F.wave * WREG;
        constexpr int NATT = NB * NH * (SEQ / 32);
        for (int i = 0; ; ++i) { const int unit = (i * F.G + (int)blockIdx.x) * NWAVES + F.wave; if (unit >= NATT) break;
            attn_unit(unit, F.lane, wl2, Z, norm_b, ACT); }
    }
    GRID_BAR(2);
    if (IN(3)) {
        pg8::Gemm g{ACT, Wo, M, DM, DM}; pg8::StaticOrder S; S.init(M, DM, F.G, (int)blockIdx.x);
        pg8::EpiRes1 E{x, HG, ssq1, DM};
        pg8::gemm_phase<pg8::EpiRes1, pg8::StaticOrder, true, true>(F.lds + RING_OFF, g, S, E);
    }
    GRID_BAR(3);
    if (IN(4)) {
        pg8::Gemm g{HG, Wu, M, DFF, DM}; pg8::StaticOrder S; S.init(M, DFF, F.G, (int)blockIdx.x);
        pg8::EpiUp E{HID, DFF, ssq1, 1.0f / DM, EPS};
        pg8::gemm_phase<pg8::EpiUp, pg8::StaticOrder, true, true>(F.lds + RING_OFF, g, S, E);
    }
    GRID_BAR(4);
    if (IN(5)) {
        pg8::Gemm g{HID, Wd, M, DM, DFF}; pg8::StaticOrder S; S.init(M, DM, F.G, (int)blockIdx.x);
        pg8::EpiRes2 E{HG, ssq2, DM};
        pg8::gemm_phase<pg8::EpiRes2, pg8::StaticOrder, true, true>(F.lds + RING_OFF, g, S, E);
    }
    GRID_BAR(5);
    if (IN(6)) {
        pg8::Gemm g{PBF, Wp, M, DM, PLE}; pg8::StaticOrder S; S.init(M, DM, F.G, (int)blockIdx.x);
        pg8::EpiPlainBf16 E{ACT, DM};
        pg8::gemm_phase<pg8::EpiPlainBf16, pg8::StaticOrder, true, true>(F.lds + RING_OFF, g, S, E);
        VM_WAIT(); __syncthreads();
    }

    if (IN(7)) {
        pg8::Gemm g{HG, Wg, M, DM, DM}; pg8::StaticOrder S; S.init(M, DM, F.G, (int)blockIdx.x);
        pg8::EpiGate E{Z, HG, ACT, ssq2, ssq3, DM, 1.0f / DM, EPS};
        pg8::gemm_phase<pg8::EpiGate, pg8::StaticOrder, true, true>(F.lds + RING_OFF, g, S, E);
    }
    GRID_BAR(7);
    if (IN(8)) {
        for (int m = gw; m < M; m += NGW) final_row(F.lane, Z + (size_t)m * DM, out + (size_t)m * DM, norm_final, ssq3[m]);
    }
#if defined(MK_EXP)
    if (IN(9)) {
        pg8::Gemm g{HG, Wu, M, DFF, DM}; pg8::StaticOrder S; S.init(M, DFF, F.G, (int)blockIdx.x);
        pg8::EpiUp E{HID, DFF, ssq1, 1.0f / DM, EPS};
#if MK_EXP == 2
        struct SameUnit { int c; __device__ bool next(int i, pg8::Unit& u) const { if (i >= 16) return false; u.pm = c & 7; u.pn = (c >> 3) & 1; return true; }
            __device__ __forceinline__ void a_ready(const pg8::Unit&) const {} __device__ __forceinline__ void done(const pg8::Unit&) const {} } SU{(int)blockIdx.x};
        pg8::gemm_phase<pg8::EpiUp, SameUnit, true, true, false>(F.lds + RING_OFF, g, SU, E);
#else
        pg8::gemm_phase<pg8::EpiUp, pg8::StaticOrder, true, true, (MK_EXP == 1)>(F.lds + RING_OFF, g, S, E);
#endif
    }
#endif
#undef IN
#undef GRID_BAR
}

extern "C" void kernel_launch(void* const* d_in, const int* in_sizes, int n_in, void* d_out, int out_size, void* d_ws, size_t ws_size, hipStream_t stream) {
    static int grid = 0;
    if (grid == 0) {
        if (n_in != 16 || in_sizes[0] != M * DM || out_size != M * DM || ws_size < WS_END) { fprintf(stderr, "kernel_launch: unexpected shapes: n_in %d, in0 %d, out %d, ws %zu (need %zu); nothing launched\n", n_in, n_in > 0 ? in_sizes[0] : -1, out_size, ws_size, (size_t)WS_END); grid = -1; return; }
        int dev = 0, cus = 0, per_cu = 0;
        if (hipGetDevice(&dev) != hipSuccess || hipDeviceGetAttribute(&cus, hipDeviceAttributeMultiprocessorCount, dev) != hipSuccess) { fprintf(stderr, "kernel_launch: device query failed\n"); grid = -1; return; }
        if (hipFuncSetAttribute((const void*)mk_fwd, hipFuncAttributeMaxDynamicSharedMemorySize, LDS_BYTES) != hipSuccess) { fprintf(stderr, "kernel_launch: hipFuncSetAttribute failed\n"); grid = -1; return; }
        if (hipOccupancyMaxActiveBlocksPerMultiprocessor(&per_cu, (const void*)mk_fwd, NWAVES * 64, LDS_BYTES) != hipSuccess || per_cu < 1) { fprintf(stderr, "kernel_launch: occupancy query reports %d workgroups per CU\n", per_cu); }
        (void)hipGetLastError();
        grid = cus;
    }
    if (grid < 0) return;
    if (hipMemsetAsync((char*)d_ws + WS_CTL, 0, CTL_ZERO_BYTES, stream) != hipSuccess) { fprintf(stderr, "kernel_launch: hipMemsetAsync failed\n"); return; }
    Args a{};
    for (int i = 0; i < 16; ++i) a.in[i] = (const float*)d_in[i];
    a.out = (float*)d_out; a.ws = (unsigned char*)d_ws;
#if defined(MK_PLAN)
    { const int plan[] = MK_PLAN; int li = 0;
      for (unsigned i = 0; i + 1 < sizeof(plan) / sizeof(plan[0]); i += 2) { a.ph_lo = plan[i]; a.ph_hi = plan[i + 1]; a.li = li; if (plan[i + 1] - plan[i] > 1) ++li;
          hipLaunchKernelGGL(mk_fwd, dim3(grid), dim3(NWAVES * 64), LDS_BYTES, stream, a); } }
#else
    a.ph_lo = 0; a.ph_hi = N_PHASES; a.li = 0;
    hipLaunchKernelGGL(mk_fwd, dim3(grid), dim3(NWAVES * 64), LDS_BYTES, stream, a);
#endif
    const hipError_t le = hipPeekAtLastError();
    if (le != hipSuccess) fprintf(stderr, "kernel_launch: launch failed: %s\n", hipGetErrorName(le));
}
```

```cpp
#include <hip/hip_runtime.h>
#include <cstdio>
#include <cstdint>
namespace pg8 {
#define PG8_LAS __attribute__((address_space(3)))
typedef unsigned short bf16_t;
typedef short bf16x8 __attribute__((ext_vector_type(8)));
typedef float f32x4 __attribute__((ext_vector_type(4)));
typedef unsigned u32x4 __attribute__((ext_vector_type(4)));
constexpr int BM = 256, BK = 64, HALF = 128, HTB = HALF * BK * 2  , STAGE_BYTES = 8 * HTB, NXCD = 8, WGM = 8;

__host__ __device__ __forceinline__ int lds_byte(int r, int c) { const int st = (r >> 4) * 2 + (c >> 5), rr = r & 15, cc = c & 31, ob = rr * 64 + cc * 2; return st * 1024 + (ob ^ (((ob >> 9) & 1) << 5)); }
__host__ __device__ __forceinline__ void stage_rc(int b, int& R, int& C) { const int st = b / 1024, sb = b % 1024, swz = sb ^ (((sb >> 9) & 1) << 5); R = (st >> 1) * 16 + swz / 64; C = (st & 1) * 32 + (swz % 64) / 2; }
__host__ __device__ __forceinline__ int perm32(int rho) { const int n = rho >> 4, i = rho & 15; return 8 * (i >> 2) + 4 * n + (i & 3); }

struct Unit { int pm, pn; };
struct Gemm { const bf16_t* A; const bf16_t* Bt; int M, N, K; };

struct StaticOrder {
    int nM, nN, nwg, G, c;
    __host__ __device__ void init(int M, int N, int G_, int c_) { nM = M / BM; nN = N / BM; nwg = nM * nN; G = G_; c = c_; }
    __host__ __device__ bool next(int i, Unit& u) const {
        const long L = (long)i * G + c; if (L >= nwg) return false;
        int wgid = (int)L; { const int q = nwg / NXCD, r = nwg % NXCD, xcd = wgid % NXCD, off = wgid / NXCD; wgid = (xcd < r ? xcd * (q + 1) : r * (q + 1) + (xcd - r) * q) + off; }
        const int nig = WGM * nN, gid = wgid / nig, fm = gid * WGM, gsz = (nM - fm) < WGM ? (nM - fm) : WGM;
        u.pm = fm + ((wgid % nig) % gsz); u.pn = (wgid % nig) / gsz; return true;
    }
    __device__ __forceinline__ void a_ready(const Unit&) const {}
    __device__ __forceinline__ void done(const Unit&) const {}
};

__device__ __forceinline__ unsigned cvt_pk_bf16(float lo, float hi) { unsigned r; asm volatile("v_cvt_pk_bf16_f32 %0, %1, %2" : "=v"(r) : "v"(lo), "v"(hi)); return r; }
typedef float f32x2 __attribute__((ext_vector_type(2)));
typedef unsigned u32x2 __attribute__((ext_vector_type(2)));
__device__ __forceinline__ float bf_lo(unsigned w) { return __builtin_bit_cast(float, w << 16); }
__device__ __forceinline__ float bf_hi(unsigned w) { return __builtin_bit_cast(float, w & 0xffff0000u); }
__device__ __forceinline__ float gelu_tanh_f(float x) {
    const float x2 = x * x, t = x * (-2.302208198f + (-0.1029432397f) * x2);
    return x * __builtin_amdgcn_rcpf(1.0f + __builtin_amdgcn_exp2f(t));
}
__device__ __forceinline__ u32x4 pack8(const f32x4 v0, const f32x4 v1) { u32x4 w; w.x = cvt_pk_bf16(v0[0], v0[1]); w.y = cvt_pk_bf16(v0[2], v0[3]); w.z = cvt_pk_bf16(v1[0], v1[1]); w.w = cvt_pk_bf16(v1[2], v1[3]); return w; }
struct EpiInProj {
    static constexpr bool PERM = true, AFTER_DRAIN = false;
    bf16_t* O; int ldc; int gelu_tiles, q_tiles; float qscale;
    __device__ __forceinline__ void operator()(const f32x4 (&acc)[2][2][4][2], const Unit& u, int wr, int wc, int fr, int fq) const {
        const int row0 = u.pm * BM + wr * 64 + fr, col0 = u.pn * BM + wc * 32 + 8 * fq;
        const int mode = u.pn < gelu_tiles ? 1 : (u.pn < q_tiles ? 2 : 0);
#pragma unroll
        for (int ai = 0; ai < 2; ++ai)
#pragma unroll
            for (int m = 0; m < 4; ++m) { bf16_t* rowp = O + (size_t)(row0 + ai * HALF + m * 16) * ldc + col0;
#pragma unroll
                for (int bj = 0; bj < 2; ++bj) { f32x4 v0 = acc[ai][bj][m][0], v1 = acc[ai][bj][m][1];
                    if (mode == 1) {
#pragma unroll
                        for (int e = 0; e < 4; ++e) { v0[e] = gelu_tanh_f(v0[e]); v1[e] = gelu_tanh_f(v1[e]); } }
                    else if (mode == 2) { v0 = v0 * qscale; v1 = v1 * qscale; }
                    *(u32x4*)(rowp + bj * HALF) = pack8(v0, v1); } }
    }
};
struct EpiPlainBf16 {
    static constexpr bool PERM = true, AFTER_DRAIN = false;
    bf16_t* O; int ldc;
    __device__ __forceinline__ void operator()(const f32x4 (&acc)[2][2][4][2], const Unit& u, int wr, int wc, int fr, int fq) const {
        const int row0 = u.pm * BM + wr * 64 + fr, col0 = u.pn * BM + wc * 32 + 8 * fq;
#pragma unroll
        for (int ai = 0; ai < 2; ++ai)
#pragma unroll
            for (int m = 0; m < 4; ++m) { bf16_t* rowp = O + (size_t)(row0 + ai * HALF + m * 16) * ldc + col0;
#pragma unroll
                for (int bj = 0; bj < 2; ++bj) *(u32x4*)(rowp + bj * HALF) = pack8(acc[ai][bj][m][0], acc[ai][bj][m][1]); }
    }
};
#define SQ8(h0, h1) ((h0[0] * h0[0] + h0[1] * h0[1]) + (h0[2] * h0[2] + h0[3] * h0[3]) + (h1[0] * h1[0] + h1[1] * h1[1]) + (h1[2] * h1[2] + h1[3] * h1[3]))
struct EpiRes1 {
    static constexpr bool PERM = true, AFTER_DRAIN = false;
    const float* base; bf16_t* hb; float* ssq; int ldc;
    __device__ __forceinline__ void operator()(const f32x4 (&acc)[2][2][4][2], const Unit& u, int wr, int wc, int fr, int fq) const {
        const int row0 = u.pm * BM + wr * 64 + fr, col0 = u.pn * BM + wc * 32 + 8 * fq;
#pragma unroll
        for (int ai = 0; ai < 2; ++ai) {
            f32x4 pre[4][2][2];
#pragma unroll
            for (int m = 0; m < 4; ++m) { const size_t off = (size_t)(row0 + ai * HALF + m * 16) * ldc + col0;
#pragma unroll
                for (int bj = 0; bj < 2; ++bj) { pre[m][bj][0] = *(const f32x4*)(base + off + bj * HALF); pre[m][bj][1] = *(const f32x4*)(base + off + bj * HALF + 4); } }
            asm volatile("" ::: "memory");
#pragma unroll
            for (int m = 0; m < 4; ++m) { const int row = row0 + ai * HALF + m * 16; const size_t off = (size_t)row * ldc + col0; float s = 0.f;
#pragma unroll
                for (int bj = 0; bj < 2; ++bj) { const f32x4 h0 = pre[m][bj][0] + acc[ai][bj][m][0], h1 = pre[m][bj][1] + acc[ai][bj][m][1];
                    s += SQ8(h0, h1); *(u32x4*)(hb + off + bj * HALF) = pack8(h0, h1); }
                s += __shfl_xor(s, 16); s += __shfl_xor(s, 32);
                if (fq == 0) atomicAdd(ssq + row, s); }
            asm volatile("" ::: "memory"); }
    }
};
struct EpiRes2 {
    static constexpr bool PERM = true, AFTER_DRAIN = false;
    bf16_t* hb; float* ssq; int ldc;
    __device__ __forceinline__ void operator()(const f32x4 (&acc)[2][2][4][2], const Unit& u, int wr, int wc, int fr, int fq) const {
        const int row0 = u.pm * BM + wr * 64 + fr, col0 = u.pn * BM + wc * 32 + 8 * fq;
        u32x4 pre[2][4][2];
#pragma unroll
        for (int ai = 0; ai < 2; ++ai)
#pragma unroll
            for (int m = 0; m < 4; ++m) { const size_t off = (size_t)(row0 + ai * HALF + m * 16) * ldc + col0;
#pragma unroll
                for (int bj = 0; bj < 2; ++bj) pre[ai][m][bj] = *(const u32x4*)(hb + off + bj * HALF); }
        asm volatile("" ::: "memory");
#pragma unroll
        for (int ai = 0; ai < 2; ++ai)
#pragma unroll
            for (int m = 0; m < 4; ++m) { const int row = row0 + ai * HALF + m * 16; const size_t off = (size_t)row * ldc + col0; float s = 0.f;
#pragma unroll
                for (int bj = 0; bj < 2; ++bj) { const u32x4 bw = pre[ai][m][bj];
                    const f32x4 h0 = (f32x4){bf_lo(bw.x), bf_hi(bw.x), bf_lo(bw.y), bf_hi(bw.y)} + acc[ai][bj][m][0], h1 = (f32x4){bf_lo(bw.z), bf_hi(bw.z), bf_lo(bw.w), bf_hi(bw.w)} + acc[ai][bj][m][1];
                    s += SQ8(h0, h1); *(u32x4*)(hb + off + bj * HALF) = pack8(h0, h1); }
                s += __shfl_xor(s, 16); s += __shfl_xor(s, 32);
                if (fq == 0) atomicAdd(ssq + row, s); }
    }
};
struct EpiUp {
    static constexpr bool PERM = true, AFTER_DRAIN = false;
    bf16_t* O; int ldc; const float* ssq; float inv_n, eps;
    __device__ __forceinline__ void operator()(const f32x4 (&acc)[2][2][4][2], const Unit& u, int wr, int wc, int fr, int fq) const {
        const int row0 = u.pm * BM + wr * 64 + fr, col0 = u.pn * BM + wc * 32 + 8 * fq;
#pragma unroll
        for (int ai = 0; ai < 2; ++ai)
#pragma unroll
            for (int m = 0; m < 4; ++m) { const int row = row0 + ai * HALF + m * 16; bf16_t* rowp = O + (size_t)row * ldc + col0;
                const float r2 = 1.0f / (ssq[row] * inv_n + eps);
#pragma unroll
                for (int bj = 0; bj < 2; ++bj) { f32x4 v0 = acc[ai][bj][m][0], v1 = acc[ai][bj][m][1];
#pragma unroll
                    for (int e = 0; e < 4; ++e) { const float a = fmaxf(v0[e], 0.f), b = fmaxf(v1[e], 0.f); v0[e] = a * a * r2; v1[e] = b * b * r2; }
                    *(u32x4*)(rowp + bj * HALF) = pack8(v0, v1); } }
    }
};
struct EpiGate {
    static constexpr bool PERM = true, AFTER_DRAIN = false;
    bf16_t* h3b; const bf16_t* hb; const bf16_t* E; const float* ssq_in; float* ssq_out; int ldc; float inv_n, eps;
    __device__ __forceinline__ void operator()(const f32x4 (&acc)[2][2][4][2], const Unit& u, int wr, int wc, int fr, int fq) const {
        const int row0 = u.pm * BM + wr * 64 + fr, col0 = u.pn * BM + wc * 32 + 8 * fq;
#pragma unroll
        for (int ai = 0; ai < 2; ++ai) {
            u32x4 preh[4][2], pree[4][2]; float nrs[4];
#pragma unroll
            for (int m = 0; m < 4; ++m) { const int row = row0 + ai * HALF + m * 16; const size_t off = (size_t)row * ldc + col0; nrs[m] = ssq_in[row];
#pragma unroll
                for (int bj = 0; bj < 2; ++bj) { preh[m][bj] = *(const u32x4*)(hb + off + bj * HALF); pree[m][bj] = *(const u32x4*)(E + off + bj * HALF); } }
            asm volatile("" ::: "memory");
#pragma unroll
            for (int m = 0; m < 4; ++m) { const int row = row0 + ai * HALF + m * 16; const size_t off = (size_t)row * ldc + col0; float s = 0.f;
                const float nr = -1.4426950408889634f / sqrtf(nrs[m] * inv_n + eps);
#pragma unroll
                for (int bj = 0; bj < 2; ++bj) { const u32x4 ew = pree[m][bj], bw = preh[m][bj];
                    f32x4 h0 = (f32x4){bf_lo(bw.x), bf_hi(bw.x), bf_lo(bw.y), bf_hi(bw.y)}, h1 = (f32x4){bf_lo(bw.z), bf_hi(bw.z), bf_lo(bw.w), bf_hi(bw.w)};
                    const f32x4 a0 = acc[ai][bj][m][0], a1 = acc[ai][bj][m][1];
                    const float e0[4] = {bf_lo(ew.x), bf_hi(ew.x), bf_lo(ew.y), bf_hi(ew.y)}, e1[4] = {bf_lo(ew.z), bf_hi(ew.z), bf_lo(ew.w), bf_hi(ew.w)};
#pragma unroll
                    for (int e = 0; e < 4; ++e) {
                        h0[e] += __builtin_amdgcn_rcpf(1.0f + __builtin_amdgcn_exp2f(nr * a0[e])) * e0[e];
                        h1[e] += __builtin_amdgcn_rcpf(1.0f + __builtin_amdgcn_exp2f(nr * a1[e])) * e1[e]; }
                    s += SQ8(h0, h1); *(u32x4*)(h3b + off + bj * HALF) = pack8(h0, h1); }
                s += __shfl_xor(s, 16); s += __shfl_xor(s, 32);
                if (fq == 0) atomicAdd(ssq_out + row, s); }
            asm volatile("" ::: "memory"); }
    }
};
template <class Epi, class Sched, bool ALIGN_EPI = false, bool SP2 = false, bool TILED = false, int DBG = 0  , int GV = 0  >
__device__ __forceinline__ void gemm_phase(PG8_LAS unsigned char* lds, const Gemm g, const Sched& S, const Epi& E) {
    const int tid = threadIdx.x, wid = __builtin_amdgcn_readfirstlane(tid >> 6), lane = tid & 63, wr = wid >> 2, wc = wid & 3, fr = lane & 15, fq = lane >> 4;
    const int K = g.K, nt = K / BK;
    unsigned voffA[2], voffB[2];
#pragma unroll
    for (int i = 0; i < 2; ++i) { int R, C; stage_rc(tid * 16 + i * 8192, R, C); const int Rb = Epi::PERM ? ((R & ~31) + perm32(R & 31)) : R;
        voffA[i] = (unsigned)(R * K + C) * 2u; voffB[i] = (unsigned)(Rb * K + C) * 2u;
        if (TILED) { voffA[i] = voffB[i] = (unsigned)(tid * 16 + i * 8192); } }
    const size_t kstep = TILED ? (size_t)HTB : (size_t)(BK * 2);
    const size_t hstep = (size_t)HALF * K * 2;
    const size_t tstep = 2 * hstep;
    const unsigned ldsw = (unsigned)wid * 1024u;
    const int aoff = lds_byte(wr * 64 + fr, fq * 8), boff = lds_byte(wc * 32 + fr, fq * 8);
#define PG8_SA(b, h) (((b) * 2 + (h)) * HTB)
#define PG8_SB(b, h) ((4 + (b) * 2 + (h)) * HTB)
#define PG8_STAGE(bufoff, gbase, voff) do { if (DBG >= 3) break; _Pragma("unroll") for (int _i = 0; _i < 2; ++_i) \
        __builtin_amdgcn_global_load_lds((const unsigned*)((const char*)(gbase) + (voff)[_i]), (PG8_LAS unsigned*)(lds + (bufoff) + ldsw + _i * 8192), 16, 0, 0); } while (0)
#define PG8_LDA(dst, b, h) do { if (DBG >= 2) break; _Pragma("unroll") for (int m = 0; m < 4; ++m) _Pragma("unroll") for (int k = 0; k < 2; ++k) dst[m][k] = *(const PG8_LAS bf16x8*)(lds + PG8_SA(b, h) + aoff + m * 2048 + k * 1024); } while (0)
#define PG8_LDB(dst, b, h) do { if (DBG >= 2) break; _Pragma("unroll") for (int n = 0; n < 2; ++n) _Pragma("unroll") for (int k = 0; k < 2; ++k) dst[n][k] = *(const PG8_LAS bf16x8*)(lds + PG8_SB(b, h) + boff + n * 2048 + k * 1024); } while (0)
#define PG8_MMA(ai, bj, At, Bt) do { __builtin_amdgcn_s_setprio(1); _Pragma("unroll") for (int m = 0; m < 4; ++m) _Pragma("unroll") for (int n = 0; n < 2; ++n) _Pragma("unroll") for (int k = 0; k < 2; ++k) { \
        if (DBG == 1 || (DBG == 4 && (bj) == 1)) { asm volatile("" :: "v"(Bt[n][k]), "v"(At[m][k])); } else \
        acc[ai][bj][m][n] = __builtin_amdgcn_mfma_f32_16x16x32_bf16(Bt[n][k], At[m][k], acc[ai][bj][m][n], 0, 0, 0); } __builtin_amdgcn_s_setprio(0); } while (0)
#define PG8_WAIT_V(n) asm volatile("s_waitcnt vmcnt(" #n ")" ::: "memory")
#define PG8_WAIT_L(n) asm volatile("s_waitcnt lgkmcnt(" #n ")" ::: "memory")
#define PG8_BAR __builtin_amdgcn_s_barrier()
#define PG8_SCHED __builtin_amdgcn_sched_barrier(0)
    Unit cur, nxt; int ui = 0;
    if (!S.next(0, cur)) return;
    f32x4 acc[2][2][4][2];
#pragma unroll
    for (int a = 0; a < 2; ++a)
#pragma unroll
        for (int b = 0; b < 2; ++b)
#pragma unroll
            for (int m = 0; m < 4; ++m)
#pragma unroll
                for (int n = 0; n < 2; ++n) acc[a][b][m][n] = (f32x4){0.f, 0.f, 0.f, 0.f};
    bf16x8 At[4][2], B0[2][2], B1[2][2];
    if (DBG >= 2) { _Pragma("unroll") for (int k = 0; k < 2; ++k) { _Pragma("unroll") for (int m = 0; m < 4; ++m) _Pragma("unroll") for (int e = 0; e < 8; ++e) At[m][k][e] = (short)(0x3f00 + ((tid * 37 + m * 11 + k * 5 + e * 3) & 0xff) - ((tid + e) & 1) * 0x8000);
        _Pragma("unroll") for (int n = 0; n < 2; ++n) _Pragma("unroll") for (int e = 0; e < 8; ++e) { B0[n][k][e] = (short)(0x3f00 + ((tid * 29 + n * 13 + k * 7 + e * 5) & 0xff) - ((tid + e + n) & 1) * 0x8000); B1[n][k][e] = (short)(0x3f00 + ((tid * 23 + n * 17 + k * 3 + e * 7) & 0xff) - ((tid + e + k) & 1) * 0x8000); } } }
    const char* cA = (const char*)g.A + (size_t)cur.pm * tstep; const char* cB = (const char*)g.Bt + (size_t)cur.pn * tstep;
    S.a_ready(cur);
    if constexpr (SP2) {
        PG8_STAGE(PG8_SB(0, 0), cB, voffB); PG8_STAGE(PG8_SB(0, 1), cB + hstep, voffB); PG8_STAGE(PG8_SA(0, 0), cA, voffA); PG8_STAGE(PG8_SA(0, 1), cA + hstep, voffA);
        if (wr == 1) PG8_BAR;
        PG8_WAIT_V(2); PG8_BAR;
        PG8_STAGE(PG8_SB(1, 0), cB + kstep, voffB); PG8_STAGE(PG8_SA(1, 0), cA + kstep, voffA); PG8_STAGE(PG8_SB(1, 1), cB + hstep + kstep, voffB);
        PG8_WAIT_V(6); PG8_BAR;
    } else {
        PG8_STAGE(PG8_SB(0, 0), cB, voffB); PG8_STAGE(PG8_SA(0, 0), cA, voffA); PG8_STAGE(PG8_SB(0, 1), cB + hstep, voffB); PG8_STAGE(PG8_SA(0, 1), cA + hstep, voffA);
        if (wr == 1) PG8_BAR;
        PG8_WAIT_V(4); PG8_BAR;
        PG8_STAGE(PG8_SB(1, 0), cB + kstep, voffB); PG8_STAGE(PG8_SA(1, 0), cA + kstep, voffA); PG8_STAGE(PG8_SB(1, 1), cB + hstep + kstep, voffB);
        PG8_WAIT_V(6); PG8_BAR;
    }
    for (;;) {
        const bool has_next = S.next(ui + 1, nxt);
        const char* nA = has_next ? (const char*)g.A + (size_t)nxt.pm * tstep : cA; const char* nB = has_next ? (const char*)g.Bt + (size_t)nxt.pn * tstep : cB;
        for (int t = 0; t < nt; t += 2) {
            const bool last = (t == nt - 2);
            const char* a1 = cA + (size_t)(t + 1) * kstep;
            const char* a2 = last ? nA : cA + (size_t)(t + 2) * kstep; const char* b2 = last ? nB : cB + (size_t)(t + 2) * kstep;
            const char* a3 = a2 + kstep; const char* b3 = b2 + kstep;
            if (last && has_next) S.a_ready(nxt);
            if constexpr (SP2 && GV == 1) {
            PG8_LDB(B0, 0, 0); PG8_LDB(B1, 0, 1); PG8_SCHED; PG8_LDA(At, 0, 0);
            PG8_WAIT_V(6); PG8_WAIT_L(0); PG8_BAR; PG8_MMA(0, 0, At, B0); PG8_SCHED; PG8_STAGE(PG8_SA(1, 1), a1 + hstep, voffA); PG8_SCHED; PG8_MMA(0, 1, At, B1); PG8_BAR; PG8_SCHED;
            PG8_LDA(At, 0, 1);
            PG8_WAIT_V(2); PG8_WAIT_L(0); PG8_BAR; PG8_MMA(1, 0, At, B0); PG8_SCHED; PG8_STAGE(PG8_SB(0, 0), b2, voffB); PG8_STAGE(PG8_SB(0, 1), b2 + hstep, voffB); PG8_STAGE(PG8_SA(0, 0), a2, voffA); PG8_SCHED; PG8_MMA(1, 1, At, B1); PG8_BAR; PG8_SCHED;
            PG8_LDB(B0, 1, 0); PG8_LDB(B1, 1, 1); PG8_SCHED; PG8_LDA(At, 1, 0);
            PG8_WAIT_V(6); PG8_WAIT_L(0); PG8_BAR; PG8_MMA(0, 0, At, B0); PG8_SCHED; PG8_STAGE(PG8_SA(0, 1), a2 + hstep, voffA); PG8_SCHED; PG8_MMA(0, 1, At, B1); PG8_BAR; PG8_SCHED;
            PG8_LDA(At, 1, 1);
            PG8_WAIT_V(2); PG8_WAIT_L(0); PG8_BAR; PG8_MMA(1, 0, At, B0); PG8_SCHED; PG8_STAGE(PG8_SB(1, 0), b3, voffB); PG8_STAGE(PG8_SB(1, 1), b3 + hstep, voffB); PG8_STAGE(PG8_SA(1, 0), a3, voffA); PG8_SCHED; PG8_MMA(1, 1, At, B1); PG8_BAR; PG8_SCHED;
            } else if constexpr (SP2 && GV == 2) {
            PG8_LDB(B0, 0, 0); PG8_LDB(B1, 0, 1); PG8_SCHED; PG8_LDA(At, 0, 0); PG8_STAGE(PG8_SA(1, 1), a1 + hstep, voffA);
            PG8_WAIT_V(8); PG8_WAIT_L(0); PG8_BAR; PG8_MMA(0, 0, At, B0); PG8_MMA(0, 1, At, B1); PG8_BAR; PG8_SCHED;
            PG8_LDA(At, 0, 1); PG8_STAGE(PG8_SB(0, 0), b2, voffB); PG8_STAGE(PG8_SB(0, 1), b2 + hstep, voffB);
            PG8_WAIT_V(6); PG8_WAIT_L(0); PG8_BAR; PG8_MMA(1, 0, At, B0); PG8_SCHED; PG8_STAGE(PG8_SA(0, 0), a2, voffA); PG8_SCHED; PG8_MMA(1, 1, At, B1); PG8_BAR; PG8_SCHED;
            PG8_LDB(B0, 1, 0); PG8_LDB(B1, 1, 1); PG8_SCHED; PG8_LDA(At, 1, 0); PG8_STAGE(PG8_SA(0, 1), a2 + hstep, voffA);
            PG8_WAIT_V(8); PG8_WAIT_L(0); PG8_BAR; PG8_MMA(0, 0, At, B0); PG8_MMA(0, 1, At, B1); PG8_BAR; PG8_SCHED;
            PG8_LDA(At, 1, 1); PG8_STAGE(PG8_SB(1, 0), b3, voffB); PG8_STAGE(PG8_SB(1, 1), b3 + hstep, voffB);
            PG8_WAIT_V(6); PG8_WAIT_L(0); PG8_BAR; PG8_MMA(1, 0, At, B0); PG8_SCHED; PG8_STAGE(PG8_SA(1, 0), a3, voffA); PG8_SCHED; PG8_MMA(1, 1, At, B1); PG8_BAR; PG8_SCHED;
            } else if constexpr (SP2) {
            PG8_LDB(B0, 0, 0); PG8_LDB(B1, 0, 1); PG8_SCHED; PG8_LDA(At, 0, 0); PG8_STAGE(PG8_SA(1, 1), a1 + hstep, voffA);
            PG8_WAIT_V(8); PG8_WAIT_L(0); PG8_BAR; PG8_MMA(0, 0, At, B0); PG8_MMA(0, 1, At, B1); PG8_BAR; PG8_SCHED;
            PG8_LDA(At, 0, 1); PG8_STAGE(PG8_SB(0, 0), b2, voffB); PG8_STAGE(PG8_SB(0, 1), b2 + hstep, voffB); PG8_STAGE(PG8_SA(0, 0), a2, voffA);
            PG8_WAIT_V(8); PG8_WAIT_L(0); PG8_BAR; PG8_MMA(1, 0, At, B0); PG8_MMA(1, 1, At, B1); PG8_BAR; PG8_SCHED;
            PG8_LDB(B0, 1, 0); PG8_LDB(B1, 1, 1); PG8_SCHED; PG8_LDA(At, 1, 0); PG8_STAGE(PG8_SA(0, 1), a2 + hstep, voffA);
            PG8_WAIT_V(8); PG8_WAIT_L(0); PG8_BAR; PG8_MMA(0, 0, At, B0); PG8_MMA(0, 1, At, B1); PG8_BAR; PG8_SCHED;
            PG8_LDA(At, 1, 1); PG8_STAGE(PG8_SB(1, 0), b3, voffB); PG8_STAGE(PG8_SB(1, 1), b3 + hstep, voffB); PG8_STAGE(PG8_SA(1, 0), a3, voffA);
            PG8_WAIT_V(8); PG8_WAIT_L(0); PG8_BAR; PG8_MMA(1, 0, At, B0); PG8_MMA(1, 1, At, B1); PG8_BAR; PG8_SCHED;
            } else {
            PG8_LDB(B0, 0, 0); PG8_SCHED; PG8_LDA(At, 0, 0); PG8_STAGE(PG8_SA(1, 1), a1 + hstep, voffA);
            PG8_WAIT_L(8); PG8_BAR; PG8_WAIT_L(0); PG8_MMA(0, 0, At, B0); PG8_BAR; PG8_SCHED;
            PG8_LDB(B1, 0, 1); PG8_STAGE(PG8_SB(0, 0), b2, voffB);
            PG8_BAR; PG8_WAIT_L(0); PG8_MMA(0, 1, At, B1); PG8_BAR;
            PG8_LDA(At, 0, 1); PG8_STAGE(PG8_SA(0, 0), a2, voffA);
            PG8_BAR; PG8_WAIT_L(0); PG8_MMA(1, 0, At, B0); PG8_BAR; PG8_SCHED;
            PG8_STAGE(PG8_SB(0, 1), b2 + hstep, voffB);
            PG8_WAIT_V(6); PG8_BAR; PG8_MMA(1, 1, At, B1); PG8_BAR;
            PG8_LDB(B0, 1, 0); PG8_SCHED; PG8_LDA(At, 1, 0); PG8_STAGE(PG8_SA(0, 1), a2 + hstep, voffA);
            PG8_WAIT_L(8); PG8_BAR; PG8_WAIT_L(0); PG8_MMA(0, 0, At, B0); PG8_BAR; PG8_SCHED;
            PG8_LDB(B1, 1, 1); PG8_STAGE(PG8_SB(1, 0), b3, voffB);
            PG8_BAR; PG8_WAIT_L(0); PG8_MMA(0, 1, At, B1); PG8_BAR;
            PG8_LDA(At, 1, 1); PG8_STAGE(PG8_SA(1, 0), a3, voffA);
            PG8_BAR; PG8_WAIT_L(0); PG8_MMA(1, 0, At, B0); PG8_BAR; PG8_SCHED;
            PG8_STAGE(PG8_SB(1, 1), b3 + hstep, voffB);
            PG8_WAIT_V(6); PG8_BAR; PG8_MMA(1, 1, At, B1); PG8_BAR;
            }
        }
        if constexpr (ALIGN_EPI) { if (wr == 0) PG8_BAR; }
        if constexpr (!Epi::AFTER_DRAIN) { E(acc, cur, wr, wc, fr, fq); S.done(cur); }
        if (!has_next) break;
#pragma unroll
        for (int a = 0; a < 2; ++a)
#pragma unroll
            for (int b = 0; b < 2; ++b)
#pragma unroll
                for (int m = 0; m < 4; ++m)
#pragma unroll
                    for (int n = 0; n < 2; ++n) acc[a][b][m][n] = (f32x4){0.f, 0.f, 0.f, 0.f};
        cur = nxt; cA = nA; cB = nB; ++ui;
        if constexpr (ALIGN_EPI) { if (wr == 1) PG8_BAR; }
    }
    PG8_WAIT_V(0);
    if constexpr (!ALIGN_EPI) { if (wr == 0) PG8_BAR; }
    PG8_BAR;
    if constexpr (Epi::AFTER_DRAIN) { E.fused(acc, cur, wr, wc, fr, fq, lds, wid, lane); S.done(cur); }
#undef PG8_SA
#undef PG8_SB
#undef PG8_STAGE
#undef PG8_LDA
#undef PG8_LDB
#undef PG8_MMA
#undef PG8_WAIT_V
#undef PG8_WAIT_L
#undef PG8_BAR
#undef PG8_SCHED
}
}
constexpr int NWAVES = 8;
constexpr int NB = 4, SEQ = 4096, DM = 4096, M = NB * SEQ, DIN = 10240, DFF = 16384, PLE = 256, AW = 2048, NH = 16, HD = 128, CH = 128;
constexpr float EPS = 1e-6f;
constexpr float QSCALE = 0.08838834764831845f;
constexpr size_t MiB = 1u << 20;
constexpr size_t WS_CTL = 0, CTL_ZERO_BYTES = 256 * 1024;
constexpr size_t WS_PBF = 1 * MiB;
constexpr size_t WS_WSB = 9 * MiB;
constexpr size_t WS_WIN = 10 * MiB, WS_WOUT = WS_WIN + 80 * MiB, WS_WUP = WS_WOUT + 32 * MiB, WS_WDN = WS_WUP + 128 * MiB, WS_WGT = WS_WDN + 128 * MiB, WS_WPJ = WS_WGT + 32 * MiB;
constexpr size_t WS_ACT = WS_WPJ + 2 * MiB;
constexpr size_t WS_Z = WS_ACT + 128 * MiB;
constexpr size_t WS_HID = WS_ACT;
constexpr size_t WS_HG = WS_ACT + 512 * MiB;
constexpr size_t WS_END = WS_HG + 128 * MiB;
static_assert(WS_Z + (size_t)M * DIN * 2 <= WS_HG && WS_HID + (size_t)M * DFF * 2 <= WS_HG && WS_WPJ + (size_t)DM * PLE * 2 <= WS_ACT && WS_PBF + (size_t)M * PLE * 2 <= WS_WSB, "d_ws map");
constexpr int CW_TMO = 0, CW_CODE = 1;
constexpr int CW_BAR = 4096;
constexpr int CW_SSQ1 = 16384, CW_SSQ2 = 32768, CW_SSQ3 = 49152;
static_assert((CW_SSQ3 + M) * 4 <= (int)CTL_ZERO_BYTES, "CTL words inside the memset region");
constexpr int RING_OFF = 0, RING_BYTES = 131072;
constexpr int LDS_BYTES = 147456;
constexpr int LDSCTL_OFF = LDS_BYTES - 1024, MISC_OFF = LDSCTL_OFF + 320;
static_assert(MISC_OFF + 128 <= LDS_BYTES, "LDS map");

#define GAS __attribute__((address_space(1)))
#define LAS __attribute__((address_space(3)))
typedef unsigned short bf16;
typedef unsigned v4u __attribute__((ext_vector_type(4)));
typedef float f32x4 __attribute__((ext_vector_type(4)));
typedef short bf16x8 __attribute__((ext_vector_type(8)));
typedef GAS unsigned gu32;
typedef GAS unsigned long long gu64;
#define RLX_AGENT __ATOMIC_RELAXED, __HIP_MEMORY_SCOPE_AGENT
#define LDS_WAIT() asm volatile("s_waitcnt lgkmcnt(0)" ::: "memory")
#define VM_WAIT() asm volatile("s_waitcnt vmcnt(0)" ::: "memory")
__device__ __forceinline__ unsigned long long rt() { return __builtin_amdgcn_s_memrealtime(); }
__device__ __forceinline__ unsigned f2bf(float f) { unsigned u = __builtin_bit_cast(unsigned, f); return (u + 0x7fffu + ((u >> 16) & 1u)) >> 16; }
__device__ __forceinline__ unsigned pk2(float lo, float hi) { return f2bf(lo) | (f2bf(hi) << 16); }
#define XB_TMO      128
#define XB_XCNT(j)  (256  + 64 * (j))
#define XB_XSUB(j)  (1280 + 64 * (j))
#define XB_XGEN(j)  (2304 + 64 * (j))
#define XB_TOP      3328
#define XB_TOPGEN   3392
#define XCD_BAR_WORDS 3456
#define XB_SPIN_CAP (1u << 18)

__device__ __forceinline__ unsigned xb_ld(unsigned* p)              { return __hip_atomic_load(p, __ATOMIC_RELAXED, __HIP_MEMORY_SCOPE_AGENT); }
__device__ __forceinline__ unsigned xb_add(unsigned* p, unsigned v) { return __hip_atomic_fetch_add(p, v, __ATOMIC_RELAXED, __HIP_MEMORY_SCOPE_AGENT); }
__device__ __forceinline__ unsigned xb_xcc_id() { return (unsigned)__builtin_amdgcn_s_getreg((3 << 11) | 20) & 0xFu; }
#define XB_SPIN(cond, bar) do { unsigned _sp = 0; while (cond) { __builtin_amdgcn_s_sleep(1); \
    if ((++_sp & 255u) == 0u) { if (xb_ld(&(bar)[XB_TMO])) break; if (_sp > XB_SPIN_CAP) { atomicAdd(&(bar)[XB_TMO], 1u); break; } } } } while (0)

struct XcdBarrier {
    unsigned* bar; unsigned x;
    volatile LAS unsigned* st;
};

__device__ __forceinline__ XcdBarrier xcd_barrier_post(unsigned* bar, volatile LAS unsigned* st) {
    XcdBarrier b; b.bar = bar; b.x = xb_xcc_id(); b.st = st;
    if (threadIdx.x == 0) (void)xb_add(&bar[XB_XCNT(b.x)], 1u);
    return b;
}
__device__ __forceinline__ void xcd_barrier_complete(unsigned* bar, unsigned x, unsigned& nloc, unsigned& nx) {
    const unsigned G = gridDim.x * gridDim.y * gridDim.z;
    unsigned sum, cnt, mine, sp = 0u;
    for (;;) {
        sum = 0u; cnt = 0u; mine = 0u;
#pragma unroll
        for (unsigned j = 0; j < 16; ++j) { const unsigned c = xb_ld(&bar[XB_XCNT(j)]); sum += c; cnt += (c > 0u) ? 1u : 0u; mine = (j == x) ? c : mine; }
        if (sum == G) break;
        __builtin_amdgcn_s_sleep(1);
        if ((++sp & 255u) == 0u) { if (xb_ld(&bar[XB_TMO])) break; if (sp > XB_SPIN_CAP) { atomicAdd(&bar[XB_TMO], 1u); break; } }
    }
    nloc = mine > 0u ? mine : 1u; nx = cnt > 0u ? cnt : 1u;
}

__device__ __forceinline__ void xcd_barrier(const XcdBarrier& b) {
    asm volatile("s_waitcnt vmcnt(0)" ::: "memory");
    __syncthreads();
    if (threadIdx.x == 0) {
        unsigned* bar = b.bar;
        __builtin_amdgcn_s_waitcnt(0);
        unsigned nloc = b.st[0], nx = b.st[1];
        if (nloc == 0u) { xcd_barrier_complete(bar, b.x, nloc, nx); b.st[0] = nloc; b.st[1] = nx; }
        const unsigned old = xb_add(&bar[XB_XSUB(b.x)], 1u);
        const unsigned gen = old / nloc;
        if (old + 1u == (gen + 1u) * nloc) {
            __builtin_amdgcn_fence(__ATOMIC_RELEASE, "agent");
            asm volatile("s_waitcnt vmcnt(0)" ::: "memory");
            const unsigned og = xb_add(&bar[XB_TOP], 1u);
            const unsigned tg = og / nx;
            if (og + 1u == (tg + 1u) * nx) xb_add(&bar[XB_TOPGEN], 1u);
            else XB_SPIN(xb_ld(&bar[XB_TOPGEN]) == tg, bar);
            __builtin_amdgcn_fence(__ATOMIC_ACQUIRE, "agent");
            xb_add(&bar[XB_XGEN(b.x)], 1u);
            asm volatile("s_waitcnt vmcnt(0)" ::: "memory");
        } else {
            XB_SPIN(xb_ld(&bar[XB_XGEN(b.x)]) == gen, bar);
            __builtin_amdgcn_fence(__ATOMIC_ACQUIRE, "agent");
            asm volatile("s_waitcnt vmcnt(0)" ::: "memory");
        }
    }
    __syncthreads();
}

struct Frame {
    LAS unsigned char* lds;
    volatile LAS unsigned* MISC;
    gu32* ctl;
    int wave;
    int vcu, G;
};
__device__ __forceinline__ int lane_id_v() { int l; asm volatile("v_mbcnt_lo_u32_b32 %0, -1, 0\n\tv_mbcnt_hi_u32_b32 %0, -1, %0" : "=v"(l)); return l; }
__device__ __forceinline__ float wave_sum(float v) {
#pragma unroll
    for (int o = 1; o < 64; o <<= 1) v += __shfl_xor(v, o);
    return v;
}
__device__ __forceinline__ float bf2f(unsigned short h) { return __builtin_bit_cast(float, (unsigned)h << 16); }
constexpr int P0_SCR = 64 * 65 * 4;
__device__ __forceinline__ void p0_transpose_item(const float* W, int K, int N, bf16* WT, LAS float* scr, int item, int lane, const float* kg = nullptr) {
    const int nblk = N / 64, kb = item / nblk, nb = item % nblk, k0 = 64 * kb, n0 = 64 * nb;
    const int kr = lane >> 4, c4 = lane & 15;
    f32x4 v[16];
#pragma unroll
    for (int i = 0; i < 16; ++i) v[i] = *(const GAS f32x4*)(W + (size_t)(k0 + 4 * i + kr) * N + n0 + 4 * c4);
#pragma unroll
    for (int i = 0; i < 16; ++i) { LAS float* s = scr + (4 * i + kr) * 65 + 4 * c4; s[0] = v[i].x; s[1] = v[i].y; s[2] = v[i].z; s[3] = v[i].w; }
    LDS_WAIT(); asm volatile("" ::: "memory");
    const int c = lane & 7;
    f32x4 g0 = {1.f, 1.f, 1.f, 1.f}, g1 = g0; if (kg) { g0 = *(const GAS f32x4*)(kg + k0 + 8 * c); g1 = *(const GAS f32x4*)(kg + k0 + 8 * c + 4); }
#pragma unroll
    for (int j = 0; j < 8; ++j) { const int n = (lane >> 3) + 8 * j; const LAS float* s = scr + (8 * c) * 65 + n;
        v4u o; o.x = pk2(s[0 * 65] * g0.x, s[1 * 65] * g0.y); o.y = pk2(s[2 * 65] * g0.z, s[3 * 65] * g0.w); o.z = pk2(s[4 * 65] * g1.x, s[5 * 65] * g1.y); o.w = pk2(s[6 * 65] * g1.z, s[7 * 65] * g1.w);
        *(GAS v4u*)(WT + (size_t)(n0 + n) * K + k0 + 8 * c) = o; }
    LDS_WAIT(); asm volatile("" ::: "memory");
}
__device__ __forceinline__ void rms_row_to_bf16(int lane, const float* xrow, const float* g, bf16* orow) {
    const GAS f32x4* xr = (const GAS f32x4*)xrow + lane; const GAS f32x4* gr = (const GAS f32x4*)g + lane;
    f32x4 v[16]; float s = 0.f;
#pragma unroll
    for (int j = 0; j < 16; ++j) { v[j] = xr[64 * j]; s += (v[j].x * v[j].x + v[j].y * v[j].y) + (v[j].z * v[j].z + v[j].w * v[j].w); }
    const float rstd = 1.f / sqrtf(wave_sum(s) * (1.f / DM) + EPS);
    GAS unsigned long long* o8 = (GAS unsigned long long*)orow + lane;
#pragma unroll
    for (int j = 0; j < 16; ++j) { const f32x4 gg = gr[64 * j];
        o8[64 * j] = (unsigned long long)pk2(v[j].x * rstd * gg.x, v[j].y * rstd * gg.y) | ((unsigned long long)pk2(v[j].z * rstd * gg.z, v[j].w * rstd * gg.w) << 32); }
}
__device__ __forceinline__ void final_row(int lane, const bf16* hrow, float* orow, const float* g, float ssq) {
    const GAS v4u* hr = (const GAS v4u*)hrow + lane; const GAS f32x4* gr = (const GAS f32x4*)g + 2 * lane; GAS f32x4* xr = (GAS f32x4*)orow + 2 * lane;
    const float rstd = 1.f / sqrtf(ssq * (1.f / DM) + EPS);
    v4u w[8];
#pragma unroll
    for (int j = 0; j < 8; ++j) w[j] = hr[64 * j];
#pragma unroll
    for (int j = 0; j < 8; ++j) { const f32x4 g0 = gr[128 * j], g1 = gr[128 * j + 1];
        xr[128 * j] = (f32x4){pg8::bf_lo(w[j].x) * rstd * g0.x, pg8::bf_hi(w[j].x) * rstd * g0.y, pg8::bf_lo(w[j].y) * rstd * g0.z, pg8::bf_hi(w[j].y) * rstd * g0.w};
        xr[128 * j + 1] = (f32x4){pg8::bf_lo(w[j].z) * rstd * g1.x, pg8::bf_hi(w[j].z) * rstd * g1.y, pg8::bf_lo(w[j].w) * rstd * g1.z, pg8::bf_hi(w[j].w) * rstd * g1.w}; }
}

typedef float f32x16 __attribute__((ext_vector_type(16)));
typedef short s16x4 __attribute__((ext_vector_type(4)));
typedef short v4i16_t __attribute__((ext_vector_type(4)));
typedef float f32x2_t __attribute__((ext_vector_type(2))); typedef __bf16 bf16x2_t __attribute__((ext_vector_type(2)));
__device__ __forceinline__ unsigned cvtpk_s(float lo, float hi) { f32x2_t v = {lo, hi}; bf16x2_t b = __builtin_convertvector(v, bf16x2_t); return __builtin_bit_cast(unsigned, b); }
__device__ __forceinline__ s16x4 vtr(LAS const unsigned char* p) { return __builtin_bit_cast(s16x4, __builtin_amdgcn_ds_read_tr16_b64_v4i16((LAS v4i16_t*)p)); }
__device__ __forceinline__ int crow(int r, int hi) { return (r & 3) + 8 * (r >> 2) + 4 * hi; }
#define MFMA32(a, b, c) __builtin_amdgcn_mfma_f32_32x32x16_bf16((a), (b), (c), 0, 0, 0)
__device__ __forceinline__ float half_swap_sum(float v) { auto rr = __builtin_amdgcn_permlane32_swap(__float_as_uint(v), __float_as_uint(v), false, false); return __uint_as_float(rr[0]) + __uint_as_float(rr[1]); }
constexpr int KST = 272, VST = 320;

__device__ __forceinline__ void head_norm_store(f32x16 (&o)[4], int lane, LAS unsigned char* wl, const float* gain, bf16* ydst) {
    const int tl = lane & 31, hh = lane >> 5, r4 = lane >> 4, c16 = lane & 15;
    float ss = 0.f;
#pragma unroll
    for (int dt = 0; dt < 4; ++dt)
#pragma unroll
        for (int r = 0; r < 16; ++r) ss += o[dt][r] * o[dt][r];
    ss = half_swap_sum(ss);
    const float rstd = 1.0f / sqrtf(ss * (1.0f / 128.0f) + EPS);
#pragma unroll
    for (int dt = 0; dt < 4; ++dt)
#pragma unroll
        for (int G = 0; G < 4; ++G) { const int d0 = 32 * dt + 8 * G + 4 * hh; const f32x4 g4 = *(const GAS f32x4*)(gain + d0);
            const unsigned w0 = cvtpk_s(o[dt][4 * G] * rstd * g4.x, o[dt][4 * G + 1] * rstd * g4.y), w1 = cvtpk_s(o[dt][4 * G + 2] * rstd * g4.z, o[dt][4 * G + 3] * rstd * g4.w);
            *(LAS unsigned long long*)(wl + tl * KST + 2 * d0) = (unsigned long long)w0 | ((unsigned long long)w1 << 32); }
#pragma unroll
    for (int i = 0; i < 8; ++i) { const int row = 4 * i + r4; const v4u w = *(LAS const v4u*)(wl + row * KST + 16 * c16);
        *(GAS v4u*)(ydst + (size_t)row * DM + 8 * c16) = w; }
}

constexpr int ATT_WREG = 2 * 32 * KST;
__device__ __forceinline__ void attn_unit(int unit, int lane, LAS unsigned char* wl, const bf16* Z, const float* gb, bf16* Y) {
    const int qb = unit & 127, h = (unit >> 7) & 15, b = unit >> 11;
    const int t0 = qb * 32, tl = lane & 31, hh = lane >> 5, r4 = lane >> 4, c16 = lane & 15;
    const size_t rowb = (size_t)b * SEQ;
    LAS unsigned char* wq = wl; LAS unsigned char* wk = wl + 32 * KST;
    const bf16* Kp = Z + (rowb + r4) * DIN + 3 * AW + h * HD + 8 * c16;
    const unsigned kw = r4 * KST + c16 * 16, kr = tl * KST + hh * 16, vw = r4 * 256 + ((c16 * 16) ^ (r4 << 6));
    v4u kreg[8], vreg[8];
#pragma unroll
    for (int i = 0; i < 8; ++i) { const v4u qv = *(const GAS v4u*)(Kp + (size_t)(t0 + 4 * i) * DIN - AW); kreg[i] = *(const GAS v4u*)(Kp + (size_t)(t0 + 4 * i) * DIN); vreg[i] = *(const GAS v4u*)(Kp + (size_t)(t0 + 4 * i) * DIN + AW);
        *(LAS v4u*)(wq + kw + i * 4 * KST) = qv; }
    f32x16 o[4];
#pragma unroll
    for (int dt = 0; dt < 4; ++dt)
#pragma unroll
        for (int r = 0; r < 16; ++r) o[dt][r] = 0.f;
    float L2 = 0.f;
    const int q4 = (lane & 15) >> 2, p4 = lane & 3, blk = (lane >> 4) & 1;
    for (int j = 0; ; ++j) {
        const int s0 = t0 - 32 * j;
#pragma unroll
        for (int i = 0; i < 8; ++i) *(LAS v4u*)(wk + kw + i * 4 * KST) = kreg[i];
        f32x16 st;
#pragma unroll
        for (int r = 0; r < 16; ++r) st[r] = 0.f;
        { bf16x8 kf[8], qf[8];
#pragma unroll
          for (int ks = 0; ks < 8; ++ks) { kf[ks] = *(LAS const bf16x8*)(wk + kr + 32 * ks); qf[ks] = *(LAS const bf16x8*)(wq + kr + 32 * ks); }
          asm volatile("s_waitcnt lgkmcnt(0)" ::: "memory"); __builtin_amdgcn_sched_barrier(0);
#pragma unroll
          for (int ks = 0; ks < 8; ++ks) st = MFMA32(kf[ks], qf[ks], st); }
#pragma unroll
        for (int i = 0; i < 8; ++i) *(LAS v4u*)(wk + vw + i * 4 * 256) = vreg[i];
        if (s0 >= 32) {
#pragma unroll
            for (int i = 0; i < 8; ++i) { kreg[i] = *(const GAS v4u*)(Kp + (size_t)(s0 - 32 + 4 * i) * DIN); vreg[i] = *(const GAS v4u*)(Kp + (size_t)(s0 - 32 + 4 * i) * DIN + AW); } }
        const bool diag = (j == 0);
        float lk[16];
#pragma unroll
        for (int r = 0; r < 16; ++r) { const float z = st[r];
            const float sp = fmaxf(z, 0.f) + __builtin_amdgcn_logf(1.0f + __builtin_amdgcn_exp2f(-fabsf(z)));
            const bool valid = !diag || (crow(r, hh) < tl);
            lk[r] = valid ? -sp : 0.f; }
        float gs[4], T[4];
#pragma unroll
        for (int G = 0; G < 4; ++G) { gs[G] = (lk[4 * G] + lk[4 * G + 1]) + (lk[4 * G + 2] + lk[4 * G + 3]); T[G] = half_swap_sum(gs[G]); }
        const float SG2 = T[3], SG1 = SG2 + T[2], SG0 = SG1 + T[1];
        const float SG[4] = {SG0, SG1, SG2, 0.f};
        unsigned pw[8];
#pragma unroll
        for (int G = 0; G < 4; ++G) {
            float run = L2 + SG[G] + (hh == 0 ? (T[G] - gs[G]) : 0.f); float a[4];
#pragma unroll
            for (int i = 3; i >= 0; --i) { const int r = 4 * G + i; const float e = __builtin_amdgcn_exp2f(st[r] + lk[r] + run);
                const bool valid = !diag || (crow(r, hh) < tl); a[i] = valid ? e : 0.f; run += lk[r]; }
            pw[2 * G] = cvtpk_s(a[0], a[1]); pw[2 * G + 1] = cvtpk_s(a[2], a[3]); }
        L2 += SG0 + T[0];
#pragma unroll
        for (int s2 = 0; s2 < 2; ++s2) { const v4u pv4 = {pw[4 * s2], pw[4 * s2 + 1], pw[4 * s2 + 2], pw[4 * s2 + 3]}; const bf16x8 pb = __builtin_bit_cast(bf16x8, pv4);
            const int R = 16 * s2 + 4 * hh + q4;
#pragma unroll
            for (int dt = 0; dt < 4; ++dt) { const unsigned xo = (unsigned)(64 * (dt ^ q4) + 32 * blk + 8 * p4);
                const s16x4 lo = vtr(wk + R * 256 + xo), hi = vtr(wk + (R + 8) * 256 + xo);
                const bf16x8 va = __builtin_shufflevector(lo, hi, 0, 1, 2, 3, 4, 5, 6, 7);
                o[dt] = MFMA32(va, pb, o[dt]); } }
        if (s0 < 32 || __all(L2 < -150.5f)) break;
    }
    head_norm_store(o, lane, wk, gb + h * HD, Y + (rowb + t0) * DM + AW + h * HD);
}

struct SguIdx { int h, nc, b; size_t row0; };
__device__ __forceinline__ SguIdx sgu_idx(int unit) { SguIdx s; s.h = unit % NH; s.nc = (unit / NH) % (SEQ / CH); s.b = unit / (NH * (SEQ / CH)); s.row0 = (size_t)s.b * SEQ + s.nc * CH; return s; }
__device__ __forceinline__ void sgu_phase(int G, int wave, int lane, LAS unsigned char* lds, const bf16* Z, const bf16* WSB, const float* bs, const float* ga, bf16* Y) {
    constexpr int NSGU = NB * (SEQ / CH) * NH;
    const int hw = wave >> 2, wq = wave & 3;
    LAS unsigned char* vn = lds + hw * 32768; LAS unsigned char* wl = lds + 65536 + wave * (32 * KST);
    const int tl = lane & 31, hh = lane >> 5, r4 = lane >> 4, c16 = lane & 15;
    const int q4 = (lane & 15) >> 2, p4 = lane & 3, blk = (lane >> 4) & 1;
    const int stride = 2 * G, first = 2 * (int)blockIdx.x + hw;
    v4u vreg[8];
    if (first < NSGU) { const SguIdx s = sgu_idx(first);
#pragma unroll
        for (int i = 0; i < 8; ++i) vreg[i] = *(const GAS v4u*)(Z + (s.row0 + 32 * wq + 4 * i + r4) * DIN + AW + s.h * HD + 8 * c16); }
    for (int unit = first; unit - hw - 2 * (int)blockIdx.x < NSGU; unit += stride) {
        const bool active = unit < NSGU; const SguIdx S = sgu_idx(active ? unit : 0);
        if (active) {
#pragma unroll
            for (int i = 0; i < 8; ++i) { const int s = 32 * wq + 4 * i + r4; const v4u w = vreg[i];
                float v[8] = {pg8::bf_lo(w.x), pg8::bf_hi(w.x), pg8::bf_lo(w.y), pg8::bf_hi(w.y), pg8::bf_lo(w.z), pg8::bf_hi(w.z), pg8::bf_lo(w.w), pg8::bf_hi(w.w)};
                float s1 = ((v[0] + v[1]) + (v[2] + v[3])) + ((v[4] + v[5]) + (v[6] + v[7]));
#pragma unroll
                for (int o = 1; o < 16; o <<= 1) s1 += __shfl_xor(s1, o);
                const float mu = s1 * (1.0f / 128.0f); float s2 = 0.f;
#pragma unroll
                for (int e = 0; e < 8; ++e) { v[e] -= mu; s2 += v[e] * v[e]; }
#pragma unroll
                for (int o = 1; o < 16; o <<= 1) s2 += __shfl_xor(s2, o);
                const float rs = 1.0f / sqrtf(s2 * (1.0f / 128.0f) + EPS);
                v4u ow; ow.x = cvtpk_s(v[0] * rs, v[1] * rs); ow.y = cvtpk_s(v[2] * rs, v[3] * rs); ow.z = cvtpk_s(v[4] * rs, v[5] * rs); ow.w = cvtpk_s(v[6] * rs, v[7] * rs);
                *(LAS v4u*)(vn + s * 256 + ((16 * c16) ^ ((s & 3) << 6))) = ow; }
        }
        LDS_WAIT(); __syncthreads();
        v4u ureg[8];
        if (active) {
#pragma unroll
            for (int i = 0; i < 8; ++i) ureg[i] = *(const GAS v4u*)(Z + (S.row0 + 32 * wq + 4 * i + r4) * DIN + S.h * HD + 8 * c16);
            if (unit + stride < NSGU) { const SguIdx n = sgu_idx(unit + stride);
#pragma unroll
                for (int i = 0; i < 8; ++i) vreg[i] = *(const GAS v4u*)(Z + (n.row0 + 32 * wq + 4 * i + r4) * DIN + AW + n.h * HD + 8 * c16); }
            f32x16 o[4];
#pragma unroll
            for (int dt = 0; dt < 4; ++dt)
#pragma unroll
                for (int r = 0; r < 16; ++r) o[dt][r] = 0.f;
            const bf16* Wrow = WSB + ((size_t)S.h * CH + 32 * wq + tl) * CH + 8 * hh;
            for (int sb = 0; sb <= wq; ++sb) {
#pragma unroll
                for (int s2 = 0; s2 < 2; ++s2) { const bf16x8 wf = *(const GAS bf16x8*)(Wrow + 32 * sb + 16 * s2);
                    const int R = 32 * sb + 16 * s2 + 8 * hh + q4;
#pragma unroll
                    for (int dt = 0; dt < 4; ++dt) { const unsigned xo = (unsigned)(64 * (dt ^ q4) + 32 * blk + 8 * p4);
                        const s16x4 lo = vtr(vn + R * 256 + xo), hi = vtr(vn + (R + 4) * 256 + xo);
                        const bf16x8 va = __builtin_shufflevector(lo, hi, 0, 1, 2, 3, 4, 5, 6, 7);
                        o[dt] = MFMA32(va, wf, o[dt]); } } }
#pragma unroll
            for (int i = 0; i < 8; ++i) { const int t = 4 * i + r4; *(LAS v4u*)(wl + t * KST + 16 * c16) = ureg[i]; }
            const float bias = bs[S.h * CH + 32 * wq + tl];
#pragma unroll
            for (int dt = 0; dt < 4; ++dt)
#pragma unroll
                for (int G4 = 0; G4 < 4; ++G4) { const int d0 = 32 * dt + 8 * G4 + 4 * hh; const unsigned long long uw = *(LAS const unsigned long long*)(wl + tl * KST + 2 * d0);
                    const unsigned u0 = (unsigned)uw, u1 = (unsigned)(uw >> 32);
                    o[dt][4 * G4] = pg8::bf_lo(u0) * (o[dt][4 * G4] + bias); o[dt][4 * G4 + 1] = pg8::bf_hi(u0) * (o[dt][4 * G4 + 1] + bias);
                    o[dt][4 * G4 + 2] = pg8::bf_lo(u1) * (o[dt][4 * G4 + 2] + bias); o[dt][4 * G4 + 3] = pg8::bf_hi(u1) * (o[dt][4 * G4 + 3] + bias); }
            head_norm_store(o, lane, wl, ga + S.h * HD, Y + (S.row0 + 32 * wq) * DM + S.h * HD);
        }
        LDS_WAIT(); __syncthreads();
    }
}

#if defined(MK_EXP)
constexpr int N_PHASES = 11;
#else
constexpr int N_PHASES = 10;
#endif
struct Args { const float* in[16]; float* out; unsigned char* ws; int ph_lo, ph_hi, li, pad; };
__global__ void __launch_bounds__(NWAVES * 64, 2) mk_fwd(Args args) {
    extern __shared__ __attribute__((aligned(16))) unsigned char lds[];
    Frame F;
    F.lds = (LAS unsigned char*)lds;
    F.MISC = (volatile LAS unsigned*)(F.lds + MISC_OFF);
    F.wave = __builtin_amdgcn_readfirstlane((int)threadIdx.x >> 6);
    F.G = gridDim.x; { const int bx = blockIdx.x; F.vcu = (F.G % 8 == 0) ? (bx % 8) * (F.G / 8) + bx / 8 : bx; }
    unsigned char* ws = args.ws;
    F.ctl = (gu32*)(ws + WS_CTL);
    const float* x = args.in[0]; const float* p = args.in[1]; const float* norm_mix = args.in[2]; const float* w_in = args.in[3];
    const float* w_s = args.in[4]; const float* b_s = args.in[5]; const float* norm_a = args.in[6]; const float* norm_b = args.in[7];
    const float* w_out = args.in[8]; const float* norm_ffn = args.in[9]; const float* w_up = args.in[10]; const float* w_down = args.in[11];
    const float* norm_ple = args.in[12]; const float* w_gate = args.in[13]; const float* w_proj = args.in[14]; const float* norm_final = args.in[15];
    float* out = args.out;
    bf16* PBF = (bf16*)(ws + WS_PBF); bf16* WSB = (bf16*)(ws + WS_WSB);
    bf16 *Wi = (bf16*)(ws + WS_WIN), *Wo = (bf16*)(ws + WS_WOUT), *Wu = (bf16*)(ws + WS_WUP), *Wd = (bf16*)(ws + WS_WDN), *Wg = (bf16*)(ws + WS_WGT), *Wp = (bf16*)(ws + WS_WPJ);
    bf16 *ACT = (bf16*)(ws + WS_ACT), *Z = (bf16*)(ws + WS_Z), *HID = (bf16*)(ws + WS_HID), *HG = (bf16*)(ws + WS_HG);
    float* ssq1 = (float*)(ws + WS_CTL) + CW_SSQ1; float* ssq2 = (float*)(ws + WS_CTL) + CW_SSQ2; float* ssq3 = (float*)(ws + WS_CTL) + CW_SSQ3;
    for (int u = (int)threadIdx.x; u < (LDS_BYTES - LDSCTL_OFF) / 4; u += NWAVES * 64) ((LAS unsigned*)(F.lds + LDSCTL_OFF))[u] = 0u;
    __syncthreads();
    const int lo = args.ph_lo, hi = args.ph_hi;
    XcdBarrier bar; bar.bar = (unsigned*)(F.ctl + CW_BAR) + args.li * XCD_BAR_WORDS; bar.x = 0; bar.st = nullptr;
    if (hi - lo > 1) bar = xcd_barrier_post((unsigned*)(F.ctl + CW_BAR) + args.li * XCD_BAR_WORDS, F.MISC + 8);
#define IN(k) (lo <= (k) && (k) < hi)
#define GRID_BAR(k) do { if (IN(k) && IN((k) + 1)) xcd_barrier(bar); } while (0)
    const int gw = F.vcu * NWAVES + F.wave, NGW = F.G * NWAVES;
#ifndef MK_REP0
#define MK_REP0 1
#endif
    if (IN(0))
_Pragma("unroll")
    for (int rep0 = 0; rep0 < MK_REP0; ++rep0) {
        const int lane = lane_id_v();
        LAS float* scr = (LAS float*)(F.lds + RING_OFF + F.wave * P0_SCR);
        constexpr int I_IN = (DM / 64) * (DIN / 64), I_OUT = (DM / 64) * (DM / 64), I_UP = (DM / 64) * (DFF / 64), I_DN = (DFF / 64) * (DM / 64), I_GT = I_OUT, I_PJ = (PLE / 64) * (DM / 64);
        constexpr int NITEMS = I_IN + I_OUT + I_UP + I_DN + I_GT + I_PJ;
        for (int it = gw; it < NITEMS; it += NGW) {
            int r = it;
            if (r < I_IN) { p0_transpose_item(w_in, DM, DIN, Wi, scr, r, lane); continue; } r -= I_IN;
            if (r < I_OUT) { p0_transpose_item(w_out, DM, DM, Wo, scr, r, lane); continue; } r -= I_OUT;
            if (r < I_UP) { p0_transpose_item(w_up, DM, DFF, Wu, scr, r, lane, norm_ffn); continue; } r -= I_UP;
            if (r < I_DN) { p0_transpose_item(w_down, DFF, DM, Wd, scr, r, lane); continue; } r -= I_DN;
            if (r < I_GT) { p0_transpose_item(w_gate, DM, DM, Wg, scr, r, lane, norm_ple); continue; } r -= I_GT;
            p0_transpose_item(w_proj, PLE, DM, Wp, scr, r, lane);
        }
        for (int i = gw; i < M * PLE / 256; i += NGW) {
            const f32x4 v = ((const GAS f32x4*)p)[(size_t)i * 64 + lane];
            ((GAS unsigned long long*)PBF)[(size_t)i * 64 + lane] = (unsigned long long)pk2(v.x, v.y) | ((unsigned long long)pk2(v.z, v.w) << 32); }
        for (int i = gw; i < NH * CH * CH / 256; i += NGW) {
            const f32x4 v = ((const GAS f32x4*)w_s)[(size_t)i * 64 + lane]; const int e0 = i * 256 + lane * 4, s = e0 & 127, t = (e0 >> 7) & 127;
            ((GAS unsigned long long*)WSB)[(size_t)i * 64 + lane] = (unsigned long long)pk2(s <= t ? v.x : 0.f, s + 1 <= t ? v.y : 0.f) | ((unsigned long long)pk2(s + 2 <= t ? v.z : 0.f, s + 3 <= t ? v.w : 0.f) << 32); }
        for (int m = gw; m < M; m += NGW) rms_row_to_bf16(lane, x + (size_t)m * DM, norm_mix, ACT + (size_t)m * DM);
    }
    GRID_BAR(0);
    if (IN(1)) {
        pg8::Gemm g{ACT, Wi, M, DIN, DM}; pg8::StaticOrder S; S.init(M, DIN, F.G, (int)blockIdx.x);
        pg8::EpiInProj E{Z, DIN, (2 * AW) / 256, (3 * AW) / 256, QSCALE * 1.4426950408889634f};
        pg8::gemm_phase<pg8::EpiInProj, pg8::StaticOrder, true, true>(F.lds + RING_OFF, g, S, E);
    }
    GRID_BAR(1);
    if (IN(2)) {
        sgu_phase(F.G, F.wave, lane_id_v(), F.lds, Z, WSB, b_s, norm_a, ACT);
    }
    if (IN(3)) {
        const int lane = lane_id_v();
        LAS unsigned char* wl2 = F.lds + F.wave * ATT_WREG;
        constexpr int NATT = NB * NH * (SEQ / 32);
        for (int i = 0; ; ++i) { const int unit = (i * F.G + (int)blockIdx.x) * NWAVES + F.wave; if (unit >= NATT) break;
            attn_unit(unit, lane, wl2, Z, norm_b, ACT); }
    }
    GRID_BAR(3);
    if (IN(4)) {
        pg8::Gemm g{ACT, Wo, M, DM, DM}; pg8::StaticOrder S; S.init(M, DM, F.G, (int)blockIdx.x);
        pg8::EpiRes1 E{x, HG, ssq1, DM};
        pg8::gemm_phase<pg8::EpiRes1, pg8::StaticOrder, true, true>(F.lds + RING_OFF, g, S, E);
    }
    GRID_BAR(4);
    if (IN(5)) {
        pg8::Gemm g{HG, Wu, M, DFF, DM}; pg8::StaticOrder S; S.init(M, DFF, F.G, (int)blockIdx.x);
        pg8::EpiUp E{HID, DFF, ssq1, 1.0f / DM, EPS};
        pg8::gemm_phase<pg8::EpiUp, pg8::StaticOrder, true, true>(F.lds + RING_OFF, g, S, E);
    }
    GRID_BAR(5);
    if (IN(6)) {
        pg8::Gemm g{HID, Wd, M, DM, DFF}; pg8::StaticOrder S; S.init(M, DM, F.G, (int)blockIdx.x);
        pg8::EpiRes2 E{HG, ssq2, DM};
        pg8::gemm_phase<pg8::EpiRes2, pg8::StaticOrder, true, true>(F.lds + RING_OFF, g, S, E);
    }
    GRID_BAR(6);
    if (IN(7)) {
        pg8::Gemm g{PBF, Wp, M, DM, PLE}; pg8::StaticOrder S; S.init(M, DM, F.G, (int)blockIdx.x);
        pg8::EpiPlainBf16 E{ACT, DM};
        pg8::gemm_phase<pg8::EpiPlainBf16, pg8::StaticOrder, true, true>(F.lds + RING_OFF, g, S, E);
        VM_WAIT(); __syncthreads();
    }

    if (IN(8)) {
        pg8::Gemm g{HG, Wg, M, DM, DM}; pg8::StaticOrder S; S.init(M, DM, F.G, (int)blockIdx.x);
        pg8::EpiGate E{Z, HG, ACT, ssq2, ssq3, DM, 1.0f / DM, EPS};
        pg8::gemm_phase<pg8::EpiGate, pg8::StaticOrder, true, true>(F.lds + RING_OFF, g, S, E);
    }
    GRID_BAR(8);
    if (IN(9)) {
        const int lane = lane_id_v();
        for (int m = gw; m < M; m += NGW) final_row(lane, Z + (size_t)m * DM, out + (size_t)m * DM, norm_final, ssq3[m]);
    }
#if defined(MK_EXP)
    if (IN(10)) {
        pg8::Gemm g{HG, Wu, M, DFF, DM}; pg8::StaticOrder S; S.init(M, DFF, F.G, (int)blockIdx.x);
        pg8::EpiUp E{HID, DFF, ssq1, 1.0f / DM, EPS};
#if MK_EXP == 2
        struct SameUnit { int c; __device__ bool next(int i, pg8::Unit& u) const { if (i >= 16) return false; u.pm = c & 7; u.pn = (c >> 3) & 1; return true; }
            __device__ __forceinline__ void a_ready(const pg8::Unit&) const {} __device__ __forceinline__ void done(const pg8::Unit&) const {} } SU{(int)blockIdx.x};
        pg8::gemm_phase<pg8::EpiUp, SameUnit, true, true, false>(F.lds + RING_OFF, g, SU, E);
#else
        pg8::gemm_phase<pg8::EpiUp, pg8::StaticOrder, true, true, (MK_EXP == 1), (MK_EXP >= 10 && MK_EXP < 20 ? MK_EXP - 10 : 0), (MK_EXP >= 20 ? MK_EXP - 20 : 0)>(F.lds + RING_OFF, g, S, E);
#endif
    }
#endif
#undef IN
#undef GRID_BAR
}

extern "C" void kernel_launch(void* const* d_in, const int* in_sizes, int n_in, void* d_out, int out_size, void* d_ws, size_t ws_size, hipStream_t stream) {
    static int grid = 0;
    if (grid == 0) {
        if (n_in != 16 || in_sizes[0] != M * DM || out_size != M * DM || ws_size < WS_END) { fprintf(stderr, "kernel_launch: unexpected shapes: n_in %d, in0 %d, out %d, ws %zu (need %zu); nothing launched\n", n_in, n_in > 0 ? in_sizes[0] : -1, out_size, ws_size, (size_t)WS_END); grid = -1; return; }
        int dev = 0, cus = 0, per_cu = 0;
        if (hipGetDevice(&dev) != hipSuccess || hipDeviceGetAttribute(&cus, hipDeviceAttributeMultiprocessorCount, dev) != hipSuccess) { fprintf(stderr, "kernel_launch: device query failed\n"); grid = -1; return; }
        if (hipFuncSetAttribute((const void*)mk_fwd, hipFuncAttributeMaxDynamicSharedMemorySize, LDS_BYTES) != hipSuccess) { fprintf(stderr, "kernel_launch: hipFuncSetAttribute failed\n"); grid = -1; return; }
        if (hipOccupancyMaxActiveBlocksPerMultiprocessor(&per_cu, (const void*)mk_fwd, NWAVES * 64, LDS_BYTES) != hipSuccess || per_cu < 1) { fprintf(stderr, "kernel_launch: occupancy query reports %d workgroups per CU\n", per_cu); }
        (void)hipGetLastError();
        grid = cus;
    }
    if (grid < 0) return;
    if (hipMemsetAsync((char*)d_ws + WS_CTL, 0, CTL_ZERO_BYTES, stream) != hipSuccess) { fprintf(stderr, "kernel_launch: hipMemsetAsync failed\n"); return; }
    Args a{};
    for (int i = 0; i < 16; ++i) a.in[i] = (const float*)d_in[i];
    a.out = (float*)d_out; a.ws = (unsigned char*)d_ws;
#if defined(MK_PLAN)
    { const int plan[] = MK_PLAN; int li = 0;
      for (unsigned i = 0; i + 1 < sizeof(plan) / sizeof(plan[0]); i += 2) { a.ph_lo = plan[i]; a.ph_hi = plan[i + 1]; a.li = li; if (plan[i + 1] - plan[i] > 1) ++li;
          hipLaunchKernelGGL(mk_fwd, dim3(grid), dim3(NWAVES * 64), LDS_BYTES, stream, a); } }
#else
    a.ph_lo = 0; a.ph_hi = N_PHASES; a.li = 0;
    hipLaunchKernelGGL(mk_fwd, dim3(grid), dim3(NWAVES * 64), LDS_BYTES, stream, a);
#endif
    const hipError_t le = hipPeekAtLastError();
    if (le != hipSuccess) fprintf(stderr, "kernel_launch: launch failed: %s\n", hipGetErrorName(le));
}
```

```cpp
#include <hip/hip_runtime.h>
#include <cstdio>
#include <cstdint>
namespace pg8 {
#define PG8_LAS __attribute__((address_space(3)))
typedef unsigned short bf16_t;
typedef short bf16x8 __attribute__((ext_vector_type(8)));
typedef float f32x4 __attribute__((ext_vector_type(4)));
typedef unsigned u32x4 __attribute__((ext_vector_type(4)));
constexpr int BM = 256, BK = 64, HALF = 128, HTB = HALF * BK * 2  , STAGE_BYTES = 8 * HTB, NXCD = 8, WGM = 8;

__host__ __device__ __forceinline__ int lds_byte(int r, int c) { const int st = (r >> 4) * 2 + (c >> 5), rr = r & 15, cc = c & 31, ob = rr * 64 + cc * 2; return st * 1024 + (ob ^ (((ob >> 9) & 1) << 5)); }
__host__ __device__ __forceinline__ void stage_rc(int b, int& R, int& C) { const int st = b / 1024, sb = b % 1024, swz = sb ^ (((sb >> 9) & 1) << 5); R = (st >> 1) * 16 + swz / 64; C = (st & 1) * 32 + (swz % 64) / 2; }
__host__ __device__ __forceinline__ int perm32(int rho) { const int n = rho >> 4, i = rho & 15; return 8 * (i >> 2) + 4 * n + (i & 3); }

struct Unit { int pm, pn; };
struct Gemm { const bf16_t* A; const bf16_t* Bt; int M, N, K; };

struct StaticOrder {
    int nM, nN, nwg, G, c;
    __host__ __device__ void init(int M, int N, int G_, int c_) { nM = M / BM; nN = N / BM; nwg = nM * nN; G = G_; c = c_; }
    __host__ __device__ bool next(int i, Unit& u) const {
        const long L = (long)i * G + c; if (L >= nwg) return false;
        int wgid = (int)L; { const int q = nwg / NXCD, r = nwg % NXCD, xcd = wgid % NXCD, off = wgid / NXCD; wgid = (xcd < r ? xcd * (q + 1) : r * (q + 1) + (xcd - r) * q) + off; }
        const int nig = WGM * nN, gid = wgid / nig, fm = gid * WGM, gsz = (nM - fm) < WGM ? (nM - fm) : WGM;
        u.pm = fm + ((wgid % nig) % gsz); u.pn = (wgid % nig) / gsz; return true;
    }
    __device__ __forceinline__ void a_ready(const Unit&) const {}
    __device__ __forceinline__ void done(const Unit&) const {}
};

__device__ __forceinline__ unsigned cvt_pk_bf16(float lo, float hi) { unsigned r; asm volatile("v_cvt_pk_bf16_f32 %0, %1, %2" : "=v"(r) : "v"(lo), "v"(hi)); return r; }
typedef float f32x2 __attribute__((ext_vector_type(2)));
typedef unsigned u32x2 __attribute__((ext_vector_type(2)));
__device__ __forceinline__ int lane_id_v() { int l; asm volatile("v_mbcnt_lo_u32_b32 %0, -1, 0\n\tv_mbcnt_hi_u32_b32 %0, -1, %0" : "=v"(l)); return l; }
__device__ __forceinline__ float fq_sum(float v, int lid) {
    v += __builtin_bit_cast(float, __builtin_amdgcn_ds_bpermute((lid ^ 16) << 2, __builtin_bit_cast(int, v)));
    v += __builtin_bit_cast(float, __builtin_amdgcn_ds_bpermute((lid ^ 32) << 2, __builtin_bit_cast(int, v)));
    return v; }
__device__ __forceinline__ int lane_id_after(float dep) { int l; asm volatile("v_mbcnt_lo_u32_b32 %0, -1, 0\n\tv_mbcnt_hi_u32_b32 %0, -1, %0 ; after %1" : "=&v"(l) : "v"(dep)); return l; }
__device__ __forceinline__ float bf_lo(unsigned w) { return __builtin_bit_cast(float, w << 16); }
__device__ __forceinline__ float bf_hi(unsigned w) { return __builtin_bit_cast(float, w & 0xffff0000u); }
__device__ __forceinline__ float gelu_tanh_f(float x) {
    const float x2 = x * x, t = x * (-2.302208198f + (-0.1029432397f) * x2);
    return x * __builtin_amdgcn_rcpf(1.0f + __builtin_amdgcn_exp2f(t));
}
__device__ __forceinline__ u32x4 pack8(const f32x4 v0, const f32x4 v1) { u32x4 w; w.x = cvt_pk_bf16(v0[0], v0[1]); w.y = cvt_pk_bf16(v0[2], v0[3]); w.z = cvt_pk_bf16(v1[0], v1[1]); w.w = cvt_pk_bf16(v1[2], v1[3]); return w; }
struct EpiInProj {
    static constexpr bool PERM = true, AFTER_DRAIN = false;
    bf16_t* O; int ldc; int gelu_tiles, q_tiles; float qscale;
    __device__ __forceinline__ void operator()(const f32x4 (&acc)[2][2][4][2], const Unit& u, int wr, int wc, int, int) const {
        const int lid_ = lane_id_after(acc[1][1][3][1][3]), fr = lid_ & 15, fq = lid_ >> 4;
        const int row0 = u.pm * BM + wr * 64 + fr, col0 = u.pn * BM + wc * 32 + 8 * fq;
        const int mode = u.pn < gelu_tiles ? 1 : (u.pn < q_tiles ? 2 : 0);
#pragma unroll
        for (int ai = 0; ai < 2; ++ai)
#pragma unroll
            for (int m = 0; m < 4; ++m) { bf16_t* rowp = O + (size_t)(row0 + ai * HALF + m * 16) * ldc + col0;
#pragma unroll
                for (int bj = 0; bj < 2; ++bj) { f32x4 v0 = acc[ai][bj][m][0], v1 = acc[ai][bj][m][1];
                    if (mode == 1) {
#pragma unroll
                        for (int e = 0; e < 4; ++e) { v0[e] = gelu_tanh_f(v0[e]); v1[e] = gelu_tanh_f(v1[e]); } }
                    else if (mode == 2) { v0 = v0 * qscale; v1 = v1 * qscale; }
                    *(u32x4*)(rowp + bj * HALF) = pack8(v0, v1); } }
    }
};
struct EpiPlainBf16 {
    static constexpr bool PERM = true, AFTER_DRAIN = false;
    bf16_t* O; int ldc;
    __device__ __forceinline__ void operator()(const f32x4 (&acc)[2][2][4][2], const Unit& u, int wr, int wc, int, int) const {
        const int lid_ = lane_id_after(acc[1][1][3][1][3]), fr = lid_ & 15, fq = lid_ >> 4;
        const int row0 = u.pm * BM + wr * 64 + fr, col0 = u.pn * BM + wc * 32 + 8 * fq;
#pragma unroll
        for (int ai = 0; ai < 2; ++ai)
#pragma unroll
            for (int m = 0; m < 4; ++m) { bf16_t* rowp = O + (size_t)(row0 + ai * HALF + m * 16) * ldc + col0;
#pragma unroll
                for (int bj = 0; bj < 2; ++bj) *(u32x4*)(rowp + bj * HALF) = pack8(acc[ai][bj][m][0], acc[ai][bj][m][1]); }
    }
};
#define SQ8(h0, h1) ((h0[0] * h0[0] + h0[1] * h0[1]) + (h0[2] * h0[2] + h0[3] * h0[3]) + (h1[0] * h1[0] + h1[1] * h1[1]) + (h1[2] * h1[2] + h1[3] * h1[3]))
struct EpiRes1 {
    static constexpr bool PERM = true, AFTER_DRAIN = false;
    const float* base; bf16_t* hb; float* ssq; int ldc;
    __device__ __forceinline__ void operator()(const f32x4 (&acc)[2][2][4][2], const Unit& u, int wr, int wc, int, int) const {
        const int lid_ = lane_id_after(acc[1][1][3][1][3]), fr = lid_ & 15, fq = lid_ >> 4;
        const int row0 = u.pm * BM + wr * 64 + fr, col0 = u.pn * BM + wc * 32 + 8 * fq;
#pragma unroll
        for (int ai = 0; ai < 2; ++ai) {
            f32x4 pre[4][2][2];
#pragma unroll
            for (int m = 0; m < 4; ++m) { const size_t off = (size_t)(row0 + ai * HALF + m * 16) * ldc + col0;
#pragma unroll
                for (int bj = 0; bj < 2; ++bj) { pre[m][bj][0] = *(const f32x4*)(base + off + bj * HALF); pre[m][bj][1] = *(const f32x4*)(base + off + bj * HALF + 4); } }
            asm volatile("" ::: "memory");
#pragma unroll
            for (int m = 0; m < 4; ++m) { const int row = row0 + ai * HALF + m * 16; const size_t off = (size_t)row * ldc + col0; float s = 0.f;
#pragma unroll
                for (int bj = 0; bj < 2; ++bj) { const f32x4 h0 = pre[m][bj][0] + acc[ai][bj][m][0], h1 = pre[m][bj][1] + acc[ai][bj][m][1];
                    s += SQ8(h0, h1); *(u32x4*)(hb + off + bj * HALF) = pack8(h0, h1); }
                s = fq_sum(s, lid_);
                if (fq == 0) atomicAdd(ssq + row, s); }
            asm volatile("" ::: "memory"); }
    }
};
struct EpiRes2 {
    static constexpr bool PERM = true, AFTER_DRAIN = false;
    bf16_t* hb; float* ssq; int ldc;
    __device__ __forceinline__ void operator()(const f32x4 (&acc)[2][2][4][2], const Unit& u, int wr, int wc, int, int) const {
        const int lid_ = lane_id_after(acc[1][1][3][1][3]), fr = lid_ & 15, fq = lid_ >> 4;
        const int row0 = u.pm * BM + wr * 64 + fr, col0 = u.pn * BM + wc * 32 + 8 * fq;
        u32x4 pre[2][4][2];
#pragma unroll
        for (int ai = 0; ai < 2; ++ai)
#pragma unroll
            for (int m = 0; m < 4; ++m) { const size_t off = (size_t)(row0 + ai * HALF + m * 16) * ldc + col0;
#pragma unroll
                for (int bj = 0; bj < 2; ++bj) pre[ai][m][bj] = *(const u32x4*)(hb + off + bj * HALF); }
        asm volatile("" ::: "memory");
#pragma unroll
        for (int ai = 0; ai < 2; ++ai)
#pragma unroll
            for (int m = 0; m < 4; ++m) { const int row = row0 + ai * HALF + m * 16; const size_t off = (size_t)row * ldc + col0; float s = 0.f;
#pragma unroll
                for (int bj = 0; bj < 2; ++bj) { const u32x4 bw = pre[ai][m][bj];
                    const f32x4 h0 = (f32x4){bf_lo(bw.x), bf_hi(bw.x), bf_lo(bw.y), bf_hi(bw.y)} + acc[ai][bj][m][0], h1 = (f32x4){bf_lo(bw.z), bf_hi(bw.z), bf_lo(bw.w), bf_hi(bw.w)} + acc[ai][bj][m][1];
                    s += SQ8(h0, h1); *(u32x4*)(hb + off + bj * HALF) = pack8(h0, h1); }
                s = fq_sum(s, lid_);
                if (fq == 0) atomicAdd(ssq + row, s); }
    }
};
struct EpiUp {
    static constexpr bool PERM = true, AFTER_DRAIN = false;
    bf16_t* O; int ldc; const float* ssq; float inv_n, eps;
    __device__ __forceinline__ void operator()(const f32x4 (&acc)[2][2][4][2], const Unit& u, int wr, int wc, int, int) const {
        const int lid_ = lane_id_after(acc[1][1][3][1][3]), fr = lid_ & 15, fq = lid_ >> 4;
        const int row0 = u.pm * BM + wr * 64 + fr, col0 = u.pn * BM + wc * 32 + 8 * fq;
#pragma unroll
        for (int ai = 0; ai < 2; ++ai)
#pragma unroll
            for (int m = 0; m < 4; ++m) { const int row = row0 + ai * HALF + m * 16; bf16_t* rowp = O + (size_t)row * ldc + col0;
                const float r2 = 1.0f / (ssq[row] * inv_n + eps);
#pragma unroll
                for (int bj = 0; bj < 2; ++bj) { f32x4 v0 = acc[ai][bj][m][0], v1 = acc[ai][bj][m][1];
#pragma unroll
                    for (int e = 0; e < 4; ++e) { const float a = fmaxf(v0[e], 0.f), b = fmaxf(v1[e], 0.f); v0[e] = a * a * r2; v1[e] = b * b * r2; }
                    *(u32x4*)(rowp + bj * HALF) = pack8(v0, v1); } }
    }
};
struct EpiGate {
    static constexpr bool PERM = true, AFTER_DRAIN = false;
    bf16_t* h3b; const bf16_t* hb; const bf16_t* E; const float* ssq_in; float* ssq_out; int ldc; float inv_n, eps; const float* sa; const float* sw;
    __device__ __forceinline__ void operator()(const f32x4 (&acc)[2][2][4][2], const Unit& u, int wr, int wc, int, int) const {
        const int lid_ = lane_id_after(acc[1][1][3][1][3]), fr = lid_ & 15, fq = lid_ >> 4;
        const int row0 = u.pm * BM + wr * 64 + fr, col0 = u.pn * BM + wc * 32 + 8 * fq;
        f32x4 wv[2][2];
#pragma unroll
        for (int bj = 0; bj < 2; ++bj)
#pragma unroll
            for (int n = 0; n < 2; ++n) wv[bj][n] = sw ? *(const f32x4*)(sw + col0 + bj * HALF + 4 * n) : (f32x4){1.f, 1.f, 1.f, 1.f};
#pragma unroll
        for (int ag = 0; ag < 4; ++ag) { const int ai = ag >> 1, mb = (ag & 1) * 2;
            u32x4 preh[2][2], pree[2][2]; float nrs[2], sas[2];
#pragma unroll
            for (int mm = 0; mm < 2; ++mm) { const int row = row0 + ai * HALF + (mb + mm) * 16; const size_t off = (size_t)row * ldc + col0; nrs[mm] = ssq_in[row]; sas[mm] = sa ? sa[row] : 1.f;
#pragma unroll
                for (int bj = 0; bj < 2; ++bj) { preh[mm][bj] = *(const u32x4*)(hb + off + bj * HALF); pree[mm][bj] = *(const u32x4*)(E + off + bj * HALF); } }
            asm volatile("" ::: "memory");
#pragma unroll
            for (int mm = 0; mm < 2; ++mm) { const int m = mb + mm; const int row = row0 + ai * HALF + m * 16; const size_t off = (size_t)row * ldc + col0; float s = 0.f;
                const float nr = -1.4426950408889634f * sas[mm] * __builtin_amdgcn_rsqf(nrs[mm] * inv_n + eps);
#pragma unroll
                for (int bj = 0; bj < 2; ++bj) { const u32x4 ew = pree[mm][bj], bw = preh[mm][bj];
                    f32x4 h0 = (f32x4){bf_lo(bw.x), bf_hi(bw.x), bf_lo(bw.y), bf_hi(bw.y)}, h1 = (f32x4){bf_lo(bw.z), bf_hi(bw.z), bf_lo(bw.w), bf_hi(bw.w)};
                    const f32x4 a0 = acc[ai][bj][m][0] * wv[bj][0], a1 = acc[ai][bj][m][1] * wv[bj][1];
                    const float e0[4] = {bf_lo(ew.x), bf_hi(ew.x), bf_lo(ew.y), bf_hi(ew.y)}, e1[4] = {bf_lo(ew.z), bf_hi(ew.z), bf_lo(ew.w), bf_hi(ew.w)};
#pragma unroll
                    for (int e = 0; e < 4; ++e) {
                        h0[e] += __builtin_amdgcn_rcpf(1.0f + __builtin_amdgcn_exp2f(nr * a0[e])) * e0[e];
                        h1[e] += __builtin_amdgcn_rcpf(1.0f + __builtin_amdgcn_exp2f(nr * a1[e])) * e1[e]; }
                    s += SQ8(h0, h1); *(u32x4*)(h3b + off + bj * HALF) = pack8(h0, h1); }
                s = fq_sum(s, lid_);
                if (fq == 0) atomicAdd(ssq_out + row, s); }
            asm volatile("" ::: "memory"); }
    }
};
template <bool C, class A, class B> struct pg8_sel { typedef A type; };
template <class A, class B> struct pg8_sel<false, A, B> { typedef B type; };
template <class Epi, class Sched, bool ALIGN_EPI = false, bool SP2 = false, bool TILED = false, int DBG = 0  , int GV = 0  , bool I8 = false  >
__device__ __forceinline__ void gemm_phase(PG8_LAS unsigned char* lds, const Gemm g, const Sched& S, const Epi& E) {
    const int tid = threadIdx.x, wid = __builtin_amdgcn_readfirstlane(tid >> 6), lane = tid & 63, wr = wid >> 2, wc = wid & 3, fr = lane & 15, fq = lane >> 4;
    const int K = g.K, nt = K / BK;
    unsigned voffA[2], voffB[2];
#pragma unroll
    for (int i = 0; i < 2; ++i) { int R, C; stage_rc(tid * 16 + i * 8192, R, C); const int Rb = Epi::PERM ? ((R & ~31) + perm32(R & 31)) : R;
        voffA[i] = (unsigned)(R * K + C) * 2u; voffB[i] = (unsigned)(Rb * K + C) * 2u;
        if (TILED) { voffA[i] = voffB[i] = (unsigned)(tid * 16 + i * 8192); } }
    const size_t kstep = TILED ? (size_t)HTB : (size_t)(BK * 2);
    const size_t hstep = (size_t)HALF * K * 2;
    const size_t tstep = 2 * hstep;
    const unsigned ldsw = (unsigned)wid * 1024u;
    const int aoff = lds_byte(wr * 64 + fr, fq * 8), boff = lds_byte(wc * 32 + fr, fq * 8);
#define PG8_SA(b, h) (((b) * 2 + (h)) * HTB)
#define PG8_SB(b, h) ((4 + (b) * 2 + (h)) * HTB)
#define PG8_STAGE(bufoff, gbase, voff) do { if (DBG >= 3) break; _Pragma("unroll") for (int _i = 0; _i < 2; ++_i) \
        __builtin_amdgcn_global_load_lds((const unsigned*)((const char*)(gbase) + (voff)[_i]), (PG8_LAS unsigned*)(lds + (bufoff) + ldsw + _i * 8192), 16, 0, 0); } while (0)
#define PG8_PIECE(bufoff, gbase, voff, _i) do { if (DBG >= 3) break; \
        __builtin_amdgcn_global_load_lds((const unsigned*)((const char*)(gbase) + (voff)[_i]), (PG8_LAS unsigned*)(lds + (bufoff) + ldsw + (_i) * 8192), 16, 0, 0); } while (0)
#define PG8_LDA(dst, b, h) do { if (DBG >= 2) break; _Pragma("unroll") for (int m = 0; m < 4; ++m) _Pragma("unroll") for (int k = 0; k < 2; ++k) dst[m][k] = *(const PG8_LAS bf16x8*)(lds + PG8_SA(b, h) + aoff + m * 2048 + k * 1024); } while (0)
#define PG8_LDB(dst, b, h) do { if (DBG >= 2) break; _Pragma("unroll") for (int n = 0; n < 2; ++n) _Pragma("unroll") for (int k = 0; k < 2; ++k) dst[n][k] = *(const PG8_LAS bf16x8*)(lds + PG8_SB(b, h) + boff + n * 2048 + k * 1024); } while (0)
#define PG8_MMA(ai, bj, At, Bt) do { __builtin_amdgcn_s_setprio(1); _Pragma("unroll") for (int m = 0; m < 4; ++m) _Pragma("unroll") for (int n = 0; n < 2; ++n) _Pragma("unroll") for (int k = 0; k < 2; ++k) { \
        if (DBG == 1 || (DBG == 4 && (bj) == 1)) { asm volatile("" :: "v"(Bt[n][k]), "v"(At[m][k])); } else \
        if constexpr (I8) acc[ai][bj][m][n] = __builtin_bit_cast(acc_t, __builtin_amdgcn_mfma_i32_16x16x64_i8(__builtin_bit_cast(i32x4, Bt[n][k]), __builtin_bit_cast(i32x4, At[m][k]), __builtin_bit_cast(i32x4, acc[ai][bj][m][n]), 0, 0, 0)); else \
        acc[ai][bj][m][n] = __builtin_bit_cast(acc_t, __builtin_amdgcn_mfma_f32_16x16x32_bf16(Bt[n][k], At[m][k], __builtin_bit_cast(f32x4, acc[ai][bj][m][n]), 0, 0, 0)); } __builtin_amdgcn_s_setprio(0); } while (0)
#define PG8_WAIT_V(n) asm volatile("s_waitcnt vmcnt(" #n ")" ::: "memory")
#define PG8_WAIT_L(n) asm volatile("s_waitcnt lgkmcnt(" #n ")" ::: "memory")
#define PG8_BAR do { if (DBG != 5) __builtin_amdgcn_s_barrier(); } while (0)
#define PG8_SCHED __builtin_amdgcn_sched_barrier(0)
    Unit cur, nxt; int ui = 0;
    if (!S.next(0, cur)) return;
    typedef int i32x4 __attribute__((ext_vector_type(4)));
    using acc_t = typename pg8_sel<I8, i32x4, f32x4>::type;
    acc_t acc[2][2][4][2];
#pragma unroll
    for (int a = 0; a < 2; ++a)
#pragma unroll
        for (int b = 0; b < 2; ++b)
#pragma unroll
            for (int m = 0; m < 4; ++m)
#pragma unroll
                for (int n = 0; n < 2; ++n) acc[a][b][m][n] = acc_t{};
    bf16x8 At[4][2], B0[2][2], B1[2][2];
    if (DBG >= 2) { _Pragma("unroll") for (int k = 0; k < 2; ++k) { _Pragma("unroll") for (int m = 0; m < 4; ++m) _Pragma("unroll") for (int e = 0; e < 8; ++e) At[m][k][e] = (short)(0x3f00 + ((tid * 37 + m * 11 + k * 5 + e * 3) & 0xff) - ((tid + e) & 1) * 0x8000);
        _Pragma("unroll") for (int n = 0; n < 2; ++n) _Pragma("unroll") for (int e = 0; e < 8; ++e) { B0[n][k][e] = (short)(0x3f00 + ((tid * 29 + n * 13 + k * 7 + e * 5) & 0xff) - ((tid + e + n) & 1) * 0x8000); B1[n][k][e] = (short)(0x3f00 + ((tid * 23 + n * 17 + k * 3 + e * 7) & 0xff) - ((tid + e + k) & 1) * 0x8000); } } }
    const char* cA = (const char*)g.A + (size_t)cur.pm * tstep; const char* cB = (const char*)g.Bt + (size_t)cur.pn * tstep;
    S.a_ready(cur);
    if constexpr (SP2 && GV == 4) {
        PG8_STAGE(PG8_SB(0, 0), cB, voffB); PG8_STAGE(PG8_SB(0, 1), cB + hstep, voffB); PG8_STAGE(PG8_SA(0, 0), cA, voffA); PG8_STAGE(PG8_SA(0, 1), cA + hstep, voffA);
        if (wr == 1) PG8_BAR;
        PG8_WAIT_V(2); PG8_BAR;
        PG8_STAGE(PG8_SB(1, 0), cB + kstep, voffB); PG8_PIECE(PG8_SA(1, 0), cA + kstep, voffA, 0); PG8_STAGE(PG8_SB(1, 1), cB + hstep + kstep, voffB);
        PG8_WAIT_V(5); PG8_BAR;
    } else if constexpr (SP2) {
        PG8_STAGE(PG8_SB(0, 0), cB, voffB); PG8_STAGE(PG8_SB(0, 1), cB + hstep, voffB); PG8_STAGE(PG8_SA(0, 0), cA, voffA); PG8_STAGE(PG8_SA(0, 1), cA + hstep, voffA);
        if (wr == 1) PG8_BAR;
        PG8_WAIT_V(2); PG8_BAR;
        PG8_STAGE(PG8_SB(1, 0), cB + kstep, voffB); PG8_STAGE(PG8_SA(1, 0), cA + kstep, voffA); PG8_STAGE(PG8_SB(1, 1), cB + hstep + kstep, voffB);
        PG8_WAIT_V(6); PG8_BAR;
    } else {
        PG8_STAGE(PG8_SB(0, 0), cB, voffB); PG8_STAGE(PG8_SA(0, 0), cA, voffA); PG8_STAGE(PG8_SB(0, 1), cB + hstep, voffB); PG8_STAGE(PG8_SA(0, 1), cA + hstep, voffA);
        if (wr == 1) PG8_BAR;
        PG8_WAIT_V(4); PG8_BAR;
        PG8_STAGE(PG8_SB(1, 0), cB + kstep, voffB); PG8_STAGE(PG8_SA(1, 0), cA + kstep, voffA); PG8_STAGE(PG8_SB(1, 1), cB + hstep + kstep, voffB);
        PG8_WAIT_V(6); PG8_BAR;
    }
    for (;;) {
        const bool has_next = S.next(ui + 1, nxt);
        const char* nA = has_next ? (const char*)g.A + (size_t)nxt.pm * tstep : cA; const char* nB = has_next ? (const char*)g.Bt + (size_t)nxt.pn * tstep : cB;
        for (int t = 0; t < nt; t += 2) {
            const bool last = (t == nt - 2);
            const char* a1 = cA + (size_t)(t + 1) * kstep;
            const char* a2 = last ? nA : cA + (size_t)(t + 2) * kstep; const char* b2 = last ? nB : cB + (size_t)(t + 2) * kstep;
            const char* a3 = a2 + kstep; const char* b3 = b2 + kstep;
            if (last && has_next) S.a_ready(nxt);
            if constexpr (SP2 && GV == 1) {
            PG8_LDB(B0, 0, 0); PG8_LDB(B1, 0, 1); PG8_SCHED; PG8_LDA(At, 0, 0);
            PG8_WAIT_V(6); PG8_WAIT_L(0); PG8_BAR; PG8_MMA(0, 0, At, B0); PG8_SCHED; PG8_STAGE(PG8_SA(1, 1), a1 + hstep, voffA); PG8_SCHED; PG8_MMA(0, 1, At, B1); PG8_BAR; PG8_SCHED;
            PG8_LDA(At, 0, 1);
            PG8_WAIT_V(2); PG8_WAIT_L(0); PG8_BAR; PG8_MMA(1, 0, At, B0); PG8_SCHED; PG8_STAGE(PG8_SB(0, 0), b2, voffB); PG8_STAGE(PG8_SB(0, 1), b2 + hstep, voffB); PG8_STAGE(PG8_SA(0, 0), a2, voffA); PG8_SCHED; PG8_MMA(1, 1, At, B1); PG8_BAR; PG8_SCHED;
            PG8_LDB(B0, 1, 0); PG8_LDB(B1, 1, 1); PG8_SCHED; PG8_LDA(At, 1, 0);
            PG8_WAIT_V(6); PG8_WAIT_L(0); PG8_BAR; PG8_MMA(0, 0, At, B0); PG8_SCHED; PG8_STAGE(PG8_SA(0, 1), a2 + hstep, voffA); PG8_SCHED; PG8_MMA(0, 1, At, B1); PG8_BAR; PG8_SCHED;
            PG8_LDA(At, 1, 1);
            PG8_WAIT_V(2); PG8_WAIT_L(0); PG8_BAR; PG8_MMA(1, 0, At, B0); PG8_SCHED; PG8_STAGE(PG8_SB(1, 0), b3, voffB); PG8_STAGE(PG8_SB(1, 1), b3 + hstep, voffB); PG8_STAGE(PG8_SA(1, 0), a3, voffA); PG8_SCHED; PG8_MMA(1, 1, At, B1); PG8_BAR; PG8_SCHED;
            } else if constexpr (SP2 && GV == 4) {
            PG8_LDB(B0, 0, 0); PG8_LDB(B1, 0, 1); PG8_SCHED; PG8_LDA(At, 0, 0); PG8_STAGE(PG8_SA(1, 1), a1 + hstep, voffA); PG8_PIECE(PG8_SA(1, 0), a1, voffA, 1);
            PG8_WAIT_V(9); PG8_WAIT_L(0); PG8_BAR; PG8_MMA(0, 0, At, B0); PG8_MMA(0, 1, At, B1); PG8_BAR; PG8_SCHED;
            PG8_LDA(At, 0, 1); PG8_STAGE(PG8_SB(0, 0), b2, voffB); PG8_STAGE(PG8_SB(0, 1), b2 + hstep, voffB); PG8_PIECE(PG8_SA(0, 0), a2, voffA, 0);
            PG8_WAIT_V(5); PG8_WAIT_L(0); PG8_BAR; PG8_MMA(1, 0, At, B0); PG8_MMA(1, 1, At, B1); PG8_BAR; PG8_SCHED;
            PG8_LDB(B0, 1, 0); PG8_LDB(B1, 1, 1); PG8_SCHED; PG8_LDA(At, 1, 0); PG8_STAGE(PG8_SA(0, 1), a2 + hstep, voffA); PG8_PIECE(PG8_SA(0, 0), a2, voffA, 1);
            PG8_WAIT_V(9); PG8_WAIT_L(0); PG8_BAR; PG8_MMA(0, 0, At, B0); PG8_MMA(0, 1, At, B1); PG8_BAR; PG8_SCHED;
            PG8_LDA(At, 1, 1); PG8_STAGE(PG8_SB(1, 0), b3, voffB); PG8_STAGE(PG8_SB(1, 1), b3 + hstep, voffB); PG8_PIECE(PG8_SA(1, 0), a3, voffA, 0);
            PG8_WAIT_V(5); PG8_WAIT_L(0); PG8_BAR; PG8_MMA(1, 0, At, B0); PG8_MMA(1, 1, At, B1); PG8_BAR; PG8_SCHED;
            } else if constexpr (SP2 && GV == 2) {
            PG8_LDB(B0, 0, 0); PG8_LDB(B1, 0, 1); PG8_SCHED; PG8_LDA(At, 0, 0); PG8_STAGE(PG8_SA(1, 1), a1 + hstep, voffA);
            PG8_WAIT_V(8); PG8_WAIT_L(0); PG8_BAR; PG8_MMA(0, 0, At, B0); PG8_MMA(0, 1, At, B1); PG8_BAR; PG8_SCHED;
            PG8_LDA(At, 0, 1); PG8_STAGE(PG8_SB(0, 0), b2, voffB); PG8_STAGE(PG8_SB(0, 1), b2 + hstep, voffB);
            PG8_WAIT_V(6); PG8_WAIT_L(0); PG8_BAR; PG8_MMA(1, 0, At, B0); PG8_SCHED; PG8_STAGE(PG8_SA(0, 0), a2, voffA); PG8_SCHED; PG8_MMA(1, 1, At, B1); PG8_BAR; PG8_SCHED;
            PG8_LDB(B0, 1, 0); PG8_LDB(B1, 1, 1); PG8_SCHED; PG8_LDA(At, 1, 0); PG8_STAGE(PG8_SA(0, 1), a2 + hstep, voffA);
            PG8_WAIT_V(8); PG8_WAIT_L(0); PG8_BAR; PG8_MMA(0, 0, At, B0); PG8_MMA(0, 1, At, B1); PG8_BAR; PG8_SCHED;
            PG8_LDA(At, 1, 1); PG8_STAGE(PG8_SB(1, 0), b3, voffB); PG8_STAGE(PG8_SB(1, 1), b3 + hstep, voffB);
            PG8_WAIT_V(6); PG8_WAIT_L(0); PG8_BAR; PG8_MMA(1, 0, At, B0); PG8_SCHED; PG8_STAGE(PG8_SA(1, 0), a3, voffA); PG8_SCHED; PG8_MMA(1, 1, At, B1); PG8_BAR; PG8_SCHED;
            } else if constexpr (SP2) {
            PG8_LDB(B0, 0, 0); PG8_LDB(B1, 0, 1); PG8_SCHED; PG8_LDA(At, 0, 0); PG8_STAGE(PG8_SA(1, 1), a1 + hstep, voffA);
            PG8_WAIT_V(8); PG8_WAIT_L(0); PG8_BAR; PG8_MMA(0, 0, At, B0); PG8_MMA(0, 1, At, B1); PG8_BAR; PG8_SCHED;
            PG8_LDA(At, 0, 1); PG8_STAGE(PG8_SB(0, 0), b2, voffB); PG8_STAGE(PG8_SB(0, 1), b2 + hstep, voffB); PG8_STAGE(PG8_SA(0, 0), a2, voffA);
            PG8_WAIT_V(8); PG8_WAIT_L(0); PG8_BAR; PG8_MMA(1, 0, At, B0); PG8_MMA(1, 1, At, B1); PG8_BAR; PG8_SCHED;
            PG8_LDB(B0, 1, 0); PG8_LDB(B1, 1, 1); PG8_SCHED; PG8_LDA(At, 1, 0); PG8_STAGE(PG8_SA(0, 1), a2 + hstep, voffA);
            PG8_WAIT_V(8); PG8_WAIT_L(0); PG8_BAR; PG8_MMA(0, 0, At, B0); PG8_MMA(0, 1, At, B1); PG8_BAR; PG8_SCHED;
            PG8_LDA(At, 1, 1); PG8_STAGE(PG8_SB(1, 0), b3, voffB); PG8_STAGE(PG8_SB(1, 1), b3 + hstep, voffB); PG8_STAGE(PG8_SA(1, 0), a3, voffA);
            PG8_WAIT_V(8); PG8_WAIT_L(0); PG8_BAR; PG8_MMA(1, 0, At, B0); PG8_MMA(1, 1, At, B1); PG8_BAR; PG8_SCHED;
            } else {
            PG8_LDB(B0, 0, 0); PG8_SCHED; PG8_LDA(At, 0, 0); PG8_STAGE(PG8_SA(1, 1), a1 + hstep, voffA);
            PG8_WAIT_L(8); PG8_BAR; PG8_WAIT_L(0); PG8_MMA(0, 0, At, B0); PG8_BAR; PG8_SCHED;
            PG8_LDB(B1, 0, 1); PG8_STAGE(PG8_SB(0, 0), b2, voffB);
            PG8_BAR; PG8_WAIT_L(0); PG8_MMA(0, 1, At, B1); PG8_BAR;
            PG8_LDA(At, 0, 1); PG8_STAGE(PG8_SA(0, 0), a2, voffA);
            PG8_BAR; PG8_WAIT_L(0); PG8_MMA(1, 0, At, B0); PG8_BAR; PG8_SCHED;
            PG8_STAGE(PG8_SB(0, 1), b2 + hstep, voffB);
            PG8_WAIT_V(6); PG8_BAR; PG8_MMA(1, 1, At, B1); PG8_BAR;
            PG8_LDB(B0, 1, 0); PG8_SCHED; PG8_LDA(At, 1, 0); PG8_STAGE(PG8_SA(0, 1), a2 + hstep, voffA);
            PG8_WAIT_L(8); PG8_BAR; PG8_WAIT_L(0); PG8_MMA(0, 0, At, B0); PG8_BAR; PG8_SCHED;
            PG8_LDB(B1, 1, 1); PG8_STAGE(PG8_SB(1, 0), b3, voffB);
            PG8_BAR; PG8_WAIT_L(0); PG8_MMA(0, 1, At, B1); PG8_BAR;
            PG8_LDA(At, 1, 1); PG8_STAGE(PG8_SA(1, 0), a3, voffA);
            PG8_BAR; PG8_WAIT_L(0); PG8_MMA(1, 0, At, B0); PG8_BAR; PG8_SCHED;
            PG8_STAGE(PG8_SB(1, 1), b3 + hstep, voffB);
            PG8_WAIT_V(6); PG8_BAR; PG8_MMA(1, 1, At, B1); PG8_BAR;
            }
        }
        if constexpr (ALIGN_EPI) { if (wr == 0) PG8_BAR; }
        if constexpr (!Epi::AFTER_DRAIN) {
            if constexpr (I8) { f32x4 accf[2][2][4][2];
                _Pragma("unroll") for (int a = 0; a < 2; ++a) _Pragma("unroll") for (int b = 0; b < 2; ++b) _Pragma("unroll") for (int m = 0; m < 4; ++m) _Pragma("unroll") for (int n = 0; n < 2; ++n) accf[a][b][m][n] = __builtin_convertvector(acc[a][b][m][n], f32x4);
                E(accf, cur, wr, wc, fr, fq); }
            else E(acc, cur, wr, wc, fr, fq);
            S.done(cur); }
        if (!has_next) break;
#pragma unroll
        for (int a = 0; a < 2; ++a)
#pragma unroll
            for (int b = 0; b < 2; ++b)
#pragma unroll
                for (int m = 0; m < 4; ++m)
#pragma unroll
                    for (int n = 0; n < 2; ++n) acc[a][b][m][n] = acc_t{};
        cur = nxt; cA = nA; cB = nB; ++ui;
        if constexpr (ALIGN_EPI) { if (wr == 1) PG8_BAR; }
    }
    PG8_WAIT_V(0);
    if constexpr (!ALIGN_EPI) { if (wr == 0) PG8_BAR; }
    PG8_BAR;
    if constexpr (Epi::AFTER_DRAIN && !I8) { E.fused(acc, cur, wr, wc, fr, fq, lds, wid, lane); S.done(cur); }
#undef PG8_SA
#undef PG8_SB
#undef PG8_STAGE
#undef PG8_PIECE
#undef PG8_LDA
#undef PG8_LDB
#undef PG8_MMA
#undef PG8_WAIT_V
#undef PG8_WAIT_L
#undef PG8_BAR
#undef PG8_SCHED
}
}
constexpr int NWAVES = 8;
constexpr int NB = 4, SEQ = 4096, DM = 4096, M = NB * SEQ, DIN = 10240, DFF = 16384, PLE = 256, AW = 2048, NH = 16, HD = 128, CH = 128;
constexpr float EPS = 1e-6f;
constexpr float QSCALE = 0.08838834764831845f;
constexpr size_t MiB = 1u << 20;
constexpr size_t WS_CTL = 0, CTL_ZERO_BYTES = 256 * 1024;
constexpr size_t WS_PBF = 1 * MiB;
constexpr size_t WS_WSB = 9 * MiB;
constexpr size_t WS_WIN = 10 * MiB, WS_WOUT = WS_WIN + 80 * MiB, WS_WUP = WS_WOUT + 32 * MiB, WS_WDN = WS_WUP + 128 * MiB, WS_WGT = WS_WDN + 128 * MiB, WS_WPJ = WS_WGT + 32 * MiB;
constexpr size_t WS_ACT = WS_WPJ + 2 * MiB;
constexpr size_t WS_Z = WS_ACT + 128 * MiB;
constexpr size_t WS_HID = WS_ACT;
constexpr size_t WS_HG = WS_ACT + 512 * MiB;
constexpr size_t WS_WG8 = WS_HG + 128 * MiB;
constexpr size_t WS_END = WS_WG8 + 16 * MiB;
constexpr size_t WS_H2Q = WS_Z + 128 * MiB;
constexpr size_t WS_SA2 = 320 * 1024, WS_SWG = 400 * 1024;
static_assert(WS_Z + (size_t)M * DIN * 2 <= WS_HG && WS_HID + (size_t)M * DFF * 2 <= WS_HG && WS_WPJ + (size_t)DM * PLE * 2 <= WS_ACT && WS_PBF + (size_t)M * PLE * 2 <= WS_WSB, "d_ws map");
constexpr int CW_TMO = 0, CW_CODE = 1;
constexpr int CW_BAR = 4096;
constexpr int CW_SSQ1 = 16384, CW_SSQ2 = 32768, CW_SSQ3 = 49152;
static_assert((CW_SSQ3 + M) * 4 <= (int)CTL_ZERO_BYTES, "CTL words inside the memset region");
constexpr int RING_OFF = 0, RING_BYTES = 131072;
constexpr int LDS_BYTES = 147456;
constexpr int LDSCTL_OFF = LDS_BYTES - 1024, MISC_OFF = LDSCTL_OFF + 320;
static_assert(MISC_OFF + 128 <= LDS_BYTES, "LDS map");

#define GAS __attribute__((address_space(1)))
#define LAS __attribute__((address_space(3)))
typedef unsigned short bf16;
typedef unsigned v4u __attribute__((ext_vector_type(4)));
typedef float f32x4 __attribute__((ext_vector_type(4)));
typedef short bf16x8 __attribute__((ext_vector_type(8)));
typedef GAS unsigned gu32;
typedef GAS unsigned long long gu64;
#define RLX_AGENT __ATOMIC_RELAXED, __HIP_MEMORY_SCOPE_AGENT
#define LDS_WAIT() asm volatile("s_waitcnt lgkmcnt(0)" ::: "memory")
#define VM_WAIT() asm volatile("s_waitcnt vmcnt(0)" ::: "memory")
__device__ __forceinline__ unsigned long long rt() { return __builtin_amdgcn_s_memrealtime(); }
__device__ __forceinline__ unsigned f2bf(float f) { unsigned u = __builtin_bit_cast(unsigned, f); return (u + 0x7fffu + ((u >> 16) & 1u)) >> 16; }
__device__ __forceinline__ unsigned pk2(float lo, float hi) { return f2bf(lo) | (f2bf(hi) << 16); }
#define XB_TMO      128
#define XB_XCNT(j)  (256  + 64 * (j))
#define XB_XSUB(j)  (1280 + 64 * (j))
#define XB_XGEN(j)  (2304 + 64 * (j))
#define XB_TOP      3328
#define XB_TOPGEN   3392
#define XCD_BAR_WORDS 3456
#define XB_SPIN_CAP (1u << 18)

__device__ __forceinline__ unsigned xb_ld(unsigned* p)              { return __hip_atomic_load(p, __ATOMIC_RELAXED, __HIP_MEMORY_SCOPE_AGENT); }
__device__ __forceinline__ unsigned xb_add(unsigned* p, unsigned v) { return __hip_atomic_fetch_add(p, v, __ATOMIC_RELAXED, __HIP_MEMORY_SCOPE_AGENT); }
__device__ __forceinline__ unsigned xb_xcc_id() { return (unsigned)__builtin_amdgcn_s_getreg((3 << 11) | 20) & 0xFu; }
#define XB_SPIN(cond, bar) do { unsigned _sp = 0; while (cond) { __builtin_amdgcn_s_sleep(1); \
    if ((++_sp & 255u) == 0u) { if (xb_ld(&(bar)[XB_TMO])) break; if (_sp > XB_SPIN_CAP) { atomicAdd(&(bar)[XB_TMO], 1u); break; } } } } while (0)

struct XcdBarrier {
    unsigned* bar; unsigned x;
    volatile LAS unsigned* st;
};

__device__ __forceinline__ XcdBarrier xcd_barrier_post(unsigned* bar, volatile LAS unsigned* st) {
    XcdBarrier b; b.bar = bar; b.x = xb_xcc_id(); b.st = st;
    if (threadIdx.x == 0) (void)xb_add(&bar[XB_XCNT(b.x)], 1u);
    return b;
}
__device__ __forceinline__ void xcd_barrier_complete(unsigned* bar, unsigned x, unsigned& nloc, unsigned& nx) {
    const unsigned G = gridDim.x * gridDim.y * gridDim.z;
    unsigned sum, cnt, mine, sp = 0u;
    for (;;) {
        sum = 0u; cnt = 0u; mine = 0u;
#pragma unroll
        for (unsigned j = 0; j < 16; ++j) { const unsigned c = xb_ld(&bar[XB_XCNT(j)]); sum += c; cnt += (c > 0u) ? 1u : 0u; mine = (j == x) ? c : mine; }
        if (sum == G) break;
        __builtin_amdgcn_s_sleep(1);
        if ((++sp & 255u) == 0u) { if (xb_ld(&bar[XB_TMO])) break; if (sp > XB_SPIN_CAP) { atomicAdd(&bar[XB_TMO], 1u); break; } }
    }
    nloc = mine > 0u ? mine : 1u; nx = cnt > 0u ? cnt : 1u;
}

__device__ __forceinline__ void xcd_barrier(const XcdBarrier& b) {
    asm volatile("s_waitcnt vmcnt(0)" ::: "memory");
    __syncthreads();
    if (threadIdx.x == 0) {
        unsigned* bar = b.bar;
        __builtin_amdgcn_s_waitcnt(0);
        unsigned nloc = b.st[0], nx = b.st[1];
        if (nloc == 0u) { xcd_barrier_complete(bar, b.x, nloc, nx); b.st[0] = nloc; b.st[1] = nx; }
        const unsigned old = xb_add(&bar[XB_XSUB(b.x)], 1u);
        const unsigned gen = old / nloc;
        if (old + 1u == (gen + 1u) * nloc) {
            __builtin_amdgcn_fence(__ATOMIC_RELEASE, "agent");
            asm volatile("s_waitcnt vmcnt(0)" ::: "memory");
            const unsigned og = xb_add(&bar[XB_TOP], 1u);
            const unsigned tg = og / nx;
            if (og + 1u == (tg + 1u) * nx) xb_add(&bar[XB_TOPGEN], 1u);
            else XB_SPIN(xb_ld(&bar[XB_TOPGEN]) == tg, bar);
            __builtin_amdgcn_fence(__ATOMIC_ACQUIRE, "agent");
            xb_add(&bar[XB_XGEN(b.x)], 1u);
            asm volatile("s_waitcnt vmcnt(0)" ::: "memory");
        } else {
            XB_SPIN(xb_ld(&bar[XB_XGEN(b.x)]) == gen, bar);
            __builtin_amdgcn_fence(__ATOMIC_ACQUIRE, "agent");
            asm volatile("s_waitcnt vmcnt(0)" ::: "memory");
        }
    }
    __syncthreads();
}

struct Frame {
    LAS unsigned char* lds;
    volatile LAS unsigned* MISC;
    gu32* ctl;
    int wave;
    int vcu, G;
};
using pg8::lane_id_v;
__device__ __forceinline__ float wave_sum(float v) {
#pragma unroll
    for (int o = 1; o < 64; o <<= 1) v += __shfl_xor(v, o);
    return v;
}
__device__ __forceinline__ float bf2f(unsigned short h) { return __builtin_bit_cast(float, (unsigned)h << 16); }
constexpr int P0_SCR = 64 * 65 * 4;
__device__ __forceinline__ void p0_transpose_item(const float* W, int K, int N, bf16* WT, LAS float* scr, int item, int lane, const float* kg = nullptr) {
    const int nblk = N / 64, kb = item / nblk, nb = item % nblk, k0 = 64 * kb, n0 = 64 * nb;
    const int kr = lane >> 4, c4 = lane & 15;
    f32x4 v[16];
#pragma unroll
    for (int i = 0; i < 16; ++i) v[i] = *(const GAS f32x4*)(W + (size_t)(k0 + 4 * i + kr) * N + n0 + 4 * c4);
#pragma unroll
    for (int i = 0; i < 16; ++i) { LAS float* s = scr + (4 * i + kr) * 65 + 4 * c4; s[0] = v[i].x; s[1] = v[i].y; s[2] = v[i].z; s[3] = v[i].w; }
    LDS_WAIT(); asm volatile("" ::: "memory");
    const int c = lane & 7;
    f32x4 g0 = {1.f, 1.f, 1.f, 1.f}, g1 = g0; if (kg) { g0 = *(const GAS f32x4*)(kg + k0 + 8 * c); g1 = *(const GAS f32x4*)(kg + k0 + 8 * c + 4); }
#pragma unroll
    for (int j = 0; j < 8; ++j) { const int n = (lane >> 3) + 8 * j; const LAS float* s = scr + (8 * c) * 65 + n;
        v4u o; o.x = pk2(s[0 * 65] * g0.x, s[1 * 65] * g0.y); o.y = pk2(s[2 * 65] * g0.z, s[3 * 65] * g0.w); o.z = pk2(s[4 * 65] * g1.x, s[5 * 65] * g1.y); o.w = pk2(s[6 * 65] * g1.z, s[7 * 65] * g1.w);
        *(GAS v4u*)(WT + (size_t)(n0 + n) * K + k0 + 8 * c) = o; }
    LDS_WAIT(); asm volatile("" ::: "memory");
}
__device__ __forceinline__ unsigned q4(float a, float b, float c, float dd, float inv) {
    const int i0 = (int)__builtin_rintf(fminf(fmaxf(a * inv, -127.f), 127.f)), i1 = (int)__builtin_rintf(fminf(fmaxf(b * inv, -127.f), 127.f));
    const int i2 = (int)__builtin_rintf(fminf(fmaxf(c * inv, -127.f), 127.f)), i3 = (int)__builtin_rintf(fminf(fmaxf(dd * inv, -127.f), 127.f));
    return (unsigned)(i0 & 0xff) | ((unsigned)(i1 & 0xff) << 8) | ((unsigned)(i2 & 0xff) << 16) | ((unsigned)(i3 & 0xff) << 24); }
__device__ __forceinline__ float wave_max(float v) {
#pragma unroll
    for (int o = 1; o < 64; o <<= 1) v = fmaxf(v, __shfl_xor(v, o));
    return v;
}
__device__ __forceinline__ void rms_row_to_bf16(int lane, const float* xrow, const float* g, bf16* orow) {
    const GAS f32x4* xr = (const GAS f32x4*)xrow + lane; const GAS f32x4* gr = (const GAS f32x4*)g + lane;
    f32x4 v[16]; float s = 0.f;
#pragma unroll
    for (int j = 0; j < 16; ++j) { v[j] = xr[64 * j]; s += (v[j].x * v[j].x + v[j].y * v[j].y) + (v[j].z * v[j].z + v[j].w * v[j].w); }
    const float rstd = __builtin_amdgcn_rsqf(wave_sum(s) * (1.f / DM) + EPS);
    GAS unsigned long long* o8 = (GAS unsigned long long*)orow + lane;
#pragma unroll
    for (int j = 0; j < 16; ++j) { const f32x4 gg = gr[64 * j];
        o8[64 * j] = (unsigned long long)pk2(v[j].x * rstd * gg.x, v[j].y * rstd * gg.y) | ((unsigned long long)pk2(v[j].z * rstd * gg.z, v[j].w * rstd * gg.w) << 32); }
}
__device__ __forceinline__ void quant_row_bf16(int lane, const bf16* hrow, unsigned char* qrow, float* sa) {
    const GAS v4u* hr = (const GAS v4u*)hrow + lane;
    v4u w[8]; float am = 0.f;
#pragma unroll
    for (int j = 0; j < 8; ++j) { w[j] = hr[64 * j];
        am = fmaxf(am, fmaxf(fmaxf(fabsf(pg8::bf_lo(w[j].x)), fabsf(pg8::bf_hi(w[j].x))), fmaxf(fabsf(pg8::bf_lo(w[j].y)), fabsf(pg8::bf_hi(w[j].y)))));
        am = fmaxf(am, fmaxf(fmaxf(fabsf(pg8::bf_lo(w[j].z)), fabsf(pg8::bf_hi(w[j].z))), fmaxf(fabsf(pg8::bf_lo(w[j].w)), fabsf(pg8::bf_hi(w[j].w))))); }
    am = fmaxf(wave_max(am), 1e-30f); const float inv = 127.0f / am;
    GAS unsigned long long* q64 = (GAS unsigned long long*)qrow + lane;
#pragma unroll
    for (int j = 0; j < 8; ++j) q64[64 * j] = (unsigned long long)q4(pg8::bf_lo(w[j].x), pg8::bf_hi(w[j].x), pg8::bf_lo(w[j].y), pg8::bf_hi(w[j].y), inv) | ((unsigned long long)q4(pg8::bf_lo(w[j].z), pg8::bf_hi(w[j].z), pg8::bf_lo(w[j].w), pg8::bf_hi(w[j].w), inv) << 32);
    if (lane == 0) *sa = am * (1.0f / 127.0f);
}
__device__ __forceinline__ void final_row(int lane, const bf16* hrow, float* orow, const float* g, float ssq) {
    const GAS v4u* hr = (const GAS v4u*)hrow + lane; const GAS f32x4* gr = (const GAS f32x4*)g + 2 * lane; GAS f32x4* xr = (GAS f32x4*)orow + 2 * lane;
    const float rstd = __builtin_amdgcn_rsqf(ssq * (1.f / DM) + EPS);
    v4u w[8];
#pragma unroll
    for (int j = 0; j < 8; ++j) w[j] = hr[64 * j];
#pragma unroll
    for (int j = 0; j < 8; ++j) { const f32x4 g0 = gr[128 * j], g1 = gr[128 * j + 1];
        xr[128 * j] = (f32x4){pg8::bf_lo(w[j].x) * rstd * g0.x, pg8::bf_hi(w[j].x) * rstd * g0.y, pg8::bf_lo(w[j].y) * rstd * g0.z, pg8::bf_hi(w[j].y) * rstd * g0.w};
        xr[128 * j + 1] = (f32x4){pg8::bf_lo(w[j].z) * rstd * g1.x, pg8::bf_hi(w[j].z) * rstd * g1.y, pg8::bf_lo(w[j].w) * rstd * g1.z, pg8::bf_hi(w[j].w) * rstd * g1.w}; }
}

typedef float f32x16 __attribute__((ext_vector_type(16)));
typedef short s16x4 __attribute__((ext_vector_type(4)));
typedef short v4i16_t __attribute__((ext_vector_type(4)));
typedef float f32x2_t __attribute__((ext_vector_type(2))); typedef __bf16 bf16x2_t __attribute__((ext_vector_type(2)));
__device__ __forceinline__ unsigned cvtpk_s(float lo, float hi) { f32x2_t v = {lo, hi}; bf16x2_t b = __builtin_convertvector(v, bf16x2_t); return __builtin_bit_cast(unsigned, b); }
__device__ __forceinline__ s16x4 vtr(LAS const unsigned char* p) { return __builtin_bit_cast(s16x4, __builtin_amdgcn_ds_read_tr16_b64_v4i16((LAS v4i16_t*)p)); }
__device__ __forceinline__ int crow(int r, int hi) { return (r & 3) + 8 * (r >> 2) + 4 * hi; }
#define MFMA32(a, b, c) __builtin_amdgcn_mfma_f32_32x32x16_bf16((a), (b), (c), 0, 0, 0)
__device__ __forceinline__ float half_swap_sum(float v) { auto rr = __builtin_amdgcn_permlane32_swap(__float_as_uint(v), __float_as_uint(v), false, false); return __uint_as_float(rr[0]) + __uint_as_float(rr[1]); }
constexpr int KST = 272, VST = 320;

__device__ __forceinline__ void head_norm_store(f32x16 (&o)[4], int lane, LAS unsigned char* wl, const float* gain, bf16* ydst) {
    const int tl = lane & 31, hh = lane >> 5, r4 = lane >> 4, c16 = lane & 15;
    float ss = 0.f;
#pragma unroll
    for (int dt = 0; dt < 4; ++dt)
#pragma unroll
        for (int r = 0; r < 16; ++r) ss += o[dt][r] * o[dt][r];
    ss = half_swap_sum(ss);
    const float rstd = __builtin_amdgcn_rsqf(ss * (1.0f / 128.0f) + EPS);
#pragma unroll
    for (int dt = 0; dt < 4; ++dt)
#pragma unroll
        for (int G = 0; G < 4; ++G) { const int d0 = 32 * dt + 8 * G + 4 * hh; const f32x4 g4 = *(const GAS f32x4*)(gain + d0);
            const unsigned w0 = cvtpk_s(o[dt][4 * G] * rstd * g4.x, o[dt][4 * G + 1] * rstd * g4.y), w1 = cvtpk_s(o[dt][4 * G + 2] * rstd * g4.z, o[dt][4 * G + 3] * rstd * g4.w);
            *(LAS unsigned long long*)(wl + tl * KST + 2 * d0) = (unsigned long long)w0 | ((unsigned long long)w1 << 32); }
#pragma unroll
    for (int i = 0; i < 8; ++i) { const int row = 4 * i + r4; const v4u w = *(LAS const v4u*)(wl + row * KST + 16 * c16);
        *(GAS v4u*)(ydst + (size_t)row * DM + 8 * c16) = w; }
}

constexpr int ATT_WREG = 2 * 32 * KST;
__device__ __forceinline__ void attn_unit(int unit, int lane, LAS unsigned char* wl, const bf16* Z, const float* gb, bf16* Y) {
    const int qb = unit & 127, h = (unit >> 7) & 15, b = unit >> 11;
    const int t0 = qb * 32, tl = lane & 31, hh = lane >> 5, r4 = lane >> 4, c16 = lane & 15;
    const size_t rowb = (size_t)b * SEQ;
    LAS unsigned char* wq = wl; LAS unsigned char* wk = wl + 32 * KST;
    const bf16* Kp = Z + (rowb + r4) * DIN + 3 * AW + h * HD + 8 * c16;
    const unsigned kw = r4 * KST + c16 * 16, kr = tl * KST + hh * 16, vw = r4 * 256 + ((c16 * 16) ^ (r4 << 6));
    v4u kreg[8], vreg[8];
#pragma unroll
    for (int i = 0; i < 8; ++i) { const v4u qv = *(const GAS v4u*)(Kp + (size_t)(t0 + 4 * i) * DIN - AW); kreg[i] = *(const GAS v4u*)(Kp + (size_t)(t0 + 4 * i) * DIN); vreg[i] = *(const GAS v4u*)(Kp + (size_t)(t0 + 4 * i) * DIN + AW);
        *(LAS v4u*)(wq + kw + i * 4 * KST) = qv; }
    f32x16 o[4];
#pragma unroll
    for (int dt = 0; dt < 4; ++dt)
#pragma unroll
        for (int r = 0; r < 16; ++r) o[dt][r] = 0.f;
    float L2 = 0.f;
    const int q4 = (lane & 15) >> 2, p4 = lane & 3, blk = (lane >> 4) & 1;
    for (int j = 0; ; ++j) {
        const int s0 = t0 - 32 * j;
#pragma unroll
        for (int i = 0; i < 8; ++i) *(LAS v4u*)(wk + kw + i * 4 * KST) = kreg[i];
        f32x16 st;
#pragma unroll
        for (int r = 0; r < 16; ++r) st[r] = 0.f;
        { bf16x8 kf[8], qf[8];
#pragma unroll
          for (int ks = 0; ks < 8; ++ks) { kf[ks] = *(LAS const bf16x8*)(wk + kr + 32 * ks); qf[ks] = *(LAS const bf16x8*)(wq + kr + 32 * ks); }
          asm volatile("s_waitcnt lgkmcnt(0)" ::: "memory"); __builtin_amdgcn_sched_barrier(0);
#pragma unroll
          for (int ks = 0; ks < 8; ++ks) st = MFMA32(kf[ks], qf[ks], st); }
#pragma unroll
        for (int i = 0; i < 8; ++i) *(LAS v4u*)(wk + vw + i * 4 * 256) = vreg[i];
        if (s0 >= 32) {
#pragma unroll
            for (int i = 0; i < 8; ++i) { kreg[i] = *(const GAS v4u*)(Kp + (size_t)(s0 - 32 + 4 * i) * DIN); vreg[i] = *(const GAS v4u*)(Kp + (size_t)(s0 - 32 + 4 * i) * DIN + AW); } }
        const bool diag = (j == 0);
        float lk[16];
#pragma unroll
        for (int r = 0; r < 16; ++r) { const float z = st[r];
            const float sp = fmaxf(z, 0.f) + __builtin_amdgcn_logf(1.0f + __builtin_amdgcn_exp2f(-fabsf(z)));
            const bool valid = !diag || (crow(r, hh) < tl);
            lk[r] = valid ? -sp : 0.f; }
        float gs[4], T[4];
#pragma unroll
        for (int G = 0; G < 4; ++G) { gs[G] = (lk[4 * G] + lk[4 * G + 1]) + (lk[4 * G + 2] + lk[4 * G + 3]); T[G] = half_swap_sum(gs[G]); }
        const float SG2 = T[3], SG1 = SG2 + T[2], SG0 = SG1 + T[1];
        const float SG[4] = {SG0, SG1, SG2, 0.f};
        unsigned pw[8];
#pragma unroll
        for (int G = 0; G < 4; ++G) {
            float run = L2 + SG[G] + (hh == 0 ? (T[G] - gs[G]) : 0.f); float a[4];
#pragma unroll
            for (int i = 3; i >= 0; --i) { const int r = 4 * G + i; const float e = __builtin_amdgcn_exp2f(st[r] + lk[r] + run);
                const bool valid = !diag || (crow(r, hh) < tl); a[i] = valid ? e : 0.f; run += lk[r]; }
            pw[2 * G] = cvtpk_s(a[0], a[1]); pw[2 * G + 1] = cvtpk_s(a[2], a[3]); }
        L2 += SG0 + T[0];
#pragma unroll
        for (int s2 = 0; s2 < 2; ++s2) { const v4u pv4 = {pw[4 * s2], pw[4 * s2 + 1], pw[4 * s2 + 2], pw[4 * s2 + 3]}; const bf16x8 pb = __builtin_bit_cast(bf16x8, pv4);
            const int R = 16 * s2 + 4 * hh + q4;
#pragma unroll
            for (int dt = 0; dt < 4; ++dt) { const unsigned xo = (unsigned)(64 * (dt ^ q4) + 32 * blk + 8 * p4);
                const s16x4 lo = vtr(wk + R * 256 + xo), hi = vtr(wk + (R + 8) * 256 + xo);
                const bf16x8 va = __builtin_shufflevector(lo, hi, 0, 1, 2, 3, 4, 5, 6, 7);
                o[dt] = MFMA32(va, pb, o[dt]); } }
        if (s0 < 32 || __all(L2 < -150.5f)) break;
    }
    head_norm_store(o, lane, wk, gb + h * HD, Y + (rowb + t0) * DM + AW + h * HD);
}

__device__ __forceinline__ void sgu_unit(bool active, int unit, int wq, int lane, LAS unsigned char* vn, LAS unsigned char* wl, const bf16* Z, const bf16* WSB, const float* bs, const float* ga, bf16* Y) {
    const int h = unit % NH, nc = (unit / NH) % (SEQ / CH), b = unit / (NH * (SEQ / CH));
    const int tl = lane & 31, hh = lane >> 5, r4 = lane >> 4, c16 = lane & 15;
    const size_t row0 = (size_t)b * SEQ + nc * CH;
    if (active) {
#pragma unroll
        for (int i = 0; i < 8; ++i) { const int s = 32 * wq + 4 * i + r4;
            const v4u w = *(const GAS v4u*)(Z + (row0 + s) * DIN + AW + h * HD + 8 * c16);
            float v[8] = {pg8::bf_lo(w.x), pg8::bf_hi(w.x), pg8::bf_lo(w.y), pg8::bf_hi(w.y), pg8::bf_lo(w.z), pg8::bf_hi(w.z), pg8::bf_lo(w.w), pg8::bf_hi(w.w)};
            float s1 = ((v[0] + v[1]) + (v[2] + v[3])) + ((v[4] + v[5]) + (v[6] + v[7]));
#pragma unroll
            for (int o = 1; o < 16; o <<= 1) s1 += __shfl_xor(s1, o);
            const float mu = s1 * (1.0f / 128.0f); float s2 = 0.f;
#pragma unroll
            for (int e = 0; e < 8; ++e) { v[e] -= mu; s2 += v[e] * v[e]; }
#pragma unroll
            for (int o = 1; o < 16; o <<= 1) s2 += __shfl_xor(s2, o);
            const float rs = __builtin_amdgcn_rsqf(s2 * (1.0f / 128.0f) + EPS);
            v4u ow; ow.x = cvtpk_s(v[0] * rs, v[1] * rs); ow.y = cvtpk_s(v[2] * rs, v[3] * rs); ow.z = cvtpk_s(v[4] * rs, v[5] * rs); ow.w = cvtpk_s(v[6] * rs, v[7] * rs);
            *(LAS v4u*)(vn + s * 256 + ((16 * c16) ^ ((s & 3) << 6))) = ow; }
    }
    LDS_WAIT(); __syncthreads();
    if (active) {
        f32x16 o[4];
#pragma unroll
        for (int dt = 0; dt < 4; ++dt)
#pragma unroll
            for (int r = 0; r < 16; ++r) o[dt][r] = 0.f;
        const int q4 = (lane & 15) >> 2, p4 = lane & 3, blk = (lane >> 4) & 1;
        const bf16* Wrow = WSB + ((size_t)h * CH + 32 * wq + tl) * CH + 8 * hh;
        for (int sb = 0; sb <= wq; ++sb) {
#pragma unroll
            for (int s2 = 0; s2 < 2; ++s2) { const bf16x8 wf = *(const GAS bf16x8*)(Wrow + 32 * sb + 16 * s2);
                const int R = 32 * sb + 16 * s2 + 8 * hh + q4;
#pragma unroll
                for (int dt = 0; dt < 4; ++dt) { const unsigned xo = (unsigned)(64 * (dt ^ q4) + 32 * blk + 8 * p4);
                    const s16x4 lo = vtr(vn + R * 256 + xo), hi = vtr(vn + (R + 4) * 256 + xo);
                    const bf16x8 va = __builtin_shufflevector(lo, hi, 0, 1, 2, 3, 4, 5, 6, 7);
                    o[dt] = MFMA32(va, wf, o[dt]); } } }
#pragma unroll
        for (int i = 0; i < 8; ++i) { const int t = 4 * i + r4; const v4u w = *(const GAS v4u*)(Z + (row0 + 32 * wq + t) * DIN + h * HD + 8 * c16); *(LAS v4u*)(wl + t * KST + 16 * c16) = w; }
        const float bias = bs[h * CH + 32 * wq + tl];
#pragma unroll
        for (int dt = 0; dt < 4; ++dt)
#pragma unroll
            for (int G = 0; G < 4; ++G) { const int d0 = 32 * dt + 8 * G + 4 * hh; const unsigned long long uw = *(LAS const unsigned long long*)(wl + tl * KST + 2 * d0);
                const unsigned u0 = (unsigned)uw, u1 = (unsigned)(uw >> 32);
                o[dt][4 * G] = pg8::bf_lo(u0) * (o[dt][4 * G] + bias); o[dt][4 * G + 1] = pg8::bf_hi(u0) * (o[dt][4 * G + 1] + bias);
                o[dt][4 * G + 2] = pg8::bf_lo(u1) * (o[dt][4 * G + 2] + bias); o[dt][4 * G + 3] = pg8::bf_hi(u1) * (o[dt][4 * G + 3] + bias); }
        head_norm_store(o, lane, wl, ga + h * HD, Y + (row0 + 32 * wq) * DM + h * HD);
    }
    LDS_WAIT(); __syncthreads();
}

#if defined(MK_EXP)
constexpr int N_PHASES = 13;
#else
constexpr int N_PHASES = 12;
#endif
struct Args { const float* in[16]; float* out; unsigned char* ws; int ph_lo, ph_hi, li, pad; };
__global__ void __launch_bounds__(NWAVES * 64, 2) mk_fwd(Args args) {
    extern __shared__ __attribute__((aligned(16))) unsigned char lds[];
    Frame F;
    F.lds = (LAS unsigned char*)lds;
    F.MISC = (volatile LAS unsigned*)(F.lds + MISC_OFF);
    F.wave = __builtin_amdgcn_readfirstlane((int)threadIdx.x >> 6);
    F.G = gridDim.x; { const int bx = blockIdx.x; F.vcu = (F.G % 8 == 0) ? (bx % 8) * (F.G / 8) + bx / 8 : bx; }
    unsigned char* ws = args.ws;
    F.ctl = (gu32*)(ws + WS_CTL);
    const float* x = args.in[0]; const float* p = args.in[1]; const float* norm_mix = args.in[2]; const float* w_in = args.in[3];
    const float* w_s = args.in[4]; const float* b_s = args.in[5]; const float* norm_a = args.in[6]; const float* norm_b = args.in[7];
    const float* w_out = args.in[8]; const float* norm_ffn = args.in[9]; const float* w_up = args.in[10]; const float* w_down = args.in[11];
    const float* norm_ple = args.in[12]; const float* w_gate = args.in[13]; const float* w_proj = args.in[14]; const float* norm_final = args.in[15];
    float* out = args.out;
    bf16* PBF = (bf16*)(ws + WS_PBF); bf16* WSB = (bf16*)(ws + WS_WSB);
    bf16 *Wi = (bf16*)(ws + WS_WIN), *Wo = (bf16*)(ws + WS_WOUT), *Wu = (bf16*)(ws + WS_WUP), *Wd = (bf16*)(ws + WS_WDN), *Wg = (bf16*)(ws + WS_WGT), *Wp = (bf16*)(ws + WS_WPJ);
    bf16 *ACT = (bf16*)(ws + WS_ACT), *Z = (bf16*)(ws + WS_Z), *HID = (bf16*)(ws + WS_HID), *HG = (bf16*)(ws + WS_HG);
    unsigned char* WG8 = ws + WS_WG8; unsigned char* H2Q = ws + WS_H2Q;
    float* sa2 = (float*)(ws + WS_SA2); float* swg = (float*)(ws + WS_SWG);
    float* ssq1 = (float*)(ws + WS_CTL) + CW_SSQ1; float* ssq2 = (float*)(ws + WS_CTL) + CW_SSQ2; float* ssq3 = (float*)(ws + WS_CTL) + CW_SSQ3;
    for (int u = (int)threadIdx.x; u < (LDS_BYTES - LDSCTL_OFF) / 4; u += NWAVES * 64) ((LAS unsigned*)(F.lds + LDSCTL_OFF))[u] = 0u;
    __syncthreads();
    const int lo = args.ph_lo, hi = args.ph_hi;
    XcdBarrier bar; bar.bar = (unsigned*)(F.ctl + CW_BAR) + args.li * XCD_BAR_WORDS; bar.x = 0; bar.st = nullptr;
    if (hi - lo > 1) bar = xcd_barrier_post((unsigned*)(F.ctl + CW_BAR) + args.li * XCD_BAR_WORDS, F.MISC + 8);
#define IN(k) (lo <= (k) && (k) < hi)
#define GRID_BAR(k) do { if (IN(k) && IN((k) + 1)) xcd_barrier(bar); } while (0)
    const int gw = F.vcu * NWAVES + F.wave, NGW = F.G * NWAVES;
#ifndef MK_REP0
#define MK_REP0 1
#endif
    if (IN(0))
_Pragma("unroll")
    for (int rep0 = 0; rep0 < MK_REP0; ++rep0) {
        const int lane = lane_id_v();
        LAS float* scr = (LAS float*)(F.lds + RING_OFF + F.wave * P0_SCR);
        constexpr int I_IN = (DM / 64) * (DIN / 64), I_OUT = (DM / 64) * (DM / 64), I_UP = (DM / 64) * (DFF / 64), I_DN = (DFF / 64) * (DM / 64), I_GT = I_OUT, I_PJ = (PLE / 64) * (DM / 64);
        constexpr int NITEMS = I_IN + I_OUT + I_UP + I_DN + I_GT + I_PJ;
        for (int it = gw; it < NITEMS; it += NGW) {
            int r = it;
            if (r < I_IN) { p0_transpose_item(w_in, DM, DIN, Wi, scr, r, lane); continue; } r -= I_IN;
            if (r < I_OUT) { p0_transpose_item(w_out, DM, DM, Wo, scr, r, lane); continue; } r -= I_OUT;
            if (r < I_UP) { p0_transpose_item(w_up, DM, DFF, Wu, scr, r, lane, norm_ffn); continue; } r -= I_UP;
            if (r < I_DN) { p0_transpose_item(w_down, DFF, DM, Wd, scr, r, lane); continue; } r -= I_DN;
            if (r < I_GT) { p0_transpose_item(w_gate, DM, DM, Wg, scr, r, lane, norm_ple); continue; } r -= I_GT;
            p0_transpose_item(w_proj, PLE, DM, Wp, scr, r, lane);
        }
        for (int i = gw; i < M * PLE / 256; i += NGW) {
            const f32x4 v = ((const GAS f32x4*)p)[(size_t)i * 64 + lane];
            ((GAS unsigned long long*)PBF)[(size_t)i * 64 + lane] = (unsigned long long)pk2(v.x, v.y) | ((unsigned long long)pk2(v.z, v.w) << 32); }
        for (int i = gw; i < NH * CH * CH / 256; i += NGW) {
            const f32x4 v = ((const GAS f32x4*)w_s)[(size_t)i * 64 + lane]; const int e0 = i * 256 + lane * 4, s = e0 & 127, t = (e0 >> 7) & 127;
            ((GAS unsigned long long*)WSB)[(size_t)i * 64 + lane] = (unsigned long long)pk2(s <= t ? v.x : 0.f, s + 1 <= t ? v.y : 0.f) | ((unsigned long long)pk2(s + 2 <= t ? v.z : 0.f, s + 3 <= t ? v.w : 0.f) << 32); }
        for (int m = gw; m < M; m += NGW) rms_row_to_bf16(lane, x + (size_t)m * DM, norm_mix, ACT + (size_t)m * DM);
    }
    GRID_BAR(0);
    if (IN(1)) {
        const int lane = lane_id_v();
        for (int n = gw; n < DM; n += NGW) quant_row_bf16(lane, Wg + (size_t)n * DM, WG8 + (size_t)n * DM, swg + n);
    }
    GRID_BAR(1);
    if (IN(2)) {
        pg8::Gemm g{ACT, Wi, M, DIN, DM}; pg8::StaticOrder S; S.init(M, DIN, F.G, (int)blockIdx.x);
        pg8::EpiInProj E{Z, DIN, (2 * AW) / 256, (3 * AW) / 256, QSCALE * 1.4426950408889634f};
        pg8::gemm_phase<pg8::EpiInProj, pg8::StaticOrder, true, true>(F.lds + RING_OFF, g, S, E);
    }
    GRID_BAR(2);
    if (IN(3)) {
        const int lane = lane_id_v(), hw = F.wave >> 2, wq = F.wave & 3;
        LAS unsigned char* vn = F.lds + hw * 32768; LAS unsigned char* wls = F.lds + 65536 + F.wave * (32 * KST);
        constexpr int NSGU = NB * (SEQ / CH) * NH;
        for (int it = 0; it * (2 * F.G) < NSGU; ++it) { const int unit = it * (2 * F.G) + 2 * (int)blockIdx.x + hw;
            sgu_unit(unit < NSGU, unit < NSGU ? unit : 0, wq, lane, vn, wls, Z, WSB, b_s, norm_a, ACT); }
    }
    if (IN(4)) {
        const int lane = lane_id_v();
        LAS unsigned char* wl2 = F.lds + F.wave * ATT_WREG;
        constexpr int NATT = NB * NH * (SEQ / 32);
        for (int i = 0; ; ++i) { const int unit = (i * F.G + (int)blockIdx.x) * NWAVES + F.wave; if (unit >= NATT) break;
            attn_unit(unit, lane, wl2, Z, norm_b, ACT); }
    }
    GRID_BAR(4);
    if (IN(5)) {
        pg8::Gemm g{ACT, Wo, M, DM, DM}; pg8::StaticOrder S; S.init(M, DM, F.G, (int)blockIdx.x);
        pg8::EpiRes1 E{x, HG, ssq1, DM};
        pg8::gemm_phase<pg8::EpiRes1, pg8::StaticOrder, true, true>(F.lds + RING_OFF, g, S, E);
    }
    GRID_BAR(5);
    if (IN(6)) {
        pg8::Gemm g{HG, Wu, M, DFF, DM}; pg8::StaticOrder S; S.init(M, DFF, F.G, (int)blockIdx.x);
        pg8::EpiUp E{HID, DFF, ssq1, 1.0f / DM, EPS};
        pg8::gemm_phase<pg8::EpiUp, pg8::StaticOrder, true, true>(F.lds + RING_OFF, g, S, E);
    }
    GRID_BAR(6);
    if (IN(7)) {
        pg8::Gemm g{HID, Wd, M, DM, DFF}; pg8::StaticOrder S; S.init(M, DM, F.G, (int)blockIdx.x);
        pg8::EpiRes2 E{HG, ssq2, DM};
        pg8::gemm_phase<pg8::EpiRes2, pg8::StaticOrder, true, true>(F.lds + RING_OFF, g, S, E);
    }
    GRID_BAR(7);
    if (IN(8)) {
        const int lane = lane_id_v();
        for (int m = gw; m < M; m += NGW) quant_row_bf16(lane, HG + (size_t)m * DM, H2Q + (size_t)m * DM, sa2 + m);
    }
    GRID_BAR(8);
    if (IN(9)) {
        pg8::Gemm g{PBF, Wp, M, DM, PLE}; pg8::StaticOrder S; S.init(M, DM, F.G, (int)blockIdx.x);
        pg8::EpiPlainBf16 E{ACT, DM};
        pg8::gemm_phase<pg8::EpiPlainBf16, pg8::StaticOrder, true, true>(F.lds + RING_OFF, g, S, E);
        VM_WAIT(); __syncthreads();
    }
    if (IN(10)) {
#if defined(MK_GATE_BF16)
        pg8::Gemm g{HG, Wg, M, DM, DM}; pg8::StaticOrder S; S.init(M, DM, F.G, (int)blockIdx.x);
        pg8::EpiGate E{Z, HG, ACT, ssq2, ssq3, DM, 1.0f / DM, EPS, nullptr, nullptr};
        pg8::gemm_phase<pg8::EpiGate, pg8::StaticOrder, true, true>(F.lds + RING_OFF, g, S, E);
#else
        pg8::Gemm g{(const bf16*)H2Q, (const bf16*)WG8, M, DM, DM / 2}; pg8::StaticOrder S; S.init(M, DM, F.G, (int)blockIdx.x);
        pg8::EpiGate E{Z, HG, ACT, ssq2, ssq3, DM, 1.0f / DM, EPS, sa2, swg};
        pg8::gemm_phase<pg8::EpiGate, pg8::StaticOrder, true, true, false, 0, 0, true>(F.lds + RING_OFF, g, S, E);
#endif
    }
    GRID_BAR(10);
    if (IN(11)) {
        const int lane = lane_id_v();
        for (int m = gw; m < M; m += NGW) final_row(lane, Z + (size_t)m * DM, out + (size_t)m * DM, norm_final, ssq3[m]);
    }
#if defined(MK_EXP)
    if (IN(12)) {
        pg8::Gemm g{HG, Wu, M, DFF, DM}; pg8::StaticOrder S; S.init(M, DFF, F.G, (int)blockIdx.x);
        pg8::EpiUp E{HID, DFF, ssq1, 1.0f / DM, EPS};
#if MK_EXP == 2
        struct SameUnit { int c; __device__ bool next(int i, pg8::Unit& u) const { if (i >= 16) return false; u.pm = c & 7; u.pn = (c >> 3) & 1; return true; }
            __device__ __forceinline__ void a_ready(const pg8::Unit&) const {} __device__ __forceinline__ void done(const pg8::Unit&) const {} } SU{(int)blockIdx.x};
        pg8::gemm_phase<pg8::EpiUp, SameUnit, true, true, false>(F.lds + RING_OFF, g, SU, E);
#else
        pg8::gemm_phase<pg8::EpiUp, pg8::StaticOrder, true, true, (MK_EXP == 1), (MK_EXP >= 10 && MK_EXP < 20 ? MK_EXP - 10 : 0), (MK_EXP >= 20 ? MK_EXP - 20 : 0)>(F.lds + RING_OFF, g, S, E);
#endif
    }
#endif
#undef IN
#undef GRID_BAR
}

extern "C" void kernel_launch(void* const* d_in, const int* in_sizes, int n_in, void* d_out, int out_size, void* d_ws, size_t ws_size, hipStream_t stream) {
    static int grid = 0;
    if (grid == 0) {
        if (n_in != 16 || in_sizes[0] != M * DM || out_size != M * DM || ws_size < WS_END) { fprintf(stderr, "kernel_launch: unexpected shapes: n_in %d, in0 %d, out %d, ws %zu (need %zu); nothing launched\n", n_in, n_in > 0 ? in_sizes[0] : -1, out_size, ws_size, (size_t)WS_END); grid = -1; return; }
        int dev = 0, cus = 0, per_cu = 0;
        if (hipGetDevice(&dev) != hipSuccess || hipDeviceGetAttribute(&cus, hipDeviceAttributeMultiprocessorCount, dev) != hipSuccess) { fprintf(stderr, "kernel_launch: device query failed\n"); grid = -1; return; }
        if (hipFuncSetAttribute((const void*)mk_fwd, hipFuncAttributeMaxDynamicSharedMemorySize, LDS_BYTES) != hipSuccess) { fprintf(stderr, "kernel_launch: hipFuncSetAttribute failed\n"); grid = -1; return; }
        if (hipOccupancyMaxActiveBlocksPerMultiprocessor(&per_cu, (const void*)mk_fwd, NWAVES * 64, LDS_BYTES) != hipSuccess || per_cu < 1) { fprintf(stderr, "kernel_launch: occupancy query reports %d workgroups per CU\n", per_cu); }
        (void)hipGetLastError();
        grid = cus;
    }
    if (grid < 0) return;
    if (hipMemsetAsync((char*)d_ws + WS_CTL, 0, CTL_ZERO_BYTES, stream) != hipSuccess) { fprintf(stderr, "kernel_launch: hipMemsetAsync failed\n"); return; }
    Args a{};
    for (int i = 0; i < 16; ++i) a.in[i] = (const float*)d_in[i];
    a.out = (float*)d_out; a.ws = (unsigned char*)d_ws;
#if defined(MK_PLAN)
    { const int plan[] = MK_PLAN; int li = 0;
      for (unsigned i = 0; i + 1 < sizeof(plan) / sizeof(plan[0]); i += 2) { a.ph_lo = plan[i]; a.ph_hi = plan[i + 1]; a.li = li; if (plan[i + 1] - plan[i] > 1) ++li;
          hipLaunchKernelGGL(mk_fwd, dim3(grid), dim3(NWAVES * 64), LDS_BYTES, stream, a); } }
#else
    a.ph_lo = 0; a.ph_hi = N_PHASES; a.li = 0;
    hipLaunchKernelGGL(mk_fwd, dim3(grid), dim3(NWAVES * 64), LDS_BYTES, stream, a);
#endif
    const hipError_t le = hipPeekAtLastError();
    if (le != hipSuccess) fprintf(stderr, "kernel_launch: launch failed: %s\n", hipGetErrorName(le));
}
```

```cpp
#include <hip/hip_runtime.h>
#include <cstdio>
#include <cstdint>
namespace pg8 {
#define PG8_LAS __attribute__((address_space(3)))
typedef unsigned short bf16_t;
typedef short bf16x8 __attribute__((ext_vector_type(8)));
typedef float f32x4 __attribute__((ext_vector_type(4)));
typedef unsigned u32x4 __attribute__((ext_vector_type(4)));
constexpr int BM = 256, BK = 64, HALF = 128, HTB = HALF * BK * 2  , STAGE_BYTES = 8 * HTB, NXCD = 8, WGM = 8;

__host__ __device__ __forceinline__ int lds_byte(int r, int c) { const int st = (r >> 4) * 2 + (c >> 5), rr = r & 15, cc = c & 31, ob = rr * 64 + cc * 2; return st * 1024 + (ob ^ (((ob >> 9) & 1) << 5)); }
__host__ __device__ __forceinline__ void stage_rc(int b, int& R, int& C) { const int st = b / 1024, sb = b % 1024, swz = sb ^ (((sb >> 9) & 1) << 5); R = (st >> 1) * 16 + swz / 64; C = (st & 1) * 32 + (swz % 64) / 2; }
__host__ __device__ __forceinline__ int perm32(int rho) { const int n = rho >> 4, i = rho & 15; return 8 * (i >> 2) + 4 * n + (i & 3); }

struct Unit { int pm, pn; };
struct Gemm { const bf16_t* A; const bf16_t* Bt; int M, N, K; };

struct StaticOrder {
    int nM, nN, nwg, G, c;
    __host__ __device__ void init(int M, int N, int G_, int c_) { nM = M / BM; nN = N / BM; nwg = nM * nN; G = G_; c = c_; }
    __host__ __device__ bool next(int i, Unit& u) const {
        const long L = (long)i * G + c; if (L >= nwg) return false;
        int wgid = (int)L; { const int q = nwg / NXCD, r = nwg % NXCD, xcd = wgid % NXCD, off = wgid / NXCD; wgid = (xcd < r ? xcd * (q + 1) : r * (q + 1) + (xcd - r) * q) + off; }
        const int nig = WGM * nN, gid = wgid / nig, fm = gid * WGM, gsz = (nM - fm) < WGM ? (nM - fm) : WGM;
        u.pm = fm + ((wgid % nig) % gsz); u.pn = (wgid % nig) / gsz; return true;
    }
    __device__ __forceinline__ void a_ready(const Unit&) const {}
    __device__ __forceinline__ void done(const Unit&) const {}
};

__device__ __forceinline__ unsigned cvt_pk_bf16(float lo, float hi) { unsigned r; asm volatile("v_cvt_pk_bf16_f32 %0, %1, %2" : "=v"(r) : "v"(lo), "v"(hi)); return r; }
typedef float f32x2 __attribute__((ext_vector_type(2)));
typedef unsigned u32x2 __attribute__((ext_vector_type(2)));
__device__ __forceinline__ int lane_id_v() { int l; asm volatile("v_mbcnt_lo_u32_b32 %0, -1, 0\n\tv_mbcnt_hi_u32_b32 %0, -1, %0" : "=v"(l)); return l; }
__device__ __forceinline__ float fq_sum(float v, int lid) {
    v += __builtin_bit_cast(float, __builtin_amdgcn_ds_bpermute((lid ^ 16) << 2, __builtin_bit_cast(int, v)));
    v += __builtin_bit_cast(float, __builtin_amdgcn_ds_bpermute((lid ^ 32) << 2, __builtin_bit_cast(int, v)));
    return v; }
__device__ __forceinline__ int lane_id_after(float dep) { int l; asm volatile("v_mbcnt_lo_u32_b32 %0, -1, 0\n\tv_mbcnt_hi_u32_b32 %0, -1, %0 ; after %1" : "=&v"(l) : "v"(dep)); return l; }
__device__ __forceinline__ float bf_lo(unsigned w) { return __builtin_bit_cast(float, w << 16); }
__device__ __forceinline__ float bf_hi(unsigned w) { return __builtin_bit_cast(float, w & 0xffff0000u); }
__device__ __forceinline__ float gelu_tanh_f(float x) {
    const float x2 = x * x, t = x * (-2.302208198f + (-0.1029432397f) * x2);
    return x * __builtin_amdgcn_rcpf(1.0f + __builtin_amdgcn_exp2f(t));
}
__device__ __forceinline__ u32x4 pack8(const f32x4 v0, const f32x4 v1) { u32x4 w; w.x = cvt_pk_bf16(v0[0], v0[1]); w.y = cvt_pk_bf16(v0[2], v0[3]); w.z = cvt_pk_bf16(v1[0], v1[1]); w.w = cvt_pk_bf16(v1[2], v1[3]); return w; }
struct EpiInProj {
    static constexpr bool PERM = true, AFTER_DRAIN = false;
    bf16_t* O; int ldc; int gelu_tiles, q_tiles; float qscale;
    __device__ __forceinline__ void operator()(const f32x4 (&acc)[2][2][4][2], const Unit& u, int wr, int wc, int, int) const {
        const int lid_ = lane_id_after(acc[1][1][3][1][3]), fr = lid_ & 15, fq = lid_ >> 4;
        const int row0 = u.pm * BM + wr * 64 + fr, col0 = u.pn * BM + wc * 32 + 8 * fq;
        const int mode = u.pn < gelu_tiles ? 1 : (u.pn < q_tiles ? 2 : 0);
#pragma unroll
        for (int ai = 0; ai < 2; ++ai)
#pragma unroll
            for (int m = 0; m < 4; ++m) { bf16_t* rowp = O + (size_t)(row0 + ai * HALF + m * 16) * ldc + col0;
#pragma unroll
                for (int bj = 0; bj < 2; ++bj) { f32x4 v0 = acc[ai][bj][m][0], v1 = acc[ai][bj][m][1];
                    if (mode == 1) {
#pragma unroll
                        for (int e = 0; e < 4; ++e) { v0[e] = gelu_tanh_f(v0[e]); v1[e] = gelu_tanh_f(v1[e]); } }
                    else if (mode == 2) { v0 = v0 * qscale; v1 = v1 * qscale; }
                    *(u32x4*)(rowp + bj * HALF) = pack8(v0, v1); } }
    }
};
struct EpiInProjI8 {
    static constexpr bool PERM = true, AFTER_DRAIN = false;
    bf16_t* O; int ldc; int gelu_tiles, q_tiles; unsigned qscale_bits; const float* sa; const float* sw;
    __device__ __forceinline__ void operator()(const f32x4 (&acc)[2][2][4][2], const Unit& u, int wr, int wc, int, int) const {
        const int lid_ = lane_id_after(acc[1][1][3][1][3]), fr = lid_ & 15, fq = lid_ >> 4;
        const int oz = lid_ >> 6;
        const int row0 = u.pm * BM + wr * 64 + fr, col0 = u.pn * BM + wc * 32 + 8 * fq;
        const int mode = u.pn < gelu_tiles ? 1 : (u.pn < q_tiles ? 2 : 0);
        const float* sw_ = sw + oz; const float* sa_ = sa + oz; const float qscale = __builtin_bit_cast(float, qscale_bits + (unsigned)oz);
        f32x4 wv[2][2];
#pragma unroll
        for (int bj = 0; bj < 2; ++bj)
#pragma unroll
            for (int n = 0; n < 2; ++n) { wv[bj][n] = *(const f32x4*)(sw_ + col0 + bj * HALF + 4 * n); if (mode == 2) wv[bj][n] = wv[bj][n] * qscale; }
#pragma unroll
        for (int ai = 0; ai < 2; ++ai)
#pragma unroll
            for (int m = 0; m < 4; ++m) { const int row = row0 + ai * HALF + m * 16; bf16_t* rowp = O + (size_t)row * ldc + col0; const float ra = sa_[row];
#pragma unroll
                for (int bj = 0; bj < 2; ++bj) { f32x4 v0 = acc[ai][bj][m][0] * wv[bj][0] * ra, v1 = acc[ai][bj][m][1] * wv[bj][1] * ra;
                    if (mode == 1) {
#pragma unroll
                        for (int e = 0; e < 4; ++e) { v0[e] = gelu_tanh_f(v0[e]); v1[e] = gelu_tanh_f(v1[e]); } }
                    *(u32x4*)(rowp + bj * HALF) = pack8(v0, v1); } }
    }
};
struct EpiPlainBf16 {
    static constexpr bool PERM = true, AFTER_DRAIN = false;
    bf16_t* O; int ldc;
    __device__ __forceinline__ void operator()(const f32x4 (&acc)[2][2][4][2], const Unit& u, int wr, int wc, int, int) const {
        const int lid_ = lane_id_after(acc[1][1][3][1][3]), fr = lid_ & 15, fq = lid_ >> 4;
        const int row0 = u.pm * BM + wr * 64 + fr, col0 = u.pn * BM + wc * 32 + 8 * fq;
#pragma unroll
        for (int ai = 0; ai < 2; ++ai)
#pragma unroll
            for (int m = 0; m < 4; ++m) { bf16_t* rowp = O + (size_t)(row0 + ai * HALF + m * 16) * ldc + col0;
#pragma unroll
                for (int bj = 0; bj < 2; ++bj) *(u32x4*)(rowp + bj * HALF) = pack8(acc[ai][bj][m][0], acc[ai][bj][m][1]); }
    }
};
#define SQ8(h0, h1) ((h0[0] * h0[0] + h0[1] * h0[1]) + (h0[2] * h0[2] + h0[3] * h0[3]) + (h1[0] * h1[0] + h1[1] * h1[1]) + (h1[2] * h1[2] + h1[3] * h1[3]))
struct EpiRes1 {
    static constexpr bool PERM = true, AFTER_DRAIN = false;
    const float* base; bf16_t* hb; float* ssq; int ldc;
    __device__ __forceinline__ void operator()(const f32x4 (&acc)[2][2][4][2], const Unit& u, int wr, int wc, int, int) const {
        const int lid_ = lane_id_after(acc[1][1][3][1][3]), fr = lid_ & 15, fq = lid_ >> 4;
        const int row0 = u.pm * BM + wr * 64 + fr, col0 = u.pn * BM + wc * 32 + 8 * fq;
#pragma unroll
        for (int ai = 0; ai < 2; ++ai) {
            f32x4 pre[4][2][2];
#pragma unroll
            for (int m = 0; m < 4; ++m) { const size_t off = (size_t)(row0 + ai * HALF + m * 16) * ldc + col0;
#pragma unroll
                for (int bj = 0; bj < 2; ++bj) { pre[m][bj][0] = *(const f32x4*)(base + off + bj * HALF); pre[m][bj][1] = *(const f32x4*)(base + off + bj * HALF + 4); } }
            asm volatile("" ::: "memory");
#pragma unroll
            for (int m = 0; m < 4; ++m) { const int row = row0 + ai * HALF + m * 16; const size_t off = (size_t)row * ldc + col0; float s = 0.f;
#pragma unroll
                for (int bj = 0; bj < 2; ++bj) { const f32x4 h0 = pre[m][bj][0] + acc[ai][bj][m][0], h1 = pre[m][bj][1] + acc[ai][bj][m][1];
                    s += SQ8(h0, h1); *(u32x4*)(hb + off + bj * HALF) = pack8(h0, h1); }
                s = fq_sum(s, lid_);
                if (fq == 0) atomicAdd(ssq + row, s); }
            asm volatile("" ::: "memory"); }
    }
};
struct EpiRes2 {
    static constexpr bool PERM = true, AFTER_DRAIN = false;
    bf16_t* hb; float* ssq; int ldc;
    __device__ __forceinline__ void operator()(const f32x4 (&acc)[2][2][4][2], const Unit& u, int wr, int wc, int, int) const {
        const int lid_ = lane_id_after(acc[1][1][3][1][3]), fr = lid_ & 15, fq = lid_ >> 4;
        const int row0 = u.pm * BM + wr * 64 + fr, col0 = u.pn * BM + wc * 32 + 8 * fq;
        u32x4 pre[2][4][2];
#pragma unroll
        for (int ai = 0; ai < 2; ++ai)
#pragma unroll
            for (int m = 0; m < 4; ++m) { const size_t off = (size_t)(row0 + ai * HALF + m * 16) * ldc + col0;
#pragma unroll
                for (int bj = 0; bj < 2; ++bj) pre[ai][m][bj] = *(const u32x4*)(hb + off + bj * HALF); }
        asm volatile("" ::: "memory");
#pragma unroll
        for (int ai = 0; ai < 2; ++ai)
#pragma unroll
            for (int m = 0; m < 4; ++m) { const int row = row0 + ai * HALF + m * 16; const size_t off = (size_t)row * ldc + col0; float s = 0.f;
#pragma unroll
                for (int bj = 0; bj < 2; ++bj) { const u32x4 bw = pre[ai][m][bj];
                    const f32x4 h0 = (f32x4){bf_lo(bw.x), bf_hi(bw.x), bf_lo(bw.y), bf_hi(bw.y)} + acc[ai][bj][m][0], h1 = (f32x4){bf_lo(bw.z), bf_hi(bw.z), bf_lo(bw.w), bf_hi(bw.w)} + acc[ai][bj][m][1];
                    s += SQ8(h0, h1); *(u32x4*)(hb + off + bj * HALF) = pack8(h0, h1); }
                s = fq_sum(s, lid_);
                if (fq == 0) atomicAdd(ssq + row, s); }
    }
};
struct EpiUp {
    static constexpr bool PERM = true, AFTER_DRAIN = false;
    bf16_t* O; int ldc; const float* ssq; float inv_n, eps;
    __device__ __forceinline__ void operator()(const f32x4 (&acc)[2][2][4][2], const Unit& u, int wr, int wc, int, int) const {
        const int lid_ = lane_id_after(acc[1][1][3][1][3]), fr = lid_ & 15, fq = lid_ >> 4;
        const int row0 = u.pm * BM + wr * 64 + fr, col0 = u.pn * BM + wc * 32 + 8 * fq;
#pragma unroll
        for (int ai = 0; ai < 2; ++ai)
#pragma unroll
            for (int m = 0; m < 4; ++m) { const int row = row0 + ai * HALF + m * 16; bf16_t* rowp = O + (size_t)row * ldc + col0;
                const float r2 = 1.0f / (ssq[row] * inv_n + eps);
#pragma unroll
                for (int bj = 0; bj < 2; ++bj) { f32x4 v0 = acc[ai][bj][m][0], v1 = acc[ai][bj][m][1];
#pragma unroll
                    for (int e = 0; e < 4; ++e) { const float a = fmaxf(v0[e], 0.f), b = fmaxf(v1[e], 0.f); v0[e] = a * a * r2; v1[e] = b * b * r2; }
                    *(u32x4*)(rowp + bj * HALF) = pack8(v0, v1); } }
    }
};
struct EpiGate {
    static constexpr bool PERM = true, AFTER_DRAIN = false;
    bf16_t* h3b; const bf16_t* hb; const bf16_t* E; const float* ssq_in; float* ssq_out; int ldc; float inv_n, eps; const float* sa; const float* sw;
    __device__ __forceinline__ void operator()(const f32x4 (&acc)[2][2][4][2], const Unit& u, int wr, int wc, int, int) const {
        const int lid_ = lane_id_after(acc[1][1][3][1][3]), fr = lid_ & 15, fq = lid_ >> 4;
        const int row0 = u.pm * BM + wr * 64 + fr, col0 = u.pn * BM + wc * 32 + 8 * fq;
        f32x4 wv[2][2];
#pragma unroll
        for (int bj = 0; bj < 2; ++bj)
#pragma unroll
            for (int n = 0; n < 2; ++n) wv[bj][n] = sw ? *(const f32x4*)(sw + col0 + bj * HALF + 4 * n) : (f32x4){1.f, 1.f, 1.f, 1.f};
#pragma unroll
        for (int ag = 0; ag < 4; ++ag) { const int ai = ag >> 1, mb = (ag & 1) * 2;
            u32x4 preh[2][2], pree[2][2]; float nrs[2], sas[2];
#pragma unroll
            for (int mm = 0; mm < 2; ++mm) { const int row = row0 + ai * HALF + (mb + mm) * 16; const size_t off = (size_t)row * ldc + col0; nrs[mm] = ssq_in[row]; sas[mm] = sa ? sa[row] : 1.f;
#pragma unroll
                for (int bj = 0; bj < 2; ++bj) { preh[mm][bj] = *(const u32x4*)(hb + off + bj * HALF); pree[mm][bj] = *(const u32x4*)(E + off + bj * HALF); } }
            asm volatile("" ::: "memory");
#pragma unroll
            for (int mm = 0; mm < 2; ++mm) { const int m = mb + mm; const int row = row0 + ai * HALF + m * 16; const size_t off = (size_t)row * ldc + col0; float s = 0.f;
                const float nr = -1.4426950408889634f * sas[mm] * __builtin_amdgcn_rsqf(nrs[mm] * inv_n + eps);
#pragma unroll
                for (int bj = 0; bj < 2; ++bj) { const u32x4 ew = pree[mm][bj], bw = preh[mm][bj];
                    f32x4 h0 = (f32x4){bf_lo(bw.x), bf_hi(bw.x), bf_lo(bw.y), bf_hi(bw.y)}, h1 = (f32x4){bf_lo(bw.z), bf_hi(bw.z), bf_lo(bw.w), bf_hi(bw.w)};
                    const f32x4 a0 = acc[ai][bj][m][0] * wv[bj][0], a1 = acc[ai][bj][m][1] * wv[bj][1];
                    const float e0[4] = {bf_lo(ew.x), bf_hi(ew.x), bf_lo(ew.y), bf_hi(ew.y)}, e1[4] = {bf_lo(ew.z), bf_hi(ew.z), bf_lo(ew.w), bf_hi(ew.w)};
#pragma unroll
                    for (int e = 0; e < 4; ++e) {
                        h0[e] += __builtin_amdgcn_rcpf(1.0f + __builtin_amdgcn_exp2f(nr * a0[e])) * e0[e];
                        h1[e] += __builtin_amdgcn_rcpf(1.0f + __builtin_amdgcn_exp2f(nr * a1[e])) * e1[e]; }
                    s += SQ8(h0, h1); *(u32x4*)(h3b + off + bj * HALF) = pack8(h0, h1); }
                s = fq_sum(s, lid_);
                if (fq == 0) atomicAdd(ssq_out + row, s); }
            asm volatile("" ::: "memory"); }
    }
};
template <bool C, class A, class B> struct pg8_sel { typedef A type; };
template <class A, class B> struct pg8_sel<false, A, B> { typedef B type; };
template <class Epi, class Sched, bool ALIGN_EPI = false, bool SP2 = false, bool TILED = false, int DBG = 0  , int GV = 0  , bool I8 = false  >
__device__ __forceinline__ void gemm_phase(PG8_LAS unsigned char* lds, const Gemm g, const Sched& S, const Epi& E) {
    const int tid = threadIdx.x, wid = __builtin_amdgcn_readfirstlane(tid >> 6), lane = tid & 63, wr = wid >> 2, wc = wid & 3, fr = lane & 15, fq = lane >> 4;
    const int K = g.K, nt = K / BK;
    unsigned voffA[2], voffB[2];
#pragma unroll
    for (int i = 0; i < 2; ++i) { int R, C; stage_rc(tid * 16 + i * 8192, R, C); const int Rb = Epi::PERM ? ((R & ~31) + perm32(R & 31)) : R;
        voffA[i] = (unsigned)(R * K + C) * 2u; voffB[i] = (unsigned)(Rb * K + C) * 2u;
        if (TILED) { voffA[i] = voffB[i] = (unsigned)(tid * 16 + i * 8192); } }
    const size_t kstep = TILED ? (size_t)HTB : (size_t)(BK * 2);
    const size_t hstep = (size_t)HALF * K * 2;
    const size_t tstep = 2 * hstep;
    const unsigned ldsw = (unsigned)wid * 1024u;
    const int aoff = lds_byte(wr * 64 + fr, fq * 8), boff = lds_byte(wc * 32 + fr, fq * 8);
#define PG8_SA(b, h) (((b) * 2 + (h)) * HTB)
#define PG8_SB(b, h) ((4 + (b) * 2 + (h)) * HTB)
#define PG8_STAGE(bufoff, gbase, voff) do { if (DBG >= 3) break; _Pragma("unroll") for (int _i = 0; _i < 2; ++_i) \
        __builtin_amdgcn_global_load_lds((const unsigned*)((const char*)(gbase) + (voff)[_i]), (PG8_LAS unsigned*)(lds + (bufoff) + ldsw + _i * 8192), 16, 0, 0); } while (0)
#define PG8_PIECE(bufoff, gbase, voff, _i) do { if (DBG >= 3) break; \
        __builtin_amdgcn_global_load_lds((const unsigned*)((const char*)(gbase) + (voff)[_i]), (PG8_LAS unsigned*)(lds + (bufoff) + ldsw + (_i) * 8192), 16, 0, 0); } while (0)
#define PG8_LDA(dst, b, h) do { if (DBG >= 2) break; _Pragma("unroll") for (int m = 0; m < 4; ++m) _Pragma("unroll") for (int k = 0; k < 2; ++k) dst[m][k] = *(const PG8_LAS bf16x8*)(lds + PG8_SA(b, h) + aoff + m * 2048 + k * 1024); } while (0)
#define PG8_LDB(dst, b, h) do { if (DBG >= 2) break; _Pragma("unroll") for (int n = 0; n < 2; ++n) _Pragma("unroll") for (int k = 0; k < 2; ++k) dst[n][k] = *(const PG8_LAS bf16x8*)(lds + PG8_SB(b, h) + boff + n * 2048 + k * 1024); } while (0)
#define PG8_MMA(ai, bj, At, Bt) do { __builtin_amdgcn_s_setprio(1); _Pragma("unroll") for (int m = 0; m < 4; ++m) _Pragma("unroll") for (int n = 0; n < 2; ++n) _Pragma("unroll") for (int k = 0; k < 2; ++k) { \
        if (DBG == 1 || (DBG == 4 && (bj) == 1)) { asm volatile("" :: "v"(Bt[n][k]), "v"(At[m][k])); } else \
        if constexpr (I8) acc[ai][bj][m][n] = __builtin_bit_cast(acc_t, __builtin_amdgcn_mfma_i32_16x16x64_i8(__builtin_bit_cast(i32x4, Bt[n][k]), __builtin_bit_cast(i32x4, At[m][k]), __builtin_bit_cast(i32x4, acc[ai][bj][m][n]), 0, 0, 0)); else \
        acc[ai][bj][m][n] = __builtin_bit_cast(acc_t, __builtin_amdgcn_mfma_f32_16x16x32_bf16(Bt[n][k], At[m][k], __builtin_bit_cast(f32x4, acc[ai][bj][m][n]), 0, 0, 0)); } __builtin_amdgcn_s_setprio(0); } while (0)
#define PG8_WAIT_V(n) asm volatile("s_waitcnt vmcnt(" #n ")" ::: "memory")
#define PG8_WAIT_L(n) asm volatile("s_waitcnt lgkmcnt(" #n ")" ::: "memory")
#define PG8_BAR do { if (DBG != 5) __builtin_amdgcn_s_barrier(); } while (0)
#define PG8_SCHED __builtin_amdgcn_sched_barrier(0)
    Unit cur, nxt; int ui = 0;
    if (!S.next(0, cur)) return;
    typedef int i32x4 __attribute__((ext_vector_type(4)));
    using acc_t = typename pg8_sel<I8, i32x4, f32x4>::type;
    acc_t acc[2][2][4][2];
#pragma unroll
    for (int a = 0; a < 2; ++a)
#pragma unroll
        for (int b = 0; b < 2; ++b)
#pragma unroll
            for (int m = 0; m < 4; ++m)
#pragma unroll
                for (int n = 0; n < 2; ++n) acc[a][b][m][n] = acc_t{};
    bf16x8 At[4][2], B0[2][2], B1[2][2];
    if (DBG >= 2) { _Pragma("unroll") for (int k = 0; k < 2; ++k) { _Pragma("unroll") for (int m = 0; m < 4; ++m) _Pragma("unroll") for (int e = 0; e < 8; ++e) At[m][k][e] = (short)(0x3f00 + ((tid * 37 + m * 11 + k * 5 + e * 3) & 0xff) - ((tid + e) & 1) * 0x8000);
        _Pragma("unroll") for (int n = 0; n < 2; ++n) _Pragma("unroll") for (int e = 0; e < 8; ++e) { B0[n][k][e] = (short)(0x3f00 + ((tid * 29 + n * 13 + k * 7 + e * 5) & 0xff) - ((tid + e + n) & 1) * 0x8000); B1[n][k][e] = (short)(0x3f00 + ((tid * 23 + n * 17 + k * 3 + e * 7) & 0xff) - ((tid + e + k) & 1) * 0x8000); } } }
    const char* cA = (const char*)g.A + (size_t)cur.pm * tstep; const char* cB = (const char*)g.Bt + (size_t)cur.pn * tstep;
    S.a_ready(cur);
    if constexpr (SP2 && GV == 4) {
        PG8_STAGE(PG8_SB(0, 0), cB, voffB); PG8_STAGE(PG8_SB(0, 1), cB + hstep, voffB); PG8_STAGE(PG8_SA(0, 0), cA, voffA); PG8_STAGE(PG8_SA(0, 1), cA + hstep, voffA);
        if (wr == 1) PG8_BAR;
        PG8_WAIT_V(2); PG8_BAR;
        PG8_STAGE(PG8_SB(1, 0), cB + kstep, voffB); PG8_PIECE(PG8_SA(1, 0), cA + kstep, voffA, 0); PG8_STAGE(PG8_SB(1, 1), cB + hstep + kstep, voffB);
        PG8_WAIT_V(5); PG8_BAR;
    } else if constexpr (SP2) {
        PG8_STAGE(PG8_SB(0, 0), cB, voffB); PG8_STAGE(PG8_SB(0, 1), cB + hstep, voffB); PG8_STAGE(PG8_SA(0, 0), cA, voffA); PG8_STAGE(PG8_SA(0, 1), cA + hstep, voffA);
        if (wr == 1) PG8_BAR;
        PG8_WAIT_V(2); PG8_BAR;
        PG8_STAGE(PG8_SB(1, 0), cB + kstep, voffB); PG8_STAGE(PG8_SA(1, 0), cA + kstep, voffA); PG8_STAGE(PG8_SB(1, 1), cB + hstep + kstep, voffB);
        PG8_WAIT_V(6); PG8_BAR;
    } else {
        PG8_STAGE(PG8_SB(0, 0), cB, voffB); PG8_STAGE(PG8_SA(0, 0), cA, voffA); PG8_STAGE(PG8_SB(0, 1), cB + hstep, voffB); PG8_STAGE(PG8_SA(0, 1), cA + hstep, voffA);
        if (wr == 1) PG8_BAR;
        PG8_WAIT_V(4); PG8_BAR;
        PG8_STAGE(PG8_SB(1, 0), cB + kstep, voffB); PG8_STAGE(PG8_SA(1, 0), cA + kstep, voffA); PG8_STAGE(PG8_SB(1, 1), cB + hstep + kstep, voffB);
        PG8_WAIT_V(6); PG8_BAR;
    }
    for (;;) {
        const bool has_next = S.next(ui + 1, nxt);
        const char* nA = has_next ? (const char*)g.A + (size_t)nxt.pm * tstep : cA; const char* nB = has_next ? (const char*)g.Bt + (size_t)nxt.pn * tstep : cB;
        for (int t = 0; t < nt; t += 2) {
            const bool last = (t == nt - 2);
            const char* a1 = cA + (size_t)(t + 1) * kstep;
            const char* a2 = last ? nA : cA + (size_t)(t + 2) * kstep; const char* b2 = last ? nB : cB + (size_t)(t + 2) * kstep;
            const char* a3 = a2 + kstep; const char* b3 = b2 + kstep;
            if (last && has_next) S.a_ready(nxt);
            if constexpr (SP2 && GV == 1) {
            PG8_LDB(B0, 0, 0); PG8_LDB(B1, 0, 1); PG8_SCHED; PG8_LDA(At, 0, 0);
            PG8_WAIT_V(6); PG8_WAIT_L(0); PG8_BAR; PG8_MMA(0, 0, At, B0); PG8_SCHED; PG8_STAGE(PG8_SA(1, 1), a1 + hstep, voffA); PG8_SCHED; PG8_MMA(0, 1, At, B1); PG8_BAR; PG8_SCHED;
            PG8_LDA(At, 0, 1);
            PG8_WAIT_V(2); PG8_WAIT_L(0); PG8_BAR; PG8_MMA(1, 0, At, B0); PG8_SCHED; PG8_STAGE(PG8_SB(0, 0), b2, voffB); PG8_STAGE(PG8_SB(0, 1), b2 + hstep, voffB); PG8_STAGE(PG8_SA(0, 0), a2, voffA); PG8_SCHED; PG8_MMA(1, 1, At, B1); PG8_BAR; PG8_SCHED;
            PG8_LDB(B0, 1, 0); PG8_LDB(B1, 1, 1); PG8_SCHED; PG8_LDA(At, 1, 0);
            PG8_WAIT_V(6); PG8_WAIT_L(0); PG8_BAR; PG8_MMA(0, 0, At, B0); PG8_SCHED; PG8_STAGE(PG8_SA(0, 1), a2 + hstep, voffA); PG8_SCHED; PG8_MMA(0, 1, At, B1); PG8_BAR; PG8_SCHED;
            PG8_LDA(At, 1, 1);
            PG8_WAIT_V(2); PG8_WAIT_L(0); PG8_BAR; PG8_MMA(1, 0, At, B0); PG8_SCHED; PG8_STAGE(PG8_SB(1, 0), b3, voffB); PG8_STAGE(PG8_SB(1, 1), b3 + hstep, voffB); PG8_STAGE(PG8_SA(1, 0), a3, voffA); PG8_SCHED; PG8_MMA(1, 1, At, B1); PG8_BAR; PG8_SCHED;
            } else if constexpr (SP2 && GV == 4) {
            PG8_LDB(B0, 0, 0); PG8_LDB(B1, 0, 1); PG8_SCHED; PG8_LDA(At, 0, 0); PG8_STAGE(PG8_SA(1, 1), a1 + hstep, voffA); PG8_PIECE(PG8_SA(1, 0), a1, voffA, 1);
            PG8_WAIT_V(9); PG8_WAIT_L(0); PG8_BAR; PG8_MMA(0, 0, At, B0); PG8_MMA(0, 1, At, B1); PG8_BAR; PG8_SCHED;
            PG8_LDA(At, 0, 1); PG8_STAGE(PG8_SB(0, 0), b2, voffB); PG8_STAGE(PG8_SB(0, 1), b2 + hstep, voffB); PG8_PIECE(PG8_SA(0, 0), a2, voffA, 0);
            PG8_WAIT_V(5); PG8_WAIT_L(0); PG8_BAR; PG8_MMA(1, 0, At, B0); PG8_MMA(1, 1, At, B1); PG8_BAR; PG8_SCHED;
            PG8_LDB(B0, 1, 0); PG8_LDB(B1, 1, 1); PG8_SCHED; PG8_LDA(At, 1, 0); PG8_STAGE(PG8_SA(0, 1), a2 + hstep, voffA); PG8_PIECE(PG8_SA(0, 0), a2, voffA, 1);
            PG8_WAIT_V(9); PG8_WAIT_L(0); PG8_BAR; PG8_MMA(0, 0, At, B0); PG8_MMA(0, 1, At, B1); PG8_BAR; PG8_SCHED;
            PG8_LDA(At, 1, 1); PG8_STAGE(PG8_SB(1, 0), b3, voffB); PG8_STAGE(PG8_SB(1, 1), b3 + hstep, voffB); PG8_PIECE(PG8_SA(1, 0), a3, voffA, 0);
            PG8_WAIT_V(5); PG8_WAIT_L(0); PG8_BAR; PG8_MMA(1, 0, At, B0); PG8_MMA(1, 1, At, B1); PG8_BAR; PG8_SCHED;
            } else if constexpr (SP2 && GV == 2) {
            PG8_LDB(B0, 0, 0); PG8_LDB(B1, 0, 1); PG8_SCHED; PG8_LDA(At, 0, 0); PG8_STAGE(PG8_SA(1, 1), a1 + hstep, voffA);
            PG8_WAIT_V(8); PG8_WAIT_L(0); PG8_BAR; PG8_MMA(0, 0, At, B0); PG8_MMA(0, 1, At, B1); PG8_BAR; PG8_SCHED;
            PG8_LDA(At, 0, 1); PG8_STAGE(PG8_SB(0, 0), b2, voffB); PG8_STAGE(PG8_SB(0, 1), b2 + hstep, voffB);
            PG8_WAIT_V(6); PG8_WAIT_L(0); PG8_BAR; PG8_MMA(1, 0, At, B0); PG8_SCHED; PG8_STAGE(PG8_SA(0, 0), a2, voffA); PG8_SCHED; PG8_MMA(1, 1, At, B1); PG8_BAR; PG8_SCHED;
            PG8_LDB(B0, 1, 0); PG8_LDB(B1, 1, 1); PG8_SCHED; PG8_LDA(At, 1, 0); PG8_STAGE(PG8_SA(0, 1), a2 + hstep, voffA);
            PG8_WAIT_V(8); PG8_WAIT_L(0); PG8_BAR; PG8_MMA(0, 0, At, B0); PG8_MMA(0, 1, At, B1); PG8_BAR; PG8_SCHED;
            PG8_LDA(At, 1, 1); PG8_STAGE(PG8_SB(1, 0), b3, voffB); PG8_STAGE(PG8_SB(1, 1), b3 + hstep, voffB);
            PG8_WAIT_V(6); PG8_WAIT_L(0); PG8_BAR; PG8_MMA(1, 0, At, B0); PG8_SCHED; PG8_STAGE(PG8_SA(1, 0), a3, voffA); PG8_SCHED; PG8_MMA(1, 1, At, B1); PG8_BAR; PG8_SCHED;
            } else if constexpr (SP2) {
            PG8_LDB(B0, 0, 0); PG8_LDB(B1, 0, 1); PG8_SCHED; PG8_LDA(At, 0, 0); PG8_STAGE(PG8_SA(1, 1), a1 + hstep, voffA);
            PG8_WAIT_V(8); PG8_WAIT_L(0); PG8_BAR; PG8_MMA(0, 0, At, B0); PG8_MMA(0, 1, At, B1); PG8_BAR; PG8_SCHED;
            PG8_LDA(At, 0, 1); PG8_STAGE(PG8_SB(0, 0), b2, voffB); PG8_STAGE(PG8_SB(0, 1), b2 + hstep, voffB); PG8_STAGE(PG8_SA(0, 0), a2, voffA);
            PG8_WAIT_V(8); PG8_WAIT_L(0); PG8_BAR; PG8_MMA(1, 0, At, B0); PG8_MMA(1, 1, At, B1); PG8_BAR; PG8_SCHED;
            PG8_LDB(B0, 1, 0); PG8_LDB(B1, 1, 1); PG8_SCHED; PG8_LDA(At, 1, 0); PG8_STAGE(PG8_SA(0, 1), a2 + hstep, voffA);
            PG8_WAIT_V(8); PG8_WAIT_L(0); PG8_BAR; PG8_MMA(0, 0, At, B0); PG8_MMA(0, 1, At, B1); PG8_BAR; PG8_SCHED;
            PG8_LDA(At, 1, 1); PG8_STAGE(PG8_SB(1, 0), b3, voffB); PG8_STAGE(PG8_SB(1, 1), b3 + hstep, voffB); PG8_STAGE(PG8_SA(1, 0), a3, voffA);
            PG8_WAIT_V(8); PG8_WAIT_L(0); PG8_BAR; PG8_MMA(1, 0, At, B0); PG8_MMA(1, 1, At, B1); PG8_BAR; PG8_SCHED;
            } else {
            PG8_LDB(B0, 0, 0); PG8_SCHED; PG8_LDA(At, 0, 0); PG8_STAGE(PG8_SA(1, 1), a1 + hstep, voffA);
            PG8_WAIT_L(8); PG8_BAR; PG8_WAIT_L(0); PG8_MMA(0, 0, At, B0); PG8_BAR; PG8_SCHED;
            PG8_LDB(B1, 0, 1); PG8_STAGE(PG8_SB(0, 0), b2, voffB);
            PG8_BAR; PG8_WAIT_L(0); PG8_MMA(0, 1, At, B1); PG8_BAR;
            PG8_LDA(At, 0, 1); PG8_STAGE(PG8_SA(0, 0), a2, voffA);
            PG8_BAR; PG8_WAIT_L(0); PG8_MMA(1, 0, At, B0); PG8_BAR; PG8_SCHED;
            PG8_STAGE(PG8_SB(0, 1), b2 + hstep, voffB);
            PG8_WAIT_V(6); PG8_BAR; PG8_MMA(1, 1, At, B1); PG8_BAR;
            PG8_LDB(B0, 1, 0); PG8_SCHED; PG8_LDA(At, 1, 0); PG8_STAGE(PG8_SA(0, 1), a2 + hstep, voffA);
            PG8_WAIT_L(8); PG8_BAR; PG8_WAIT_L(0); PG8_MMA(0, 0, At, B0); PG8_BAR; PG8_SCHED;
            PG8_LDB(B1, 1, 1); PG8_STAGE(PG8_SB(1, 0), b3, voffB);
            PG8_BAR; PG8_WAIT_L(0); PG8_MMA(0, 1, At, B1); PG8_BAR;
            PG8_LDA(At, 1, 1); PG8_STAGE(PG8_SA(1, 0), a3, voffA);
            PG8_BAR; PG8_WAIT_L(0); PG8_MMA(1, 0, At, B0); PG8_BAR; PG8_SCHED;
            PG8_STAGE(PG8_SB(1, 1), b3 + hstep, voffB);
            PG8_WAIT_V(6); PG8_BAR; PG8_MMA(1, 1, At, B1); PG8_BAR;
            }
        }
        if constexpr (ALIGN_EPI) { if (wr == 0) PG8_BAR; }
        if constexpr (!Epi::AFTER_DRAIN) {
            if constexpr (I8) { f32x4 accf[2][2][4][2];
                _Pragma("unroll") for (int a = 0; a < 2; ++a) _Pragma("unroll") for (int b = 0; b < 2; ++b) _Pragma("unroll") for (int m = 0; m < 4; ++m) _Pragma("unroll") for (int n = 0; n < 2; ++n) accf[a][b][m][n] = __builtin_convertvector(acc[a][b][m][n], f32x4);
                E(accf, cur, wr, wc, fr, fq); }
            else E(acc, cur, wr, wc, fr, fq);
            S.done(cur); }
        if (!has_next) break;
#pragma unroll
        for (int a = 0; a < 2; ++a)
#pragma unroll
            for (int b = 0; b < 2; ++b)
#pragma unroll
                for (int m = 0; m < 4; ++m)
#pragma unroll
                    for (int n = 0; n < 2; ++n) acc[a][b][m][n] = acc_t{};
        cur = nxt; cA = nA; cB = nB; ++ui;
        if constexpr (ALIGN_EPI) { if (wr == 1) PG8_BAR; }
    }
    PG8_WAIT_V(0);
    if constexpr (!ALIGN_EPI) { if (wr == 0) PG8_BAR; }
    PG8_BAR;
    if constexpr (Epi::AFTER_DRAIN && !I8) { E.fused(acc, cur, wr, wc, fr, fq, lds, wid, lane); S.done(cur); }
#undef PG8_SA
#undef PG8_SB
#undef PG8_STAGE
#undef PG8_PIECE
#undef PG8_LDA
#undef PG8_LDB
#undef PG8_MMA
#undef PG8_WAIT_V
#undef PG8_WAIT_L
#undef PG8_BAR
#undef PG8_SCHED
}
}
constexpr int NWAVES = 8;
constexpr int NB = 4, SEQ = 4096, DM = 4096, M = NB * SEQ, DIN = 10240, DFF = 16384, PLE = 256, AW = 2048, NH = 16, HD = 128, CH = 128;
constexpr float EPS = 1e-6f;
constexpr float QSCALE = 0.08838834764831845f;
constexpr size_t MiB = 1u << 20;
constexpr size_t WS_CTL = 0, CTL_ZERO_BYTES = 256 * 1024;
constexpr size_t WS_PBF = 1 * MiB;
constexpr size_t WS_WSB = 9 * MiB;
constexpr size_t WS_WIN = 10 * MiB, WS_WOUT = WS_WIN + 80 * MiB, WS_WUP = WS_WOUT + 32 * MiB, WS_WDN = WS_WUP + 128 * MiB, WS_WGT = WS_WDN + 128 * MiB, WS_WPJ = WS_WGT + 32 * MiB;
constexpr size_t WS_ACT = WS_WPJ + 2 * MiB;
constexpr size_t WS_Z = WS_ACT + 128 * MiB;
constexpr size_t WS_HID = WS_ACT;
constexpr size_t WS_HG = WS_ACT + 512 * MiB;
constexpr size_t WS_WG8 = WS_HG + 128 * MiB;
constexpr size_t WS_END = WS_WG8 + 16 * MiB;
constexpr size_t WS_H2Q = WS_Z + 128 * MiB;
constexpr size_t WS_SA1 = 256 * 1024, WS_SA2 = 320 * 1024, WS_SWG = 400 * 1024, WS_SWI = 416 * 1024;
constexpr size_t WS_A8 = WS_Z + 320 * MiB, WS_WI8 = WS_HG;
#ifndef MK_NI8
#define MK_NI8 10240
#endif
constexpr int NI8 = MK_NI8;
static_assert(WS_Z + (size_t)M * DIN * 2 <= WS_HG && WS_HID + (size_t)M * DFF * 2 <= WS_HG && WS_WPJ + (size_t)DM * PLE * 2 <= WS_ACT && WS_PBF + (size_t)M * PLE * 2 <= WS_WSB, "d_ws map");
constexpr int CW_TMO = 0, CW_CODE = 1;
constexpr int CW_BAR = 4096;
constexpr int CW_SSQ1 = 16384, CW_SSQ2 = 32768, CW_SSQ3 = 49152;
static_assert((CW_SSQ3 + M) * 4 <= (int)CTL_ZERO_BYTES, "CTL words inside the memset region");
constexpr int RING_OFF = 0, RING_BYTES = 131072;
constexpr int LDS_BYTES = 147456;
constexpr int LDSCTL_OFF = LDS_BYTES - 1024, MISC_OFF = LDSCTL_OFF + 320;
static_assert(MISC_OFF + 128 <= LDS_BYTES, "LDS map");

#define GAS __attribute__((address_space(1)))
#define LAS __attribute__((address_space(3)))
typedef unsigned short bf16;
typedef unsigned v4u __attribute__((ext_vector_type(4)));
typedef float f32x4 __attribute__((ext_vector_type(4)));
typedef short bf16x8 __attribute__((ext_vector_type(8)));
typedef GAS unsigned gu32;
typedef GAS unsigned long long gu64;
#define RLX_AGENT __ATOMIC_RELAXED, __HIP_MEMORY_SCOPE_AGENT
#define LDS_WAIT() asm volatile("s_waitcnt lgkmcnt(0)" ::: "memory")
#define VM_WAIT() asm volatile("s_waitcnt vmcnt(0)" ::: "memory")
__device__ __forceinline__ unsigned long long rt() { return __builtin_amdgcn_s_memrealtime(); }
__device__ __forceinline__ unsigned f2bf(float f) { unsigned u = __builtin_bit_cast(unsigned, f); return (u + 0x7fffu + ((u >> 16) & 1u)) >> 16; }
__device__ __forceinline__ unsigned pk2(float lo, float hi) { return f2bf(lo) | (f2bf(hi) << 16); }
#define XB_TMO      128
#define XB_XCNT(j)  (256  + 64 * (j))
#define XB_XSUB(j)  (1280 + 64 * (j))
#define XB_XGEN(j)  (2304 + 64 * (j))
#define XB_TOP      3328
#define XB_TOPGEN   3392
#define XCD_BAR_WORDS 3456
#define XB_SPIN_CAP (1u << 18)

__device__ __forceinline__ unsigned xb_ld(unsigned* p)              { return __hip_atomic_load(p, __ATOMIC_RELAXED, __HIP_MEMORY_SCOPE_AGENT); }
__device__ __forceinline__ unsigned xb_add(unsigned* p, unsigned v) { return __hip_atomic_fetch_add(p, v, __ATOMIC_RELAXED, __HIP_MEMORY_SCOPE_AGENT); }
__device__ __forceinline__ unsigned xb_xcc_id() { return (unsigned)__builtin_amdgcn_s_getreg((3 << 11) | 20) & 0xFu; }
#define XB_SPIN(cond, bar) do { unsigned _sp = 0; while (cond) { __builtin_amdgcn_s_sleep(1); \
    if ((++_sp & 255u) == 0u) { if (xb_ld(&(bar)[XB_TMO])) break; if (_sp > XB_SPIN_CAP) { atomicAdd(&(bar)[XB_TMO], 1u); break; } } } } while (0)

struct XcdBarrier {
    unsigned* bar; unsigned x;
    volatile LAS unsigned* st;
};

__device__ __forceinline__ XcdBarrier xcd_barrier_post(unsigned* bar, volatile LAS unsigned* st) {
    XcdBarrier b; b.bar = bar; b.x = xb_xcc_id(); b.st = st;
    if (threadIdx.x == 0) (void)xb_add(&bar[XB_XCNT(b.x)], 1u);
    return b;
}
__device__ __forceinline__ void xcd_barrier_complete(unsigned* bar, unsigned x, unsigned& nloc, unsigned& nx) {
    const unsigned G = gridDim.x * gridDim.y * gridDim.z;
    unsigned sum, cnt, mine, sp = 0u;
    for (;;) {
        sum = 0u; cnt = 0u; mine = 0u;
#pragma unroll
        for (unsigned j = 0; j < 16; ++j) { const unsigned c = xb_ld(&bar[XB_XCNT(j)]); sum += c; cnt += (c > 0u) ? 1u : 0u; mine = (j == x) ? c : mine; }
        if (sum == G) break;
        __builtin_amdgcn_s_sleep(1);
        if ((++sp & 255u) == 0u) { if (xb_ld(&bar[XB_TMO])) break; if (sp > XB_SPIN_CAP) { atomicAdd(&bar[XB_TMO], 1u); break; } }
    }
    nloc = mine > 0u ? mine : 1u; nx = cnt > 0u ? cnt : 1u;
}

__device__ __forceinline__ void xcd_barrier(const XcdBarrier& b) {
    asm volatile("s_waitcnt vmcnt(0)" ::: "memory");
    __syncthreads();
    if (threadIdx.x == 0) {
        unsigned* bar = b.bar;
        __builtin_amdgcn_s_waitcnt(0);
        unsigned nloc = b.st[0], nx = b.st[1];
        if (nloc == 0u) { xcd_barrier_complete(bar, b.x, nloc, nx); b.st[0] = nloc; b.st[1] = nx; }
        const unsigned old = xb_add(&bar[XB_XSUB(b.x)], 1u);
        const unsigned gen = old / nloc;
        if (old + 1u == (gen + 1u) * nloc) {
            __builtin_amdgcn_fence(__ATOMIC_RELEASE, "agent");
            asm volatile("s_waitcnt vmcnt(0)" ::: "memory");
            const unsigned og = xb_add(&bar[XB_TOP], 1u);
            const unsigned tg = og / nx;
            if (og + 1u == (tg + 1u) * nx) xb_add(&bar[XB_TOPGEN], 1u);
            else XB_SPIN(xb_ld(&bar[XB_TOPGEN]) == tg, bar);
            __builtin_amdgcn_fence(__ATOMIC_ACQUIRE, "agent");
            xb_add(&bar[XB_XGEN(b.x)], 1u);
            asm volatile("s_waitcnt vmcnt(0)" ::: "memory");
        } else {
            XB_SPIN(xb_ld(&bar[XB_XGEN(b.x)]) == gen, bar);
            __builtin_amdgcn_fence(__ATOMIC_ACQUIRE, "agent");
            asm volatile("s_waitcnt vmcnt(0)" ::: "memory");
        }
    }
    __syncthreads();
}

struct Frame {
    LAS unsigned char* lds;
    volatile LAS unsigned* MISC;
    gu32* ctl;
    int wave;
    int vcu, G;
};
using pg8::lane_id_v;
__device__ __forceinline__ float wave_sum(float v) {
#pragma unroll
    for (int o = 1; o < 64; o <<= 1) v += __shfl_xor(v, o);
    return v;
}
__device__ __forceinline__ float bf2f(unsigned short h) { return __builtin_bit_cast(float, (unsigned)h << 16); }
constexpr int P0_SCR = 64 * 65 * 4;
__device__ __forceinline__ void p0_transpose_item(const float* W, int K, int N, bf16* WT, LAS float* scr, int item, int lane, const float* kg = nullptr) {
    const int nblk = N / 64, kb = item / nblk, nb = item % nblk, k0 = 64 * kb, n0 = 64 * nb;
    const int kr = lane >> 4, c4 = lane & 15;
    f32x4 v[16];
#pragma unroll
    for (int i = 0; i < 16; ++i) v[i] = *(const GAS f32x4*)(W + (size_t)(k0 + 4 * i + kr) * N + n0 + 4 * c4);
#pragma unroll
    for (int i = 0; i < 16; ++i) { LAS float* s = scr + (4 * i + kr) * 65 + 4 * c4; s[0] = v[i].x; s[1] = v[i].y; s[2] = v[i].z; s[3] = v[i].w; }
    LDS_WAIT(); asm volatile("" ::: "memory");
    const int c = lane & 7;
    f32x4 g0 = {1.f, 1.f, 1.f, 1.f}, g1 = g0; if (kg) { g0 = *(const GAS f32x4*)(kg + k0 + 8 * c); g1 = *(const GAS f32x4*)(kg + k0 + 8 * c + 4); }
#pragma unroll
    for (int j = 0; j < 8; ++j) { const int n = (lane >> 3) + 8 * j; const LAS float* s = scr + (8 * c) * 65 + n;
        v4u o; o.x = pk2(s[0 * 65] * g0.x, s[1 * 65] * g0.y); o.y = pk2(s[2 * 65] * g0.z, s[3 * 65] * g0.w); o.z = pk2(s[4 * 65] * g1.x, s[5 * 65] * g1.y); o.w = pk2(s[6 * 65] * g1.z, s[7 * 65] * g1.w);
        *(GAS v4u*)(WT + (size_t)(n0 + n) * K + k0 + 8 * c) = o; }
    LDS_WAIT(); asm volatile("" ::: "memory");
}
__device__ __forceinline__ unsigned q4(float a, float b, float c, float dd, float inv) {
    const int i0 = (int)__builtin_rintf(fminf(fmaxf(a * inv, -127.f), 127.f)), i1 = (int)__builtin_rintf(fminf(fmaxf(b * inv, -127.f), 127.f));
    const int i2 = (int)__builtin_rintf(fminf(fmaxf(c * inv, -127.f), 127.f)), i3 = (int)__builtin_rintf(fminf(fmaxf(dd * inv, -127.f), 127.f));
    return (unsigned)(i0 & 0xff) | ((unsigned)(i1 & 0xff) << 8) | ((unsigned)(i2 & 0xff) << 16) | ((unsigned)(i3 & 0xff) << 24); }
__device__ __forceinline__ float wave_max(float v) {
#pragma unroll
    for (int o = 1; o < 64; o <<= 1) v = fmaxf(v, __shfl_xor(v, o));
    return v;
}
template <bool WB, bool WQ>
__device__ __forceinline__ void rms_row_out(int lane, const float* xrow, const float* g, bf16* orow, unsigned char* qrow, float* sa) {
    const GAS f32x4* xr = (const GAS f32x4*)xrow + lane; const GAS f32x4* gr = (const GAS f32x4*)g + lane;
    f32x4 v[16]; float s = 0.f;
#pragma unroll
    for (int j = 0; j < 16; ++j) { v[j] = xr[64 * j]; s += (v[j].x * v[j].x + v[j].y * v[j].y) + (v[j].z * v[j].z + v[j].w * v[j].w); }
    const float rstd = __builtin_amdgcn_rsqf(wave_sum(s) * (1.f / DM) + EPS);
    GAS unsigned long long* o8 = (GAS unsigned long long*)orow + lane; float am = 0.f;
#pragma unroll
    for (int j = 0; j < 16; ++j) { const f32x4 gg = gr[64 * j]; v[j] = v[j] * rstd * gg;
        if (WQ) am = fmaxf(fmaxf(am, fmaxf(fabsf(v[j].x), fabsf(v[j].y))), fmaxf(fabsf(v[j].z), fabsf(v[j].w)));
        if (WB) o8[64 * j] = (unsigned long long)pk2(v[j].x, v[j].y) | ((unsigned long long)pk2(v[j].z, v[j].w) << 32); }
    if (WQ) { am = fmaxf(wave_max(am), 1e-30f); const float inv = 127.0f / am;
        GAS unsigned* q32 = (GAS unsigned*)qrow + lane;
#pragma unroll
        for (int j = 0; j < 16; ++j) q32[64 * j] = q4(v[j].x, v[j].y, v[j].z, v[j].w, inv);
        if (lane == 0) *sa = am * (1.0f / 127.0f); }
}
__device__ __forceinline__ void quant_row_bf16(int lane, const bf16* hrow, unsigned char* qrow, float* sa) {
    const GAS v4u* hr = (const GAS v4u*)hrow + lane;
    v4u w[8]; float am = 0.f;
#pragma unroll
    for (int j = 0; j < 8; ++j) { w[j] = hr[64 * j];
        am = fmaxf(am, fmaxf(fmaxf(fabsf(pg8::bf_lo(w[j].x)), fabsf(pg8::bf_hi(w[j].x))), fmaxf(fabsf(pg8::bf_lo(w[j].y)), fabsf(pg8::bf_hi(w[j].y)))));
        am = fmaxf(am, fmaxf(fmaxf(fabsf(pg8::bf_lo(w[j].z)), fabsf(pg8::bf_hi(w[j].z))), fmaxf(fabsf(pg8::bf_lo(w[j].w)), fabsf(pg8::bf_hi(w[j].w))))); }
    am = fmaxf(wave_max(am), 1e-30f); const float inv = 127.0f / am;
    GAS unsigned long long* q64 = (GAS unsigned long long*)qrow + lane;
#pragma unroll
    for (int j = 0; j < 8; ++j) q64[64 * j] = (unsigned long long)q4(pg8::bf_lo(w[j].x), pg8::bf_hi(w[j].x), pg8::bf_lo(w[j].y), pg8::bf_hi(w[j].y), inv) | ((unsigned long long)q4(pg8::bf_lo(w[j].z), pg8::bf_hi(w[j].z), pg8::bf_lo(w[j].w), pg8::bf_hi(w[j].w), inv) << 32);
    if (lane == 0) *sa = am * (1.0f / 127.0f);
}
__device__ __forceinline__ void final_row(int lane, const bf16* hrow, float* orow, const float* g, float ssq) {
    const GAS v4u* hr = (const GAS v4u*)hrow + lane; const GAS f32x4* gr = (const GAS f32x4*)g + 2 * lane; GAS f32x4* xr = (GAS f32x4*)orow + 2 * lane;
    const float rstd = __builtin_amdgcn_rsqf(ssq * (1.f / DM) + EPS);
    v4u w[8];
#pragma unroll
    for (int j = 0; j < 8; ++j) w[j] = hr[64 * j];
#pragma unroll
    for (int j = 0; j < 8; ++j) { const f32x4 g0 = gr[128 * j], g1 = gr[128 * j + 1];
        xr[128 * j] = (f32x4){pg8::bf_lo(w[j].x) * rstd * g0.x, pg8::bf_hi(w[j].x) * rstd * g0.y, pg8::bf_lo(w[j].y) * rstd * g0.z, pg8::bf_hi(w[j].y) * rstd * g0.w};
        xr[128 * j + 1] = (f32x4){pg8::bf_lo(w[j].z) * rstd * g1.x, pg8::bf_hi(w[j].z) * rstd * g1.y, pg8::bf_lo(w[j].w) * rstd * g1.z, pg8::bf_hi(w[j].w) * rstd * g1.w}; }
}

typedef float f32x16 __attribute__((ext_vector_type(16)));
typedef short s16x4 __attribute__((ext_vector_type(4)));
typedef short v4i16_t __attribute__((ext_vector_type(4)));
typedef float f32x2_t __attribute__((ext_vector_type(2))); typedef __bf16 bf16x2_t __attribute__((ext_vector_type(2)));
__device__ __forceinline__ unsigned cvtpk_s(float lo, float hi) { f32x2_t v = {lo, hi}; bf16x2_t b = __builtin_convertvector(v, bf16x2_t); return __builtin_bit_cast(unsigned, b); }
__device__ __forceinline__ s16x4 vtr(LAS const unsigned char* p) { return __builtin_bit_cast(s16x4, __builtin_amdgcn_ds_read_tr16_b64_v4i16((LAS v4i16_t*)p)); }
__device__ __forceinline__ int crow(int r, int hi) { return (r & 3) + 8 * (r >> 2) + 4 * hi; }
#define MFMA32(a, b, c) __builtin_amdgcn_mfma_f32_32x32x16_bf16((a), (b), (c), 0, 0, 0)
__device__ __forceinline__ float half_swap_sum(float v) { auto rr = __builtin_amdgcn_permlane32_swap(__float_as_uint(v), __float_as_uint(v), false, false); return __uint_as_float(rr[0]) + __uint_as_float(rr[1]); }
constexpr int KST = 272, VST = 320;

__device__ __forceinline__ void head_norm_store(f32x16 (&o)[4], int lane, LAS unsigned char* wl, const float* gain, bf16* ydst) {
    const int tl = lane & 31, hh = lane >> 5, r4 = lane >> 4, c16 = lane & 15;
    float ss = 0.f;
#pragma unroll
    for (int dt = 0; dt < 4; ++dt)
#pragma unroll
        for (int r = 0; r < 16; ++r) ss += o[dt][r] * o[dt][r];
    ss = half_swap_sum(ss);
    const float rstd = __builtin_amdgcn_rsqf(ss * (1.0f / 128.0f) + EPS);
#pragma unroll
    for (int dt = 0; dt < 4; ++dt)
#pragma unroll
        for (int G = 0; G < 4; ++G) { const int d0 = 32 * dt + 8 * G + 4 * hh; const f32x4 g4 = *(const GAS f32x4*)(gain + d0);
            const unsigned w0 = cvtpk_s(o[dt][4 * G] * rstd * g4.x, o[dt][4 * G + 1] * rstd * g4.y), w1 = cvtpk_s(o[dt][4 * G + 2] * rstd * g4.z, o[dt][4 * G + 3] * rstd * g4.w);
            *(LAS unsigned long long*)(wl + tl * KST + 2 * d0) = (unsigned long long)w0 | ((unsigned long long)w1 << 32); }
#pragma unroll
    for (int i = 0; i < 8; ++i) { const int row = 4 * i + r4; const v4u w = *(LAS const v4u*)(wl + row * KST + 16 * c16);
        *(GAS v4u*)(ydst + (size_t)row * DM + 8 * c16) = w; }
}

constexpr int ATT_WREG = 2 * 32 * KST;
__device__ __forceinline__ void attn_unit(int unit, int lane, LAS unsigned char* wl, const bf16* Z, const float* gb, bf16* Y) {
    const int qb = unit & 127, h = (unit >> 7) & 15, b = unit >> 11;
    const int t0 = qb * 32, tl = lane & 31, hh = lane >> 5, r4 = lane >> 4, c16 = lane & 15;
    const size_t rowb = (size_t)b * SEQ;
    LAS unsigned char* wq = wl; LAS unsigned char* wk = wl + 32 * KST;
    const bf16* Kp = Z + (rowb + r4) * DIN + 3 * AW + h * HD + 8 * c16;
    const unsigned kw = r4 * KST + c16 * 16, kr = tl * KST + hh * 16, vw = r4 * 256 + ((c16 * 16) ^ (r4 << 6));
    v4u kreg[8], vreg[8];
#pragma unroll
    for (int i = 0; i < 8; ++i) { const v4u qv = *(const GAS v4u*)(Kp + (size_t)(t0 + 4 * i) * DIN - AW); kreg[i] = *(const GAS v4u*)(Kp + (size_t)(t0 + 4 * i) * DIN); vreg[i] = *(const GAS v4u*)(Kp + (size_t)(t0 + 4 * i) * DIN + AW);
        *(LAS v4u*)(wq + kw + i * 4 * KST) = qv; }
    f32x16 o[4];
#pragma unroll
    for (int dt = 0; dt < 4; ++dt)
#pragma unroll
        for (int r = 0; r < 16; ++r) o[dt][r] = 0.f;
    float L2 = 0.f;
    const int q4 = (lane & 15) >> 2, p4 = lane & 3, blk = (lane >> 4) & 1;
    for (int j = 0; ; ++j) {
        const int s0 = t0 - 32 * j;
#pragma unroll
        for (int i = 0; i < 8; ++i) *(LAS v4u*)(wk + kw + i * 4 * KST) = kreg[i];
        f32x16 st;
#pragma unroll
        for (int r = 0; r < 16; ++r) st[r] = 0.f;
        { bf16x8 kf[8], qf[8];
#pragma unroll
          for (int ks = 0; ks < 8; ++ks) { kf[ks] = *(LAS const bf16x8*)(wk + kr + 32 * ks); qf[ks] = *(LAS const bf16x8*)(wq + kr + 32 * ks); }
          asm volatile("s_waitcnt lgkmcnt(0)" ::: "memory"); __builtin_amdgcn_sched_barrier(0);
#pragma unroll
          for (int ks = 0; ks < 8; ++ks) st = MFMA32(kf[ks], qf[ks], st); }
#pragma unroll
        for (int i = 0; i < 8; ++i) *(LAS v4u*)(wk + vw + i * 4 * 256) = vreg[i];
        if (s0 >= 32) {
#pragma unroll
            for (int i = 0; i < 8; ++i) { kreg[i] = *(const GAS v4u*)(Kp + (size_t)(s0 - 32 + 4 * i) * DIN); vreg[i] = *(const GAS v4u*)(Kp + (size_t)(s0 - 32 + 4 * i) * DIN + AW); } }
        const bool diag = (j == 0);
        float lk[16];
#pragma unroll
        for (int r = 0; r < 16; ++r) { const float z = st[r];
            const float sp = fmaxf(z, 0.f) + __builtin_amdgcn_logf(1.0f + __builtin_amdgcn_exp2f(-fabsf(z)));
            const bool valid = !diag || (crow(r, hh) < tl);
            lk[r] = valid ? -sp : 0.f; }
        float gs[4], T[4];
#pragma unroll
        for (int G = 0; G < 4; ++G) { gs[G] = (lk[4 * G] + lk[4 * G + 1]) + (lk[4 * G + 2] + lk[4 * G + 3]); T[G] = half_swap_sum(gs[G]); }
        const float SG2 = T[3], SG1 = SG2 + T[2], SG0 = SG1 + T[1];
        const float SG[4] = {SG0, SG1, SG2, 0.f};
        unsigned pw[8];
#pragma unroll
        for (int G = 0; G < 4; ++G) {
            float run = L2 + SG[G] + (hh == 0 ? (T[G] - gs[G]) : 0.f); float a[4];
#pragma unroll
            for (int i = 3; i >= 0; --i) { const int r = 4 * G + i; const float e = __builtin_amdgcn_exp2f(st[r] + lk[r] + run);
                const bool valid = !diag || (crow(r, hh) < tl); a[i] = valid ? e : 0.f; run += lk[r]; }
            pw[2 * G] = cvtpk_s(a[0], a[1]); pw[2 * G + 1] = cvtpk_s(a[2], a[3]); }
        L2 += SG0 + T[0];
#pragma unroll
        for (int s2 = 0; s2 < 2; ++s2) { const v4u pv4 = {pw[4 * s2], pw[4 * s2 + 1], pw[4 * s2 + 2], pw[4 * s2 + 3]}; const bf16x8 pb = __builtin_bit_cast(bf16x8, pv4);
            const int R = 16 * s2 + 4 * hh + q4;
#pragma unroll
            for (int dt = 0; dt < 4; ++dt) { const unsigned xo = (unsigned)(64 * (dt ^ q4) + 32 * blk + 8 * p4);
                const s16x4 lo = vtr(wk + R * 256 + xo), hi = vtr(wk + (R + 8) * 256 + xo);
                const bf16x8 va = __builtin_shufflevector(lo, hi, 0, 1, 2, 3, 4, 5, 6, 7);
                o[dt] = MFMA32(va, pb, o[dt]); } }
        if (s0 < 32 || __all(L2 < -150.5f)) break;
    }
    head_norm_store(o, lane, wk, gb + h * HD, Y + (rowb + t0) * DM + AW + h * HD);
}

__device__ __forceinline__ void sgu_unit(bool active, int unit, int wq, int lane, LAS unsigned char* vn, LAS unsigned char* wl, const bf16* Z, const bf16* WSB, const float* bs, const float* ga, bf16* Y) {
    const int h = unit % NH, nc = (unit / NH) % (SEQ / CH), b = unit / (NH * (SEQ / CH));
    const int tl = lane & 31, hh = lane >> 5, r4 = lane >> 4, c16 = lane & 15;
    const size_t row0 = (size_t)b * SEQ + nc * CH;
    if (active) {
#pragma unroll
        for (int i = 0; i < 8; ++i) { const int s = 32 * wq + 4 * i + r4;
            const v4u w = *(const GAS v4u*)(Z + (row0 + s) * DIN + AW + h * HD + 8 * c16);
            float v[8] = {pg8::bf_lo(w.x), pg8::bf_hi(w.x), pg8::bf_lo(w.y), pg8::bf_hi(w.y), pg8::bf_lo(w.z), pg8::bf_hi(w.z), pg8::bf_lo(w.w), pg8::bf_hi(w.w)};
            float s1 = ((v[0] + v[1]) + (v[2] + v[3])) + ((v[4] + v[5]) + (v[6] + v[7]));
#pragma unroll
            for (int o = 1; o < 16; o <<= 1) s1 += __shfl_xor(s1, o);
            const float mu = s1 * (1.0f / 128.0f); float s2 = 0.f;
#pragma unroll
            for (int e = 0; e < 8; ++e) { v[e] -= mu; s2 += v[e] * v[e]; }
#pragma unroll
            for (int o = 1; o < 16; o <<= 1) s2 += __shfl_xor(s2, o);
            const float rs = __builtin_amdgcn_rsqf(s2 * (1.0f / 128.0f) + EPS);
            v4u ow; ow.x = cvtpk_s(v[0] * rs, v[1] * rs); ow.y = cvtpk_s(v[2] * rs, v[3] * rs); ow.z = cvtpk_s(v[4] * rs, v[5] * rs); ow.w = cvtpk_s(v[6] * rs, v[7] * rs);
            *(LAS v4u*)(vn + s * 256 + ((16 * c16) ^ ((s & 3) << 6))) = ow; }
    }
    LDS_WAIT(); __syncthreads();
    if (active) {
        f32x16 o[4];
#pragma unroll
        for (int dt = 0; dt < 4; ++dt)
#pragma unroll
            for (int r = 0; r < 16; ++r) o[dt][r] = 0.f;
        const int q4 = (lane & 15) >> 2, p4 = lane & 3, blk = (lane >> 4) & 1;
        const bf16* Wrow = WSB + ((size_t)h * CH + 32 * wq + tl) * CH + 8 * hh;
        for (int sb = 0; sb <= wq; ++sb) {
#pragma unroll
            for (int s2 = 0; s2 < 2; ++s2) { const bf16x8 wf = *(const GAS bf16x8*)(Wrow + 32 * sb + 16 * s2);
                const int R = 32 * sb + 16 * s2 + 8 * hh + q4;
#pragma unroll
                for (int dt = 0; dt < 4; ++dt) { const unsigned xo = (unsigned)(64 * (dt ^ q4) + 32 * blk + 8 * p4);
                    const s16x4 lo = vtr(vn + R * 256 + xo), hi = vtr(vn + (R + 4) * 256 + xo);
                    const bf16x8 va = __builtin_shufflevector(lo, hi, 0, 1, 2, 3, 4, 5, 6, 7);
                    o[dt] = MFMA32(va, wf, o[dt]); } } }
#pragma unroll
        for (int i = 0; i < 8; ++i) { const int t = 4 * i + r4; const v4u w = *(const GAS v4u*)(Z + (row0 + 32 * wq + t) * DIN + h * HD + 8 * c16); *(LAS v4u*)(wl + t * KST + 16 * c16) = w; }
        const float bias = bs[h * CH + 32 * wq + tl];
#pragma unroll
        for (int dt = 0; dt < 4; ++dt)
#pragma unroll
            for (int G = 0; G < 4; ++G) { const int d0 = 32 * dt + 8 * G + 4 * hh; const unsigned long long uw = *(LAS const unsigned long long*)(wl + tl * KST + 2 * d0);
                const unsigned u0 = (unsigned)uw, u1 = (unsigned)(uw >> 32);
                o[dt][4 * G] = pg8::bf_lo(u0) * (o[dt][4 * G] + bias); o[dt][4 * G + 1] = pg8::bf_hi(u0) * (o[dt][4 * G + 1] + bias);
                o[dt][4 * G + 2] = pg8::bf_lo(u1) * (o[dt][4 * G + 2] + bias); o[dt][4 * G + 3] = pg8::bf_hi(u1) * (o[dt][4 * G + 3] + bias); }
        head_norm_store(o, lane, wl, ga + h * HD, Y + (row0 + 32 * wq) * DM + h * HD);
    }
    LDS_WAIT(); __syncthreads();
}

#if defined(MK_EXP)
constexpr int N_PHASES = 13;
#else
constexpr int N_PHASES = 12;
#endif
struct Args { const float* in[16]; float* out; unsigned char* ws; int ph_lo, ph_hi, li, pad; };
__global__ void __launch_bounds__(NWAVES * 64, 2) mk_fwd(Args args) {
    extern __shared__ __attribute__((aligned(16))) unsigned char lds[];
    Frame F;
    F.lds = (LAS unsigned char*)lds;
    F.MISC = (volatile LAS unsigned*)(F.lds + MISC_OFF);
    F.wave = __builtin_amdgcn_readfirstlane((int)threadIdx.x >> 6);
    F.G = gridDim.x; { const int bx = blockIdx.x; F.vcu = (F.G % 8 == 0) ? (bx % 8) * (F.G / 8) + bx / 8 : bx; }
    unsigned char* ws = args.ws;
    F.ctl = (gu32*)(ws + WS_CTL);
    const float* x = args.in[0]; const float* p = args.in[1]; const float* norm_mix = args.in[2]; const float* w_in = args.in[3];
    const float* w_s = args.in[4]; const float* b_s = args.in[5]; const float* norm_a = args.in[6]; const float* norm_b = args.in[7];
    const float* w_out = args.in[8]; const float* norm_ffn = args.in[9]; const float* w_up = args.in[10]; const float* w_down = args.in[11];
    const float* norm_ple = args.in[12]; const float* w_gate = args.in[13]; const float* w_proj = args.in[14]; const float* norm_final = args.in[15];
    float* out = args.out;
    bf16* PBF = (bf16*)(ws + WS_PBF); bf16* WSB = (bf16*)(ws + WS_WSB);
    bf16 *Wi = (bf16*)(ws + WS_WIN), *Wo = (bf16*)(ws + WS_WOUT), *Wu = (bf16*)(ws + WS_WUP), *Wd = (bf16*)(ws + WS_WDN), *Wg = (bf16*)(ws + WS_WGT), *Wp = (bf16*)(ws + WS_WPJ);
    bf16 *ACT = (bf16*)(ws + WS_ACT), *Z = (bf16*)(ws + WS_Z), *HID = (bf16*)(ws + WS_HID), *HG = (bf16*)(ws + WS_HG);
    unsigned char* WG8 = ws + WS_WG8; unsigned char* H2Q = ws + WS_H2Q; unsigned char* A8 = ws + WS_A8; unsigned char* WI8 = ws + WS_WI8;
    float* sa2 = (float*)(ws + WS_SA2); float* swg = (float*)(ws + WS_SWG); float* sa1 = (float*)(ws + WS_SA1); float* swi = (float*)(ws + WS_SWI);
    float* ssq1 = (float*)(ws + WS_CTL) + CW_SSQ1; float* ssq2 = (float*)(ws + WS_CTL) + CW_SSQ2; float* ssq3 = (float*)(ws + WS_CTL) + CW_SSQ3;
    for (int u = (int)threadIdx.x; u < (LDS_BYTES - LDSCTL_OFF) / 4; u += NWAVES * 64) ((LAS unsigned*)(F.lds + LDSCTL_OFF))[u] = 0u;
    __syncthreads();
    const int lo = args.ph_lo, hi = args.ph_hi;
    XcdBarrier bar; bar.bar = (unsigned*)(F.ctl + CW_BAR) + args.li * XCD_BAR_WORDS; bar.x = 0; bar.st = nullptr;
    if (hi - lo > 1) bar = xcd_barrier_post((unsigned*)(F.ctl + CW_BAR) + args.li * XCD_BAR_WORDS, F.MISC + 8);
#define IN(k) (lo <= (k) && (k) < hi)
#define GRID_BAR(k) do { if (IN(k) && IN((k) + 1)) xcd_barrier(bar); } while (0)
    const int gw = F.vcu * NWAVES + F.wave, NGW = F.G * NWAVES;
#ifndef MK_REP0
#define MK_REP0 1
#endif
    if (IN(0))
_Pragma("unroll")
    for (int rep0 = 0; rep0 < MK_REP0; ++rep0) {
        const int lane = lane_id_v();
        LAS float* scr = (LAS float*)(F.lds + RING_OFF + F.wave * P0_SCR);
        constexpr int I_IN = (DM / 64) * (DIN / 64), I_OUT = (DM / 64) * (DM / 64), I_UP = (DM / 64) * (DFF / 64), I_DN = (DFF / 64) * (DM / 64), I_GT = I_OUT, I_PJ = (PLE / 64) * (DM / 64);
        constexpr int NITEMS = I_IN + I_OUT + I_UP + I_DN + I_GT + I_PJ;
        for (int it = gw; it < NITEMS; it += NGW) {
            int r = it;
            if (r < I_IN) { p0_transpose_item(w_in, DM, DIN, Wi, scr, r, lane); continue; } r -= I_IN;
            if (r < I_OUT) { p0_transpose_item(w_out, DM, DM, Wo, scr, r, lane); continue; } r -= I_OUT;
            if (r < I_UP) { p0_transpose_item(w_up, DM, DFF, Wu, scr, r, lane, norm_ffn); continue; } r -= I_UP;
            if (r < I_DN) { p0_transpose_item(w_down, DFF, DM, Wd, scr, r, lane); continue; } r -= I_DN;
            if (r < I_GT) { p0_transpose_item(w_gate, DM, DM, Wg, scr, r, lane, norm_ple); continue; } r -= I_GT;
            p0_transpose_item(w_proj, PLE, DM, Wp, scr, r, lane);
        }
        for (int i = gw; i < M * PLE / 256; i += NGW) {
            const f32x4 v = ((const GAS f32x4*)p)[(size_t)i * 64 + lane];
            ((GAS unsigned long long*)PBF)[(size_t)i * 64 + lane] = (unsigned long long)pk2(v.x, v.y) | ((unsigned long long)pk2(v.z, v.w) << 32); }
        for (int i = gw; i < NH * CH * CH / 256; i += NGW) {
            const f32x4 v = ((const GAS f32x4*)w_s)[(size_t)i * 64 + lane]; const int e0 = i * 256 + lane * 4, s = e0 & 127, t = (e0 >> 7) & 127;
            ((GAS unsigned long long*)WSB)[(size_t)i * 64 + lane] = (unsigned long long)pk2(s <= t ? v.x : 0.f, s + 1 <= t ? v.y : 0.f) | ((unsigned long long)pk2(s + 2 <= t ? v.z : 0.f, s + 3 <= t ? v.w : 0.f) << 32); }
        for (int m = gw; m < M; m += NGW) rms_row_out<(NI8 < DIN), (NI8 > 0)>(lane, x + (size_t)m * DM, norm_mix, ACT + (size_t)m * DM, A8 + (size_t)m * DM, sa1 + m);
    }
    GRID_BAR(0);
    if (IN(1)) {
        const int lane = lane_id_v();
        for (int n = gw; n < DM + NI8; n += NGW) {
            if (n < DM) quant_row_bf16(lane, Wg + (size_t)n * DM, WG8 + (size_t)n * DM, swg + n);
            else quant_row_bf16(lane, Wi + (size_t)(n - DM) * DM, WI8 + (size_t)(n - DM) * DM, swi + (n - DM)); }
    }
    GRID_BAR(1);
    if (IN(2)) {
        if constexpr (NI8 > 0) { pg8::Gemm g{(const bf16*)A8, (const bf16*)WI8, M, NI8, DM / 2}; pg8::StaticOrder S; S.init(M, NI8, F.G, (int)blockIdx.x);
          pg8::EpiInProjI8 E{Z, DIN, (2 * AW) / 256, (3 * AW) / 256, __builtin_bit_cast(unsigned, QSCALE * 1.4426950408889634f), sa1, swi};
          pg8::gemm_phase<pg8::EpiInProjI8, pg8::StaticOrder, true, true, false, 0, 0, true>(F.lds + RING_OFF, g, S, E); }
        if constexpr (NI8 < DIN) { pg8::Gemm g{ACT, Wi + (size_t)NI8 * DM, M, DIN - NI8, DM}; pg8::StaticOrder S; S.init(M, DIN - NI8, F.G, (int)blockIdx.x);
          pg8::EpiInProj E{Z + NI8, DIN, (2 * AW - NI8) / 256, (3 * AW - NI8) / 256, QSCALE * 1.4426950408889634f};
          pg8::gemm_phase<pg8::EpiInProj, pg8::StaticOrder, true, true>(F.lds + RING_OFF, g, S, E); }
    }
    GRID_BAR(2);
    if (IN(3)) {
        const int lane = lane_id_v(), hw = F.wave >> 2, wq = F.wave & 3;
        LAS unsigned char* vn = F.lds + hw * 32768; LAS unsigned char* wls = F.lds + 65536 + F.wave * (32 * KST);
        constexpr int NSGU = NB * (SEQ / CH) * NH;
        for (int it = 0; it * (2 * F.G) < NSGU; ++it) { const int unit = it * (2 * F.G) + 2 * (int)blockIdx.x + hw;
            sgu_unit(unit < NSGU, unit < NSGU ? unit : 0, wq, lane, vn, wls, Z, WSB, b_s, norm_a, ACT); }
    }
    if (IN(4)) {
        const int lane = lane_id_v();
        LAS unsigned char* wl2 = F.lds + F.wave * ATT_WREG;
        constexpr int NATT = NB * NH * (SEQ / 32);
        for (int i = 0; ; ++i) { const int unit = (i * F.G + (int)blockIdx.x) * NWAVES + F.wave; if (unit >= NATT) break;
            attn_unit(unit, lane, wl2, Z, norm_b, ACT); }
    }
    GRID_BAR(4);
    if (IN(5)) {
        pg8::Gemm g{ACT, Wo, M, DM, DM}; pg8::StaticOrder S; S.init(M, DM, F.G, (int)blockIdx.x);
        pg8::EpiRes1 E{x, HG, ssq1, DM};
        pg8::gemm_phase<pg8::EpiRes1, pg8::StaticOrder, true, true>(F.lds + RING_OFF, g, S, E);
    }
    GRID_BAR(5);
    if (IN(6)) {
        pg8::Gemm g{HG, Wu, M, DFF, DM}; pg8::StaticOrder S; S.init(M, DFF, F.G, (int)blockIdx.x);
        pg8::EpiUp E{HID, DFF, ssq1, 1.0f / DM, EPS};
        pg8::gemm_phase<pg8::EpiUp, pg8::StaticOrder, true, true>(F.lds + RING_OFF, g, S, E);
    }
    GRID_BAR(6);
    if (IN(7)) {
        pg8::Gemm g{HID, Wd, M, DM, DFF}; pg8::StaticOrder S; S.init(M, DM, F.G, (int)blockIdx.x);
        pg8::EpiRes2 E{HG, ssq2, DM};
        pg8::gemm_phase<pg8::EpiRes2, pg8::StaticOrder, true, true>(F.lds + RING_OFF, g, S, E);
    }
    GRID_BAR(7);
    if (IN(8)) {
        const int lane = lane_id_v();
        for (int m = gw; m < M; m += NGW) quant_row_bf16(lane, HG + (size_t)m * DM, H2Q + (size_t)m * DM, sa2 + m);
    }
    GRID_BAR(8);
    if (IN(9)) {
        pg8::Gemm g{PBF, Wp, M, DM, PLE}; pg8::StaticOrder S; S.init(M, DM, F.G, (int)blockIdx.x);
        pg8::EpiPlainBf16 E{ACT, DM};
        pg8::gemm_phase<pg8::EpiPlainBf16, pg8::StaticOrder, true, true>(F.lds + RING_OFF, g, S, E);
        VM_WAIT(); __syncthreads();
    }
    if (IN(10)) {
#if defined(MK_GATE_BF16)
        pg8::Gemm g{HG, Wg, M, DM, DM}; pg8::StaticOrder S; S.init(M, DM, F.G, (int)blockIdx.x);
        pg8::EpiGate E{Z, HG, ACT, ssq2, ssq3, DM, 1.0f / DM, EPS, nullptr, nullptr};
        pg8::gemm_phase<pg8::EpiGate, pg8::StaticOrder, true, true>(F.lds + RING_OFF, g, S, E);
#else
        pg8::Gemm g{(const bf16*)H2Q, (const bf16*)WG8, M, DM, DM / 2}; pg8::StaticOrder S; S.init(M, DM, F.G, (int)blockIdx.x);
        pg8::EpiGate E{Z, HG, ACT, ssq2, ssq3, DM, 1.0f / DM, EPS, sa2, swg};
        pg8::gemm_phase<pg8::EpiGate, pg8::StaticOrder, true, true, false, 0, 0, true>(F.lds + RING_OFF, g, S, E);
#endif
    }
    GRID_BAR(10);
    if (IN(11)) {
        const int lane = lane_id_v();
        for (int m = gw; m < M; m += NGW) final_row(lane, Z + (size_t)m * DM, out + (size_t)m * DM, norm_final, ssq3[m]);
    }
#if defined(MK_EXP)
    if (IN(12)) {
        pg8::Gemm g{HG, Wu, M, DFF, DM}; pg8::StaticOrder S; S.init(M, DFF, F.G, (int)blockIdx.x);
        pg8::EpiUp E{HID, DFF, ssq1, 1.0f / DM, EPS};
#if MK_EXP == 2
        struct SameUnit { int c; __device__ bool next(int i, pg8::Unit& u) const { if (i >= 16) return false; u.pm = c & 7; u.pn = (c >> 3) & 1; return true; }
            __device__ __forceinline__ void a_ready(const pg8::Unit&) const {} __device__ __forceinline__ void done(const pg8::Unit&) const {} } SU{(int)blockIdx.x};
        pg8::gemm_phase<pg8::EpiUp, SameUnit, true, true, false>(F.lds + RING_OFF, g, SU, E);
#else
        pg8::gemm_phase<pg8::EpiUp, pg8::StaticOrder, true, true, (MK_EXP == 1), (MK_EXP >= 10 && MK_EXP < 20 ? MK_EXP - 10 : 0), (MK_EXP >= 20 ? MK_EXP - 20 : 0)>(F.lds + RING_OFF, g, S, E);
#endif
    }
#endif
#undef IN
#undef GRID_BAR
}

extern "C" void kernel_launch(void* const* d_in, const int* in_sizes, int n_in, void* d_out, int out_size, void* d_ws, size_t ws_size, hipStream_t stream) {
    static int grid = 0;
    if (grid == 0) {
        if (n_in != 16 || in_sizes[0] != M * DM || out_size != M * DM || ws_size < WS_END) { fprintf(stderr, "kernel_launch: unexpected shapes: n_in %d, in0 %d, out %d, ws %zu (need %zu); nothing launched\n", n_in, n_in > 0 ? in_sizes[0] : -1, out_size, ws_size, (size_t)WS_END); grid = -1; return; }
        int dev = 0, cus = 0, per_cu = 0;
        if (hipGetDevice(&dev) != hipSuccess || hipDeviceGetAttribute(&cus, hipDeviceAttributeMultiprocessorCount, dev) != hipSuccess) { fprintf(stderr, "kernel_launch: device query failed\n"); grid = -1; return; }
        if (hipFuncSetAttribute((const void*)mk_fwd, hipFuncAttributeMaxDynamicSharedMemorySize, LDS_BYTES) != hipSuccess) { fprintf(stderr, "kernel_launch: hipFuncSetAttribute failed\n"); grid = -1; return; }
        if (hipOccupancyMaxActiveBlocksPerMultiprocessor(&per_cu, (const void*)mk_fwd, NWAVES * 64, LDS_BYTES) != hipSuccess || per_cu < 1) { fprintf(stderr, "kernel_launch: occupancy query reports %d workgroups per CU\n", per_cu); }
        (void)hipGetLastError();
        grid = cus;
    }
    if (grid < 0) return;
    if (hipMemsetAsync((char*)d_ws + WS_CTL, 0, CTL_ZERO_BYTES, stream) != hipSuccess) { fprintf(stderr, "kernel_launch: hipMemsetAsync failed\n"); return; }
    Args a{};
    for (int i = 0; i < 16; ++i) a.in[i] = (const float*)d_in[i];
    a.out = (float*)d_out; a.ws = (unsigned char*)d_ws;
#if defined(MK_PLAN)
    { const int plan[] = MK_PLAN; int li = 0;
      for (unsigned i = 0; i + 1 < sizeof(plan) / sizeof(plan[0]); i += 2) { a.ph_lo = plan[i]; a.ph_hi = plan[i + 1]; a.li = li; if (plan[i + 1] - plan[i] > 1) ++li;
          hipLaunchKernelGGL(mk_fwd, dim3(grid), dim3(NWAVES * 64), LDS_BYTES, stream, a); } }
#else
    a.ph_lo = 0; a.ph_hi = N_PHASES; a.li = 0;
    hipLaunchKernelGGL(mk_fwd, dim3(grid), dim3(NWAVES * 64), LDS_BYTES, stream, a);
#endif
    const hipError_t le = hipPeekAtLastError();
    if (le != hipSuccess) fprintf(stderr, "kernel_launch: launch failed: %s\n", hipGetErrorName(le));
}
```
